# Optimizing an MI355X kernel written in HIP

```python
import jax
import jax.numpy as jnp
from jax import lax

D_MODEL = 1024
BATCH = 16
SEQ = 256
DEPTH = 1
DEC_BATCH = 4
DEC_SEQ = 2048
PAST_LEN = 256

GRID_W = 64
N_RET_HEADS = 4
RET_DK = 256
RET_DV = 512
D_RET_QK = N_RET_HEADS * RET_DK
D_RET_V = N_RET_HEADS * RET_DV
RET_CHUNK = 128
N_LRU_BLOCKS = 10
LRU_BLOCK = 128
D_LRU = N_LRU_BLOCKS * LRU_BLOCK
LRU_C = 8.0
CONV_W = 4
CONV_LEFT = 2
EPS = 1e-6
D_IN = 2 * D_RET_QK + 2 * D_RET_V + 2 * D_LRU + 2 * D_MODEL

kernel_name = 'hybrid_retention_rglru_diffusion_step'

F32 = jnp.float32


def rmsnorm(x, w):
    x32 = x.astype(F32)
    return x32 * lax.rsqrt(jnp.mean(x32 * x32, axis=-1, keepdims=True) + EPS) * w.astype(F32)


def short_conv(x, w, b):
    L = x.shape[-2]
    pad = [(0, 0)] * (x.ndim - 2) + [(CONV_LEFT, CONV_W - 1 - CONV_LEFT), (0, 0)]
    xp = jnp.pad(x, pad)
    out = b.astype(F32)
    for t in range(CONV_W):
        out = out + xp[..., t:t + L, :] * w[t].astype(F32)
    return out


def retention_dir(q, k, v, log_g, s0, strict):
    B, L, H, DK = q.shape
    DV = v.shape[-1]
    C = min(RET_CHUNK, L)
    nc = L // C
    qc = q.reshape(B, nc, C, H, DK)
    kc = k.reshape(B, nc, C, H, DK)
    vc = v.reshape(B, nc, C, H, DV)
    pos = jnp.arange(C, dtype=F32)
    diff = pos[:, None] - pos[None, :]
    mask = (diff > 0) if strict else (diff >= 0)
    decay = jnp.where(mask[None], jnp.exp(log_g[:, None, None] * jnp.where(mask, diff, 0.0)[None]), 0.0)
    scores = jnp.einsum('bnihd,bnjhd->bnhij', qc, kc) * decay
    intra = jnp.einsum('bnhij,bnjhe->bnihe', scores, vc)
    k_dec = jnp.exp((C - 1 - pos)[:, None] * log_g[None])
    kv = jnp.einsum('bnjhd,jh,bnjhe->nbhde', kc, k_dec, vc)
    c_dec = jnp.exp(C * log_g)[:, None, None]

    def step(S, kv_n):
        return c_dec * S + kv_n, S

    s_fin, s_prev = lax.scan(step, s0.astype(F32), kv)
    q_dec = jnp.exp((pos + 1)[:, None] * log_g[None])
    inter = jnp.einsum('bnihd,ih,nbhde->bnihe', qc, q_dec, s_prev)
    return (intra + inter).reshape(B, L, H, DV), s_fin


def rglru(x, wa, ba, wx, bx, a_param, h0, reverse):
    B, L, _ = x.shape
    xb = x.reshape(B, L, N_LRU_BLOCKS, LRU_BLOCK)
    r = jax.nn.sigmoid(jnp.einsum('blhi,hij->blhj', xb, wa.astype(F32)).reshape(B, L, D_LRU) + ba.astype(F32))
    gi = jax.nn.sigmoid(jnp.einsum('blhi,hij->blhj', xb, wx.astype(F32)).reshape(B, L, D_LRU) + bx.astype(F32))
    log_a = -LRU_C * r * jax.nn.softplus(-a_param.astype(F32))
    a = jnp.exp(log_a)
    b = jnp.sqrt(-jnp.expm1(2.0 * log_a)) * (gi * x)

    def combine(e1, e2):
        a1, b1 = e1
        a2, b2 = e2
        return a1 * a2, a2 * b1 + b2

    a_cum, h = lax.associative_scan(combine, (a, b), axis=1, reverse=reverse)
    h = h + a_cum * h0.astype(F32)[:, None]
    fin = h[:, 0] if reverse else h[:, -1]
    return h, fin


def branch_mixer(h, s0_ret, h0_lru, on_grid, w_in, decay_logit, gn_w, w_ret_down, conv_w, conv_b,
                 wa, ba, wx, bx, a_param, w_lru_down, w_out):
    B, L, _ = h.shape
    z = h @ w_in.astype(F32)
    sizes = [D_RET_QK, D_RET_QK, D_RET_V, D_RET_V, D_LRU, D_LRU, D_MODEL, D_MODEL]
    idx = []
    acc = 0
    for s in sizes[:-1]:
        acc += s
        idx.append(acc)
    q, k, v, g_ret, x_lru, g_lru, m_ret, m_lru = jnp.split(z, idx, axis=-1)
    q = q.reshape(B, L, N_RET_HEADS, RET_DK)
    k = k.reshape(B, L, N_RET_HEADS, RET_DK) * (RET_DK ** -0.5)
    v = v.reshape(B, L, N_RET_HEADS, RET_DV)
    log_g = jax.nn.log_sigmoid(decay_logit.astype(F32))
    o_f, s_f = retention_dir(q, k, v, log_g[0], s0_ret[:, 0], False)
    o_b, s_b = retention_dir(q[:, ::-1], k[:, ::-1], v[:, ::-1], log_g[1], s0_ret[:, 1], True)
    o = o_f + o_b[:, ::-1]
    o = o * lax.rsqrt(jnp.mean(o * o, axis=-1, keepdims=True) + EPS)
    o = o.reshape(B, L, D_RET_V) * gn_w.astype(F32) * jax.nn.silu(g_ret)
    ret_out = o @ w_ret_down.astype(F32)
    if on_grid:
        rows = L // GRID_W
        xc = short_conv(x_lru.reshape(B, rows, GRID_W, D_LRU), conv_w, conv_b).reshape(B, L, D_LRU)
    else:
        xc = short_conv(x_lru, conv_w, conv_b)
    hf, fin_f = rglru(xc, wa[0], ba[0], wx[0], bx[0], a_param[0], h0_lru[:, 0], False)
    hb, fin_b = rglru(xc, wa[1], ba[1], wx[1], bx[1], a_param[1], h0_lru[:, 1], True)
    lru_out = ((hf + hb) * jax.nn.silu(g_lru)) @ w_lru_down.astype(F32)
    merged = jax.nn.sigmoid(m_ret) * ret_out + jax.nn.sigmoid(m_lru) * lru_out
    out = merged @ w_out.astype(F32)
    return out, jnp.stack([s_f, s_b], axis=1), jnp.stack([fin_f, fin_b], axis=1)


def trunk_layer(x, cond, s0_ret, h0_lru, on_grid, norm_w, w_ada, b_ada, w_in, decay_logit, gn_w,
                w_ret_down, conv_w, conv_b, wa, ba, wx, bx, a_param, w_lru_down, w_out):
    mod = jax.nn.silu(cond.astype(F32)) @ w_ada.astype(F32) + b_ada.astype(F32)
    shift, scale, gate = jnp.split(mod, 3, axis=-1)
    h = rmsnorm(x, norm_w) * (1.0 + scale[:, None]) + shift[:, None]
    out, s_ret, s_lru = branch_mixer(h, s0_ret, h0_lru, on_grid, w_in, decay_logit, gn_w, w_ret_down,
                                     conv_w, conv_b, wa, ba, wx, bx, a_param, w_lru_down, w_out)
    return x + gate[:, None] * out, s_ret, s_lru


def setup_inputs(seed: int = 0) -> dict:
    key = jax.random.key(seed)
    ks = jax.random.split(key, 24)
    n = jax.random.normal
    heads = jnp.arange(N_RET_HEADS, dtype=F32)
    base_logit = jnp.log(jnp.exp2(5.0 + heads) - 1.0)
    u = jax.random.uniform(ks[19], (DEPTH, 2, D_LRU), F32, 0.9, 0.999)
    s = u ** (1.0 / LRU_C)
    return {
        'x_prompt': n(ks[0], (BATCH, SEQ, D_MODEL), F32),
        'x_sample': n(ks[1], (DEC_BATCH, DEC_SEQ, D_MODEL), F32),
        'state_ret': 0.5 * n(ks[2], (DEC_BATCH, DEPTH, 2, N_RET_HEADS, RET_DK, RET_DV), F32),
        'state_lru': 0.5 * n(ks[3], (DEC_BATCH, DEPTH, 2, D_LRU), F32),
        'c': n(ks[4], (DEC_BATCH, D_MODEL), F32),
        'c_ctx': n(ks[5], (D_MODEL,), F32),
        'norm_w': 1.0 + 0.05 * n(ks[6], (DEPTH, D_MODEL), F32),
        'w_ada': n(ks[7], (DEPTH, D_MODEL, 3 * D_MODEL), F32) * (0.5 * D_MODEL ** -0.5),
        'b_ada': 0.02 * n(ks[8], (DEPTH, 3 * D_MODEL), F32),
        'w_in': n(ks[9], (DEPTH, D_MODEL, D_IN), F32) * D_MODEL ** -0.5,
        'ret_decay_logit': base_logit + 0.1 * n(ks[10], (DEPTH, 2, N_RET_HEADS), F32),
        'ret_gn_w': 1.0 + 0.05 * n(ks[11], (DEPTH, D_RET_V), F32),
        'w_ret_down': n(ks[12], (DEPTH, D_RET_V, D_MODEL), F32) * D_RET_V ** -0.5,
        'conv_w': n(ks[13], (DEPTH, CONV_W, D_LRU), F32) * CONV_W ** -0.5,
        'conv_b': 0.02 * n(ks[14], (DEPTH, D_LRU), F32),
        'lru_wa': n(ks[15], (DEPTH, 2, N_LRU_BLOCKS, LRU_BLOCK, LRU_BLOCK), F32) * LRU_BLOCK ** -0.5,
        'lru_ba': 0.02 * n(ks[16], (DEPTH, 2, D_LRU), F32),
        'lru_wx': n(ks[17], (DEPTH, 2, N_LRU_BLOCKS, LRU_BLOCK, LRU_BLOCK), F32) * LRU_BLOCK ** -0.5,
        'lru_bx': 0.02 * n(ks[18], (DEPTH, 2, D_LRU), F32),
        'lru_a_param': jnp.log(s) - jnp.log1p(-s),
        'w_lru_down': n(ks[20], (DEPTH, D_LRU, D_MODEL), F32) * D_LRU ** -0.5,
        'w_out': n(ks[21], (DEPTH, D_MODEL, D_MODEL), F32) * D_MODEL ** -0.5,
        'final_norm_w': 1.0 + 0.05 * n(ks[22], (D_MODEL,), F32),
    }


def reference(x_prompt, x_sample, state_ret, state_lru, c, c_ctx, norm_w, w_ada, b_ada, w_in,
              ret_decay_logit, ret_gn_w, w_ret_down, conv_w, conv_b, lru_wa, lru_ba, lru_wx, lru_bx,
              lru_a_param, w_lru_down, w_out, final_norm_w):
    x = x_prompt.astype(F32)
    y = x_sample.astype(F32)
    b_ctx = x.shape[0]
    cond_ctx = jnp.broadcast_to(c_ctx.astype(F32), (b_ctx, D_MODEL))
    zero_ret = jnp.zeros((b_ctx, 2, N_RET_HEADS, RET_DK, RET_DV), F32)
    zero_lru = jnp.zeros((b_ctx, 2, D_LRU), F32)
    new_ret = []
    new_lru = []
    for l in range(DEPTH):
        params = (norm_w[l], w_ada[l], b_ada[l], w_in[l], ret_decay_logit[l], ret_gn_w[l], w_ret_down[l],
                  conv_w[l], conv_b[l], lru_wa[l], lru_ba[l], lru_wx[l], lru_bx[l], lru_a_param[l],
                  w_lru_down[l], w_out[l])
        x, s_ret, s_lru = trunk_layer(x, cond_ctx, zero_ret, zero_lru, False, *params)
        new_ret.append(s_ret)
        new_lru.append(s_lru)
        y, _, _ = trunk_layer(y, c, state_ret[:, l], state_lru[:, l], True, *params)
    y_prompt = rmsnorm(x, final_norm_w).astype(x_prompt.dtype)
    y_sample = rmsnorm(y, final_norm_w).astype(x_sample.dtype)
    new_state_ret = jnp.stack(new_ret, axis=1).astype(state_ret.dtype)
    new_state_lru = jnp.stack(new_lru, axis=1).astype(state_lru.dtype)
    return (y_prompt, y_sample, new_state_ret, new_state_lru)
```

```cpp
#include <hip/hip_runtime.h>
#include <cstdint>
#include <cstdio>

#ifndef MK_ONE_LAUNCH
#define MK_ONE_LAUNCH 0
#endif

namespace {
constexpr int D = 1024, NCTX = 16, LCTX = 256, NLAT = 4, LLAT = 2048;
constexpr int MCTX = NCTX * LCTX, MLAT = NLAT * LLAT, M = MCTX + MLAT;
constexpr int NH = 4, DK = 256, DV = 512, DQK = NH * DK, DRV = NH * DV;
constexpr int NB = 10, LB = 128, DL = NB * LB;
constexpr int DIN = 10752;
constexpr int N1 = 6656;
constexpr int N2 = 4096;
constexpr int CH = 256;
constexpr int NCH_LAT = LLAT / CH;
constexpr float EPS = 1e-6f;
constexpr int NWAVES = 8, NTHR = 512;

constexpr size_t MiB = 1u << 20;
constexpr size_t WS_CTL = 0, CTL_ZERO_BYTES = 1 * MiB;
constexpr size_t WS_WINT = 1 * MiB;
constexpr size_t WS_WRDT = 22 * MiB;
constexpr size_t WS_WLDT = 26 * MiB;
constexpr size_t WS_WOUTT = 28 * MiB + 512 * 1024;
constexpr size_t WS_WLRUT = 30 * MiB + 512 * 1024;
constexpr size_t WS_MOD = 31 * MiB + 768 * 1024;
constexpr size_t WS_H = 32 * MiB;
constexpr size_t WS_Q = 56 * MiB, WS_K = 80 * MiB, WS_V = 104 * MiB;
constexpr size_t WS_XL = 152 * MiB, WS_GL = 182 * MiB;
constexpr size_t WS_AGG = 216 * MiB;
constexpr size_t WS_HL = 226 * MiB;
constexpr size_t WS_SP = 152 * MiB;
constexpr size_t WS_SIGR = 56 * MiB, WS_SIGL = 80 * MiB;
constexpr size_t WS_MERGED = 104 * MiB;
constexpr size_t WS_END = 256 * MiB;
constexpr size_t OUT_Y = 0;
constexpr size_t OUT_NSR = (size_t)M * D;
constexpr size_t OUT_NSL = OUT_NSR + (size_t)NCTX * 2 * NH * DK * DV;
constexpr size_t OUT_TOTAL = OUT_NSL + (size_t)NCTX * 2 * DL;

constexpr int CW_TMO = 0, CW_CODE = 1, CW_BAR = 4096;
constexpr int LDS_BYTES = 147456;
constexpr int MISC_OFF = 131072 + 320;

#define GAS __attribute__((address_space(1)))
#define LAS __attribute__((address_space(3)))
typedef unsigned short bf16;
typedef unsigned v4u __attribute__((ext_vector_type(4)));
typedef float f32x4 __attribute__((ext_vector_type(4)));
typedef short bf16x8 __attribute__((ext_vector_type(8)));
typedef GAS unsigned gu32;
#define RLX_AGENT __ATOMIC_RELAXED, __HIP_MEMORY_SCOPE_AGENT
#define LDS_WAIT() asm volatile("s_waitcnt lgkmcnt(0)" ::: "memory")
#define VM_WAIT() asm volatile("s_waitcnt vmcnt(0)" ::: "memory")

__device__ __forceinline__ unsigned f2bf(float f) { unsigned u = __builtin_bit_cast(unsigned, f); return (u + 0x7fffu + ((u >> 16) & 1u)) >> 16; }
__device__ __forceinline__ float bf2f(unsigned short b) { return __builtin_bit_cast(float, ((unsigned)b) << 16); }
__device__ __forceinline__ float bfr(float f) { return bf2f((unsigned short)f2bf(f)); }
__device__ __forceinline__ unsigned pk2(float lo, float hi) { return f2bf(lo) | (f2bf(hi) << 16); }
__device__ __forceinline__ float sigmoidf_(float x) { return 1.0f / (1.0f + __expf(-x)); }
__device__ __forceinline__ float siluf_(float x) { return x / (1.0f + __expf(-x)); }

#define XB_TMO      128
#define XB_XCNT(j)  (256  + 64 * (j))
#define XB_XSUB(j)  (1280 + 64 * (j))
#define XB_XGEN(j)  (2304 + 64 * (j))
#define XB_TOP      3328
#define XB_TOPGEN   3392
#define XCD_BAR_WORDS 3456
#define XB_SPIN_CAP (1u << 22)
__device__ __forceinline__ unsigned xb_ld(unsigned* p)              { return __hip_atomic_load(p, __ATOMIC_RELAXED, __HIP_MEMORY_SCOPE_AGENT); }
__device__ __forceinline__ unsigned xb_add(unsigned* p, unsigned v) { return __hip_atomic_fetch_add(p, v, __ATOMIC_RELAXED, __HIP_MEMORY_SCOPE_AGENT); }
__device__ __forceinline__ unsigned xb_xcc_id() { return (unsigned)__builtin_amdgcn_s_getreg((3 << 11) | 20) & 0xFu; }
#define XB_SPIN(cond, bar) do { unsigned _sp = 0; while (cond) { __builtin_amdgcn_s_sleep(1); \
    if ((++_sp & 255u) == 0u) { if (xb_ld(&(bar)[XB_TMO])) break; if (_sp > XB_SPIN_CAP) { atomicAdd(&(bar)[XB_TMO], 1u); break; } } } } while (0)
struct XcdBarrier { unsigned* bar; unsigned x; volatile LAS unsigned* st; };
__device__ __forceinline__ XcdBarrier xcd_barrier_post(unsigned* bar, volatile LAS unsigned* st) {
    XcdBarrier b; b.bar = bar; b.x = xb_xcc_id(); b.st = st;
    if (threadIdx.x == 0) (void)xb_add(&bar[XB_XCNT(b.x)], 1u);
    return b;
}
__device__ __forceinline__ void xcd_barrier_complete(unsigned* bar, unsigned x, unsigned& nloc, unsigned& nx) {
    const unsigned G = gridDim.x * gridDim.y * gridDim.z;
    unsigned sum, cnt, mine, sp = 0u;
    for (;;) {
        sum = 0u; cnt = 0u; mine = 0u;
#pragma unroll
        for (unsigned j = 0; j < 16; ++j) { const unsigned c = xb_ld(&bar[XB_XCNT(j)]); sum += c; cnt += (c > 0u) ? 1u : 0u; mine = (j == x) ? c : mine; }
        if (sum == G) break;
        __builtin_amdgcn_s_sleep(1);
        if ((++sp & 255u) == 0u) { if (xb_ld(&bar[XB_TMO])) break; if (sp > XB_SPIN_CAP) { atomicAdd(&bar[XB_TMO], 1u); break; } }
    }
    nloc = mine > 0u ? mine : 1u; nx = cnt > 0u ? cnt : 1u;
}
__device__ __forceinline__ void xcd_barrier(const XcdBarrier& b) {
    asm volatile("s_waitcnt vmcnt(0)" ::: "memory");
    __syncthreads();
    if (threadIdx.x == 0) {
        unsigned* bar = b.bar;
        __builtin_amdgcn_s_waitcnt(0);
        unsigned nloc = b.st[0], nx = b.st[1];
        if (nloc == 0u) { xcd_barrier_complete(bar, b.x, nloc, nx); b.st[0] = nloc; b.st[1] = nx; }
        const unsigned old = xb_add(&bar[XB_XSUB(b.x)], 1u);
        const unsigned gen = old / nloc;
        if (old + 1u == (gen + 1u) * nloc) {
            __builtin_amdgcn_fence(__ATOMIC_RELEASE, "agent");
            asm volatile("s_waitcnt vmcnt(0)" ::: "memory");
            const unsigned og = xb_add(&bar[XB_TOP], 1u);
            const unsigned tg = og / nx;
            if (og + 1u == (tg + 1u) * nx) xb_add(&bar[XB_TOPGEN], 1u);
            else XB_SPIN(xb_ld(&bar[XB_TOPGEN]) == tg, bar);
            __builtin_amdgcn_fence(__ATOMIC_ACQUIRE, "agent");
            xb_add(&bar[XB_XGEN(b.x)], 1u);
            asm volatile("s_waitcnt vmcnt(0)" ::: "memory");
        } else {
            XB_SPIN(xb_ld(&bar[XB_XGEN(b.x)]) == gen, bar);
            __builtin_amdgcn_fence(__ATOMIC_ACQUIRE, "agent");
            asm volatile("s_waitcnt vmcnt(0)" ::: "memory");
        }
    }
    __syncthreads();
}

struct Args {
    const float* in[23]; float* out; unsigned char* ws; int ph_lo, ph_hi;
};
struct Frame {
    LAS unsigned char* lds;
    int tid, lane, wave, G, wg;
    const float *x_prompt, *x_sample, *state_ret, *state_lru, *c, *c_ctx, *norm_w, *w_ada, *b_ada, *w_in, *decay_logit, *gn_w, *w_ret_down,
                *conv_w, *conv_b, *lru_wa, *lru_ba, *lru_wx, *lru_bx, *lru_a, *w_lru_down, *w_out, *final_norm_w;
    float* out; unsigned char* ws;
    bf16 *WinT, *WrdT, *WldT, *WoutT, *WlruT, *H, *Q, *K, *V, *XL, *GL, *HL, *SP, *SIGR, *SIGL, *MERGED, *OG;
    float *MOD, *AGG;
};

__device__ __forceinline__ float wave_sum(float v) {
#pragma unroll
    for (int o = 1; o < 64; o <<= 1) v += __shfl_xor(v, o);
    return v;
}
__device__ __forceinline__ const float* xrow_ptr(const Frame& F, int row) {
    return row < MCTX ? F.x_prompt + (size_t)row * D : F.x_sample + (size_t)(row - MCTX) * D;
}
__device__ __forceinline__ int mod_index(int row) { return row < MCTX ? 0 : 1 + (row - MCTX) / LLAT; }

__device__ __forceinline__ void p0_transpose_item(const float* W, int K, int N, bf16* WT, int drow0, int k0, int n0, LAS float* scr, int lane) {
#pragma unroll 8
    for (int i = 0; i < 32; ++i) { const int kk = 2 * i + (lane >> 5); scr[kk * 33 + (lane & 31)] = W[(size_t)(k0 + kk) * N + n0 + (lane & 31)]; }
    LDS_WAIT(); asm volatile("" ::: "memory");
    const int c = lane & 7;
#pragma unroll
    for (int j = 0; j < 4; ++j) { const int n = (lane >> 3) + 8 * j; const LAS float* s = scr + (8 * c) * 33 + n;
        v4u o; o.x = pk2(s[0 * 33], s[1 * 33]); o.y = pk2(s[2 * 33], s[3 * 33]); o.z = pk2(s[4 * 33], s[5 * 33]); o.w = pk2(s[6 * 33], s[7 * 33]);
        *(v4u*)(WT + (size_t)(drow0 + n) * K + k0 + 8 * c) = o; }
    LDS_WAIT(); asm volatile("" ::: "memory");
}
__device__ __forceinline__ int win_dst_row(int n) { return n < 4096 ? n : (n < 6144 ? n + 2560 : (n < 8704 ? n - 2048 : n)); }

__device__ __forceinline__ void phase_prep(Frame& F) {
    LAS float* scr = (LAS float*)(F.lds + F.wave * 16384);
    const int gw = F.wg * NWAVES + F.wave, NGW = F.G * NWAVES;
    constexpr int I_IN = (D / 64) * (DIN / 32), I_RD = (DRV / 64) * (D / 32), I_LD = (DL / 64) * (D / 32), I_OUT = (D / 64) * (D / 32), I_LRU = 40 * 8, I_MOD = 3072 / 64;
    constexpr int NITEMS = I_MOD + I_IN + I_RD + I_LD + I_OUT + I_LRU;
    for (int it = gw; it < NITEMS; it += NGW) {
        int r = it;
        if (r < I_MOD) {
            const int n = r * 64 + F.lane;
            float acc[5] = {0.f, 0.f, 0.f, 0.f, 0.f};
            for (int k = 0; k < D; ++k) {
                const float w = F.w_ada[(size_t)k * 3072 + n];
                acc[0] += siluf_(F.c_ctx[k]) * w;
#pragma unroll
                for (int v = 0; v < 4; ++v) acc[1 + v] += siluf_(F.c[v * D + k]) * w;
            }
            const float bb = F.b_ada[n];
#pragma unroll
            for (int v = 0; v < 5; ++v) F.MOD[v * 3072 + n] = acc[v] + bb;
            continue;
        }
        r -= I_MOD;
        if (r < I_IN) { const int nblk = DIN / 32, kb = r / nblk, nb = r % nblk; p0_transpose_item(F.w_in, D, DIN, F.WinT, win_dst_row(nb * 32), kb * 64, nb * 32, scr, F.lane); continue; }
        r -= I_IN;
        if (r < I_RD) { const int nblk = D / 32, kb = r / nblk, nb = r % nblk; p0_transpose_item(F.w_ret_down, DRV, D, F.WrdT, nb * 32, kb * 64, nb * 32, scr, F.lane); continue; }
        r -= I_RD;
        if (r < I_LD) { const int nblk = D / 32, kb = r / nblk, nb = r % nblk; p0_transpose_item(F.w_lru_down, DL, D, F.WldT, nb * 32, kb * 64, nb * 32, scr, F.lane); continue; }
        r -= I_LD;
        if (r < I_OUT) { const int nblk = D / 32, kb = r / nblk, nb = r % nblk; p0_transpose_item(F.w_out, D, D, F.WoutT, nb * 32, kb * 64, nb * 32, scr, F.lane); continue; }
        r -= I_OUT;
        {
            const int mi = r / 8, sub = r % 8, slot = mi / NB, hb = mi % NB, kb = sub / 4, nb = sub % 4;
            const float* W = ((slot & 1) ? F.lru_wx : F.lru_wa) + (size_t)((slot >> 1) * NB + hb) * LB * LB;
            p0_transpose_item(W, LB, LB, F.WlruT + (size_t)hb * 512 * LB, slot * 128 + nb * 32, kb * 64, nb * 32, scr, F.lane);
        }
    }
}

__device__ __forceinline__ void phase_h(Frame& F) {
    const int gw = F.wg * NWAVES + F.wave, NGW = F.G * NWAVES;
    for (int m = gw; m < M; m += NGW) {
        const f32x4* xr = (const f32x4*)xrow_ptr(F, m) + F.lane;
        const float* mod = F.MOD + mod_index(m) * 3072;
        f32x4 v[4]; float s = 0.f;
#pragma unroll
        for (int j = 0; j < 4; ++j) { v[j] = xr[64 * j]; s += (v[j].x * v[j].x + v[j].y * v[j].y) + (v[j].z * v[j].z + v[j].w * v[j].w); }
        const float rstd = 1.0f / sqrtf(wave_sum(s) * (1.f / D) + EPS);
        unsigned long long* o8 = (unsigned long long*)(F.H + (size_t)m * D) + F.lane;
#pragma unroll
        for (int j = 0; j < 4; ++j) {
            const int c0 = 4 * F.lane + 256 * j;
            const f32x4 nw = *(const f32x4*)(F.norm_w + c0), sh = *(const f32x4*)(mod + c0), sc = *(const f32x4*)(mod + 1024 + c0);
            const f32x4 h = v[j] * rstd * nw * (sc + 1.0f) + sh;
            o8[64 * j] = (unsigned long long)pk2(h.x, h.y) | ((unsigned long long)pk2(h.z, h.w) << 32);
        }
    }
}

template <class Epi>
__device__ __forceinline__ void gemm_simple(const Frame& F, const bf16* A, int lda, const bf16* Bt, int ldb, int Mr, int Nc, int K, const Epi& epi) {
    const int wr = F.wave >> 2, wc = F.wave & 3, fr = F.lane & 15, fq = F.lane >> 4;
    const int tilesN = Nc / 256, tiles = (Mr / 128) * tilesN;
    for (int t = F.wg; t < tiles; t += F.G) {
        const int tm = t / tilesN, tn = t % tilesN;
        const int row0 = tm * 128 + wr * 64, col0 = tn * 256 + wc * 64;
        f32x4 acc[4][4];
#pragma unroll
        for (int i = 0; i < 4; ++i)
#pragma unroll
            for (int j = 0; j < 4; ++j) acc[i][j] = (f32x4){0.f, 0.f, 0.f, 0.f};
        const bf16* ap = A + (size_t)(row0 + fr) * lda + 8 * fq;
        const bf16* bp = Bt + (size_t)(col0 + fr) * ldb + 8 * fq;
        for (int k0 = 0; k0 < K; k0 += 32) {
            bf16x8 a[4], b[4];
#pragma unroll
            for (int i = 0; i < 4; ++i) a[i] = *(const bf16x8*)(ap + (size_t)(16 * i) * lda + k0);
#pragma unroll
            for (int j = 0; j < 4; ++j) b[j] = *(const bf16x8*)(bp + (size_t)(16 * j) * ldb + k0);
#pragma unroll
            for (int i = 0; i < 4; ++i)
#pragma unroll
                for (int j = 0; j < 4; ++j) acc[i][j] = __builtin_amdgcn_mfma_f32_16x16x32_bf16(a[i], b[j], acc[i][j], 0, 0, 0);
        }
#pragma unroll
        for (int i = 0; i < 4; ++i)
#pragma unroll
            for (int j = 0; j < 4; ++j)
#pragma unroll
                for (int r = 0; r < 4; ++r) epi(row0 + 16 * i + 4 * fq + r, col0 + 16 * j + fr, acc[i][j][r]);
    }
}

struct EpiGemm1 {
    bf16 *Q, *K, *V, *XL, *GL;
    __device__ __forceinline__ void operator()(int row, int col, float v) const {
        if (col < 1024) Q[(size_t)row * 1024 + col] = (bf16)f2bf(v);
        else if (col < 2048) K[(size_t)row * 1024 + col - 1024] = (bf16)f2bf(v * 0.0625f);
        else if (col < 4096) V[(size_t)row * 2048 + col - 2048] = (bf16)f2bf(v);
        else if (col < 5376) XL[(size_t)row * 1280 + col - 4096] = (bf16)f2bf(v);
        else GL[(size_t)row * 1280 + col - 5376] = (bf16)f2bf(siluf_(v));
    }
};
struct EpiGemm2 {
    bf16 *OG, *SIGR, *SIGL;
    __device__ __forceinline__ void operator()(int row, int col, float v) const {
        if (col < 2048) { bf16* p = OG + (size_t)row * 2048 + col; *p = (bf16)f2bf(bf2f(*p) * siluf_(v)); }
        else if (col < 3072) SIGR[(size_t)row * 1024 + col - 2048] = (bf16)f2bf(sigmoidf_(v));
        else SIGL[(size_t)row * 1024 + col - 3072] = (bf16)f2bf(sigmoidf_(v));
    }
};
struct EpiDownR { bf16 *MERGED; const bf16* SIG;
    __device__ __forceinline__ void operator()(int row, int col, float v) const { const size_t o = (size_t)row * 1024 + col; MERGED[o] = (bf16)f2bf(bf2f(SIG[o]) * v); } };
struct EpiDownL { bf16 *MERGED; const bf16* SIG;
    __device__ __forceinline__ void operator()(int row, int col, float v) const { const size_t o = (size_t)row * 1024 + col; MERGED[o] = (bf16)f2bf(bf2f(MERGED[o]) + bf2f(SIG[o]) * v); } };
struct EpiOut { float* Y; const float *xp, *xs, *MOD;
    __device__ __forceinline__ void operator()(int row, int col, float v) const {
        const float xv = row < MCTX ? xp[(size_t)row * D + col] : xs[(size_t)(row - MCTX) * D + col];
        Y[(size_t)row * D + col] = xv + MOD[mod_index(row) * 3072 + 2048 + col] * v;
    } };

__device__ __forceinline__ void lru_item(Frame& F, int T, int hb, bool fin) {
    const int row0 = 64 * T, tid = F.tid;
    int b, seq0, L; bool lat;
    if (row0 < MCTX) { b = row0 / LCTX; seq0 = b * LCTX; L = LCTX; lat = false; } else { b = (row0 - MCTX) / LLAT; seq0 = MCTX + b * LLAT; L = LLAT; lat = true; }
    const int p0 = row0 - seq0, ti = p0 / 64, ntile = L / 64;
    LAS float* xc = (LAS float*)F.lds; LAS float* a_s = xc + 8192; LAS float* b_s = xc + 16384; LAS float* hf_s = xc + 24576;
    for (int idx = tid; idx < 64 * 128; idx += NTHR) {
        const int t = idx >> 7, c = idx & 127, ch = hb * 128 + c;
        float acc = F.conv_b[ch];
#pragma unroll
        for (int tap = 0; tap < 4; ++tap) {
            const int tt = t + tap - 2; bool ok;
            if (lat) ok = (tt >= 0 && tt < 64); else { const int p = p0 + tt; ok = (p >= 0 && p < L); }
            if (ok) acc += F.conv_w[tap * DL + ch] * bf2f(F.XL[(size_t)(row0 + tt) * DL + ch]);
        }
        xc[idx] = acc;
    }
    __syncthreads();
    const int c = tid & 127, tg = tid >> 7, ch = hb * 128 + c;
    const bf16* W = F.WlruT + (size_t)hb * 512 * LB;
#pragma unroll 1
    for (int dir = 0; dir < 2; ++dir) {
        float acc[2][16];
#pragma unroll
        for (int s = 0; s < 2; ++s)
#pragma unroll
            for (int t = 0; t < 16; ++t) acc[s][t] = 0.f;
        const bf16* W0 = W + (size_t)((2 * dir) * 128 + c) * LB; const bf16* W1 = W + (size_t)((2 * dir + 1) * 128 + c) * LB;
#pragma unroll 2
        for (int i = 0; i < 128; ++i) {
            const float w0 = bf2f(W0[i]), w1 = bf2f(W1[i]);
#pragma unroll
            for (int t = 0; t < 16; ++t) { const float xv = bfr(xc[(tg * 16 + t) * 128 + i]); acc[0][t] += xv * w0; acc[1][t] += xv * w1; }
        }
        const float ba = F.lru_ba[dir * DL + ch], bx = F.lru_bx[dir * DL + ch];
        const float sp = log1pf(expf(-F.lru_a[dir * DL + ch]));
#pragma unroll
        for (int t = 0; t < 16; ++t) {
            const int tok = tg * 16 + t;
            const float r = sigmoidf_(acc[0][t] + ba), gi = sigmoidf_(acc[1][t] + bx);
            const float la = -8.0f * r * sp;
            a_s[tok * 128 + c] = expf(la);
            b_s[tok * 128 + c] = sqrtf(-expm1f(2.0f * la)) * gi * xc[tok * 128 + c];
        }
        __syncthreads();
        if (tid < 128) {
            const int cc = tid, chh = hb * 128 + cc;
            float carry = 0.f;
            if (fin) {
                carry = lat ? F.state_lru[(size_t)(b * 2 + dir) * DL + chh] : 0.f;
                if (dir == 0) { for (int n = 0; n < ti; ++n) { const float* ag = F.AGG + ((size_t)((T - ti + n) * 2 + 0) * 2) * DL; carry = ag[chh] * carry + ag[DL + chh]; } }
                else { for (int n = ntile - 1; n > ti; --n) { const float* ag = F.AGG + ((size_t)((T - ti + n) * 2 + 1) * 2) * DL; carry = ag[chh] * carry + ag[DL + chh]; } }
            }
            float h = carry, P = 1.f;
            if (dir == 0) {
                for (int t = 0; t < 64; ++t) { const float a = a_s[t * 128 + cc]; h = a * h + b_s[t * 128 + cc]; P *= a; if (fin) hf_s[t * 128 + cc] = h; }
                if (fin && !lat && ti == ntile - 1) F.out[OUT_NSL + (size_t)(b * 2 + 0) * DL + chh] = h;
            } else {
                for (int t = 63; t >= 0; --t) { const float a = a_s[t * 128 + cc]; h = a * h + b_s[t * 128 + cc]; P *= a; if (fin) hf_s[t * 128 + cc] += h; }
                if (fin && !lat && ti == 0) F.out[OUT_NSL + (size_t)(b * 2 + 1) * DL + chh] = h;
            }
            if (!fin) { float* ag = F.AGG + ((size_t)(T * 2 + dir) * 2) * DL; ag[chh] = P; ag[DL + chh] = h; }
        }
        __syncthreads();
    }
    if (fin) {
        for (int idx = tid; idx < 64 * 128; idx += NTHR) {
            const int t = idx >> 7, cc = idx & 127; const size_t o = (size_t)(row0 + t) * DL + hb * 128 + cc;
            F.HL[o] = (bf16)f2bf(hf_s[idx] * bf2f(F.GL[o]));
        }
    }
    __syncthreads();
}
__device__ __forceinline__ void phase_lru(Frame& F, bool fin) {
    for (int it = F.wg; it < (M / 64) * NB; it += F.G) lru_item(F, it / NB, it % NB, fin);
}

__device__ __forceinline__ float log_gamma(const Frame& F, int dir, int h) { const float x = F.decay_logit[dir * NH + h]; return -log1pf(expf(-x)); }
__device__ __forceinline__ size_t sp_index(int b, int h, int dir, int n) { return ((size_t)(((b * NH + h) * 2 + dir) * NCH_LAT + n)) * (DK * DV); }
__device__ __forceinline__ void phase_r12(Frame& F) {
    const int e = F.tid;
    constexpr int ITEMS = (NCTX + NLAT) * NH * 2 * (DK / 4);
    for (int it = F.wg; it < ITEMS; it += F.G) {
        int r = it; const int dg = r % (DK / 4); r /= (DK / 4); const int dir = r & 1; r >>= 1; const int h = r % NH; const int s = r / NH;
        const bool lat = s >= NCTX; const int b = lat ? s - NCTX : s; const int L = lat ? LLAT : LCTX; const int seq0 = lat ? MCTX + b * LLAT : b * LCTX;
        const float g = expf(log_gamma(F, dir, h));
        float S[4];
#pragma unroll
        for (int u = 0; u < 4; ++u) S[u] = lat ? F.state_ret[((size_t)((b * 2 + dir) * NH + h) * DK + dg * 4 + u) * DV + e] : 0.f;
        const int nch = L / CH;
        for (int nn = 0; nn < nch; ++nn) {
            const int n = dir == 0 ? nn : nch - 1 - nn;
            if (lat) {
#pragma unroll
                for (int u = 0; u < 4; ++u) F.SP[sp_index(b, h, dir, n) + (size_t)(dg * 4 + u) * DV + e] = (bf16)f2bf(S[u]);
            }
            for (int ii = 0; ii < CH; ++ii) {
                const int i = dir == 0 ? ii : CH - 1 - ii; const size_t row = (size_t)seq0 + n * CH + i;
                const float vv = bf2f(F.V[row * DRV + h * DV + e]);
                const unsigned long long kk = *(const unsigned long long*)(F.K + row * DQK + h * DK + dg * 4);
#pragma unroll
                for (int u = 0; u < 4; ++u) S[u] = g * S[u] + bf2f((unsigned short)(kk >> (16 * u))) * vv;
            }
        }
        if (!lat) {
#pragma unroll
            for (int u = 0; u < 4; ++u) F.out[OUT_NSR + ((size_t)((b * 2 + dir) * NH + h) * DK + dg * 4 + u) * DV + e] = S[u];
        }
    }
}

__device__ __forceinline__ void phase_r3(Frame& F) {
    LAS float* qs = (LAS float*)F.lds; LAS float* Ps = qs + 256; LAS float* red = qs + 512;
    const int tid = F.tid;
    for (int it = F.wg; it < M * NH; it += F.G) {
        const int row = it / NH, h = it % NH;
        const bool lat = row >= MCTX; const int b = lat ? (row - MCTX) / LLAT : row / LCTX; const int seq0 = lat ? MCTX + b * LLAT : b * LCTX;
        const int p = row - seq0, n = p / CH, i = p % CH, crow0 = row - i;
        const float lgf = log_gamma(F, 0, h), lgb = log_gamma(F, 1, h);
        if (tid < 256) qs[tid] = bf2f(F.Q[(size_t)row * DQK + h * DK + tid]);
        __syncthreads();
        if (tid < 256) {
            const int j = tid; const bf16* kr = F.K + (size_t)(crow0 + j) * DQK + h * DK; float s = 0.f;
            for (int d = 0; d < DK; d += 8) { const v4u kv = *(const v4u*)(kr + d);
                s += qs[d] * bf2f((unsigned short)kv.x) + qs[d + 1] * bf2f((unsigned short)(kv.x >> 16)) + qs[d + 2] * bf2f((unsigned short)kv.y) + qs[d + 3] * bf2f((unsigned short)(kv.y >> 16))
                   + qs[d + 4] * bf2f((unsigned short)kv.z) + qs[d + 5] * bf2f((unsigned short)(kv.z >> 16)) + qs[d + 6] * bf2f((unsigned short)kv.w) + qs[d + 7] * bf2f((unsigned short)(kv.w >> 16)); }
            const int dj = i - j; const float dec = dj >= 0 ? expf(lgf * (float)dj) : expf(lgb * (float)(-dj));
            Ps[j] = bfr(s * dec);
        }
        __syncthreads();
        const int e = tid; float acc = 0.f;
        for (int j = 0; j < CH; ++j) acc += Ps[j] * bf2f(F.V[(size_t)(crow0 + j) * DRV + h * DV + e]);
        if (lat) {
            const bf16* sf = F.SP + sp_index(b, h, 0, n); const bf16* sb = F.SP + sp_index(b, h, 1, n);
            float af = 0.f, ab = 0.f;
            for (int d = 0; d < DK; ++d) { af += qs[d] * bf2f(sf[(size_t)d * DV + e]); ab += qs[d] * bf2f(sb[(size_t)d * DV + e]); }
            acc += expf(lgf * (float)(i + 1)) * af + expf(lgb * (float)(CH - i)) * ab;
        }
        float ss = wave_sum(acc * acc);
        if (F.lane == 0) red[F.wave] = ss;
        __syncthreads();
        ss = 0.f;
#pragma unroll
        for (int w = 0; w < NWAVES; ++w) ss += red[w];
        const float sc = 1.0f / sqrtf(ss * (1.0f / DV) + EPS);
        F.OG[(size_t)row * DRV + h * DV + e] = (bf16)f2bf(acc * sc * F.gn_w[h * DV + e]);
        __syncthreads();
    }
}

__device__ __forceinline__ void phase_norm(Frame& F) {
    const int gw = F.wg * NWAVES + F.wave, NGW = F.G * NWAVES;
    for (int m = gw; m < M; m += NGW) {
        f32x4* yr = (f32x4*)(F.out + OUT_Y + (size_t)m * D) + F.lane;
        f32x4 v[4]; float s = 0.f;
#pragma unroll
        for (int j = 0; j < 4; ++j) { v[j] = yr[64 * j]; s += (v[j].x * v[j].x + v[j].y * v[j].y) + (v[j].z * v[j].z + v[j].w * v[j].w); }
        const float rstd = 1.0f / sqrtf(wave_sum(s) * (1.f / D) + EPS);
#pragma unroll
        for (int j = 0; j < 4; ++j) { const f32x4 nw = *(const f32x4*)(F.final_norm_w + 4 * F.lane + 256 * j); yr[64 * j] = v[j] * rstd * nw; }
    }
}

constexpr int PH_PREP = 0, PH_H = 1, PH_GEMM1 = 2, PH_LRUA = 3, PH_LRUB = 4, PH_R12 = 5, PH_R3 = 6, PH_G2 = 7, PH_DOWN = 8, PH_OUT = 9, PH_NORM = 10, N_PHASES = 11;

__global__ void __launch_bounds__(NTHR, 2) fwd_kernel(Args args) {
    extern __shared__ __attribute__((aligned(16))) unsigned char lds_raw[];
    Frame F;
    F.lds = (LAS unsigned char*)lds_raw;
    F.tid = threadIdx.x; F.lane = F.tid & 63; F.wave = __builtin_amdgcn_readfirstlane(F.tid >> 6);
    F.G = gridDim.x; F.wg = blockIdx.x;
    F.x_prompt = args.in[0]; F.x_sample = args.in[1]; F.state_ret = args.in[2]; F.state_lru = args.in[3]; F.c = args.in[4]; F.c_ctx = args.in[5];
    F.norm_w = args.in[6]; F.w_ada = args.in[7]; F.b_ada = args.in[8]; F.w_in = args.in[9]; F.decay_logit = args.in[10]; F.gn_w = args.in[11];
    F.w_ret_down = args.in[12]; F.conv_w = args.in[13]; F.conv_b = args.in[14]; F.lru_wa = args.in[15]; F.lru_ba = args.in[16]; F.lru_wx = args.in[17];
    F.lru_bx = args.in[18]; F.lru_a = args.in[19]; F.w_lru_down = args.in[20]; F.w_out = args.in[21]; F.final_norm_w = args.in[22];
    F.out = args.out; F.ws = args.ws;
    unsigned char* ws = args.ws;
    F.WinT = (bf16*)(ws + WS_WINT); F.WrdT = (bf16*)(ws + WS_WRDT); F.WldT = (bf16*)(ws + WS_WLDT); F.WoutT = (bf16*)(ws + WS_WOUTT); F.WlruT = (bf16*)(ws + WS_WLRUT);
    F.MOD = (float*)(ws + WS_MOD); F.H = (bf16*)(ws + WS_H); F.Q = (bf16*)(ws + WS_Q); F.K = (bf16*)(ws + WS_K); F.V = (bf16*)(ws + WS_V);
    F.XL = (bf16*)(ws + WS_XL); F.GL = (bf16*)(ws + WS_GL); F.AGG = (float*)(ws + WS_AGG); F.HL = (bf16*)(ws + WS_HL); F.SP = (bf16*)(ws + WS_SP);
    F.SIGR = (bf16*)(ws + WS_SIGR); F.SIGL = (bf16*)(ws + WS_SIGL); F.MERGED = (bf16*)(ws + WS_MERGED); F.OG = (bf16*)(args.out + OUT_Y);

    volatile LAS unsigned* MISC = (volatile LAS unsigned*)(F.lds + MISC_OFF);
    for (int u = F.tid; u < (LDS_BYTES - 131072) / 4; u += NTHR) ((LAS unsigned*)(F.lds + 131072))[u] = 0u;
    __syncthreads();
    const int lo = args.ph_lo, hi = args.ph_hi;
    XcdBarrier bar; bar.bar = (unsigned*)(ws + WS_CTL) + CW_BAR; bar.x = 0; bar.st = nullptr;
    if (hi - lo > 1) bar = xcd_barrier_post((unsigned*)(ws + WS_CTL) + CW_BAR, MISC + 8);
#define IN(k) (lo <= (k) && (k) < hi)
#define SEAM(k) do { if (IN(k) && IN((k) + 1)) xcd_barrier(bar); } while (0)

    if (IN(PH_PREP)) { phase_prep(F); SEAM(PH_PREP); }
    if (IN(PH_H)) { phase_h(F); SEAM(PH_H); }
    if (IN(PH_GEMM1)) { EpiGemm1 E{F.Q, F.K, F.V, F.XL, F.GL}; gemm_simple(F, F.H, D, F.WinT, D, M, N1, D, E); SEAM(PH_GEMM1); }
    if (IN(PH_LRUA)) { phase_lru(F, false); SEAM(PH_LRUA); }
    if (IN(PH_LRUB)) { phase_lru(F, true); SEAM(PH_LRUB); }
    if (IN(PH_R12)) { phase_r12(F); SEAM(PH_R12); }
    if (IN(PH_R3)) { phase_r3(F); SEAM(PH_R3); }
    if (IN(PH_G2)) { EpiGemm2 E{F.OG, F.SIGR, F.SIGL}; gemm_simple(F, F.H, D, F.WinT + (size_t)N1 * D, D, M, N2, D, E); SEAM(PH_G2); }
    if (IN(PH_DOWN)) {
        { EpiDownR E{F.MERGED, F.SIGR}; gemm_simple(F, F.OG, DRV, F.WrdT, DRV, M, D, DRV, E); }
        { EpiDownL E{F.MERGED, F.SIGL}; gemm_simple(F, F.HL, DL, F.WldT, DL, M, D, DL, E); }
        SEAM(PH_DOWN);
    }
    if (IN(PH_OUT)) { EpiOut E{F.out + OUT_Y, F.x_prompt, F.x_sample, F.MOD}; gemm_simple(F, F.MERGED, D, F.WoutT, D, M, D, D, E); SEAM(PH_OUT); }
    if (IN(PH_NORM)) { phase_norm(F); }
#undef IN
#undef SEAM
}
}

extern "C" void kernel_launch(void* const* d_in, const int* in_sizes, int n_in, void* d_out, int out_size, void* d_ws, size_t ws_size, hipStream_t stream) {
    static int grid = 0;
    if (grid == 0) {
        if (n_in != 23 || (size_t)out_size != OUT_TOTAL || ws_size < WS_END) { fprintf(stderr, "kernel_launch: unexpected shapes n_in %d out %d ws %zu\n", n_in, out_size, ws_size); grid = -1; return; }
        int dev = 0, cus = 0;
        if (hipGetDevice(&dev) != hipSuccess || hipDeviceGetAttribute(&cus, hipDeviceAttributeMultiprocessorCount, dev) != hipSuccess) { grid = -1; return; }
        if (hipFuncSetAttribute((const void*)fwd_kernel, hipFuncAttributeMaxDynamicSharedMemorySize, LDS_BYTES) != hipSuccess) { fprintf(stderr, "kernel_launch: hipFuncSetAttribute failed\n"); grid = -1; return; }
        int per_cu = 0;
        (void)hipOccupancyMaxActiveBlocksPerMultiprocessor(&per_cu, (const void*)fwd_kernel, NTHR, LDS_BYTES);
        (void)hipGetLastError();
        grid = cus;
    }
    if (grid < 0) return;
    (void)hipMemsetAsync((char*)d_ws + WS_CTL, 0, CTL_ZERO_BYTES, stream);
    Args a{};
    for (int i = 0; i < 23; ++i) a.in[i] = (const float*)d_in[i];
    a.out = (float*)d_out; a.ws = (unsigned char*)d_ws;
#if MK_ONE_LAUNCH
    a.ph_lo = 0; a.ph_hi = N_PHASES;
    hipLaunchKernelGGL(fwd_kernel, dim3(grid), dim3(NTHR), LDS_BYTES, stream, a);
#else
    for (int p = 0; p < N_PHASES; ++p) { a.ph_lo = p; a.ph_hi = p + 1; hipLaunchKernelGGL(fwd_kernel, dim3(grid), dim3(NTHR), LDS_BYTES, stream, a); }
#endif
}
```

```cpp
#include <hip/hip_runtime.h>
#include <cstdint>
#include <cstdio>

#ifndef MK_ONE_LAUNCH
#define MK_ONE_LAUNCH 1
#endif

namespace {
constexpr int D = 1024, NCTX = 16, LCTX = 256, NLAT = 4, LLAT = 2048;
constexpr int MCTX = NCTX * LCTX, MLAT = NLAT * LLAT, M = MCTX + MLAT;
constexpr int NH = 4, DK = 256, DV = 512, DQK = NH * DK, DRV = NH * DV;
constexpr int NB = 10, LB = 128, DL = NB * LB;
constexpr int DIN = 10752;
constexpr int N1 = 6656;
constexpr int N2 = 4096;
constexpr int CH = 256;
constexpr int NCH_LAT = LLAT / CH;
constexpr float EPS = 1e-6f;
constexpr int NWAVES = 8, NTHR = 512;

constexpr size_t MiB = 1u << 20;
constexpr size_t WS_CTL = 0, CTL_ZERO_BYTES = 1 * MiB;
constexpr size_t WS_WINT = 1 * MiB;
constexpr size_t WS_WRDT = 22 * MiB;
constexpr size_t WS_WLDT = 26 * MiB;
constexpr size_t WS_WOUTT = 28 * MiB + 512 * 1024;
constexpr size_t WS_WLRUT = 30 * MiB + 512 * 1024;
constexpr size_t WS_MOD = 31 * MiB + 768 * 1024;
constexpr size_t WS_H = 32 * MiB;
constexpr size_t WS_Q = 56 * MiB, WS_K = 80 * MiB, WS_V = 104 * MiB;
constexpr size_t WS_XL = 152 * MiB, WS_GL = 182 * MiB;
constexpr size_t WS_AGG = 216 * MiB;
constexpr size_t WS_HL = 226 * MiB;
constexpr size_t WS_SP = 152 * MiB;
constexpr size_t WS_SIGR = 56 * MiB, WS_SIGL = 80 * MiB;
constexpr size_t WS_MERGED = 104 * MiB;
constexpr size_t WS_END = 256 * MiB;
constexpr size_t OUT_Y = 0;
constexpr size_t OUT_NSR = (size_t)M * D;
constexpr size_t OUT_NSL = OUT_NSR + (size_t)NCTX * 2 * NH * DK * DV;
constexpr size_t OUT_TOTAL = OUT_NSL + (size_t)NCTX * 2 * DL;

constexpr int CW_TMO = 0, CW_CODE = 1, CW_BAR = 4096;
constexpr int LDS_BYTES = 147456;
constexpr int MISC_OFF = 131072 + 320;

#define GAS __attribute__((address_space(1)))
#define LAS __attribute__((address_space(3)))
typedef unsigned short bf16;
typedef unsigned v4u __attribute__((ext_vector_type(4)));
typedef float f32x4 __attribute__((ext_vector_type(4)));
typedef short bf16x8 __attribute__((ext_vector_type(8)));
typedef GAS unsigned gu32;
#define RLX_AGENT __ATOMIC_RELAXED, __HIP_MEMORY_SCOPE_AGENT
#define LDS_WAIT() asm volatile("s_waitcnt lgkmcnt(0)" ::: "memory")
#define VM_WAIT() asm volatile("s_waitcnt vmcnt(0)" ::: "memory")

__device__ __forceinline__ unsigned f2bf(float f) { unsigned u = __builtin_bit_cast(unsigned, f); return (u + 0x7fffu + ((u >> 16) & 1u)) >> 16; }
__device__ __forceinline__ float bf2f(unsigned short b) { return __builtin_bit_cast(float, ((unsigned)b) << 16); }
__device__ __forceinline__ float bfr(float f) { return bf2f((unsigned short)f2bf(f)); }
__device__ __forceinline__ unsigned pk2(float lo, float hi) { return f2bf(lo) | (f2bf(hi) << 16); }
__device__ __forceinline__ float sigmoidf_(float x) { return 1.0f / (1.0f + __expf(-x)); }
__device__ __forceinline__ float siluf_(float x) { return x / (1.0f + __expf(-x)); }

#define XB_TMO      128
#define XB_XCNT(j)  (256  + 64 * (j))
#define XB_XSUB(j)  (1280 + 64 * (j))
#define XB_XGEN(j)  (2304 + 64 * (j))
#define XB_TOP      3328
#define XB_TOPGEN   3392
#define XCD_BAR_WORDS 3456
#define XB_SPIN_CAP (1u << 22)
__device__ __forceinline__ unsigned xb_ld(unsigned* p)              { return __hip_atomic_load(p, __ATOMIC_RELAXED, __HIP_MEMORY_SCOPE_AGENT); }
__device__ __forceinline__ unsigned xb_add(unsigned* p, unsigned v) { return __hip_atomic_fetch_add(p, v, __ATOMIC_RELAXED, __HIP_MEMORY_SCOPE_AGENT); }
__device__ __forceinline__ unsigned xb_xcc_id() { return (unsigned)__builtin_amdgcn_s_getreg((3 << 11) | 20) & 0xFu; }
#define XB_SPIN(cond, bar) do { unsigned _sp = 0; while (cond) { __builtin_amdgcn_s_sleep(1); \
    if ((++_sp & 255u) == 0u) { if (xb_ld(&(bar)[XB_TMO])) break; if (_sp > XB_SPIN_CAP) { atomicAdd(&(bar)[XB_TMO], 1u); break; } } } } while (0)
struct XcdBarrier { unsigned* bar; unsigned x; volatile LAS unsigned* st; };
__device__ __forceinline__ XcdBarrier xcd_barrier_post(unsigned* bar, volatile LAS unsigned* st) {
    XcdBarrier b; b.bar = bar; b.x = xb_xcc_id(); b.st = st;
    if (threadIdx.x == 0) (void)xb_add(&bar[XB_XCNT(b.x)], 1u);
    return b;
}
__device__ __forceinline__ void xcd_barrier_complete(unsigned* bar, unsigned x, unsigned& nloc, unsigned& nx) {
    const unsigned G = gridDim.x * gridDim.y * gridDim.z;
    unsigned sum, cnt, mine, sp = 0u;
    for (;;) {
        sum = 0u; cnt = 0u; mine = 0u;
#pragma unroll
        for (unsigned j = 0; j < 16; ++j) { const unsigned c = xb_ld(&bar[XB_XCNT(j)]); sum += c; cnt += (c > 0u) ? 1u : 0u; mine = (j == x) ? c : mine; }
        if (sum == G) break;
        __builtin_amdgcn_s_sleep(1);
        if ((++sp & 255u) == 0u) { if (xb_ld(&bar[XB_TMO])) break; if (sp > XB_SPIN_CAP) { atomicAdd(&bar[XB_TMO], 1u); break; } }
    }
    nloc = mine > 0u ? mine : 1u; nx = cnt > 0u ? cnt : 1u;
}
__device__ __forceinline__ void xcd_barrier(const XcdBarrier& b) {
    asm volatile("s_waitcnt vmcnt(0)" ::: "memory");
    __syncthreads();
    if (threadIdx.x == 0) {
        unsigned* bar = b.bar;
        __builtin_amdgcn_s_waitcnt(0);
        unsigned nloc = b.st[0], nx = b.st[1];
        if (nloc == 0u) { xcd_barrier_complete(bar, b.x, nloc, nx); b.st[0] = nloc; b.st[1] = nx; }
        const unsigned old = xb_add(&bar[XB_XSUB(b.x)], 1u);
        const unsigned gen = old / nloc;
        if (old + 1u == (gen + 1u) * nloc) {
            __builtin_amdgcn_fence(__ATOMIC_RELEASE, "agent");
            asm volatile("s_waitcnt vmcnt(0)" ::: "memory");
            const unsigned og = xb_add(&bar[XB_TOP], 1u);
            const unsigned tg = og / nx;
            if (og + 1u == (tg + 1u) * nx) xb_add(&bar[XB_TOPGEN], 1u);
            else XB_SPIN(xb_ld(&bar[XB_TOPGEN]) == tg, bar);
            __builtin_amdgcn_fence(__ATOMIC_ACQUIRE, "agent");
            xb_add(&bar[XB_XGEN(b.x)], 1u);
            asm volatile("s_waitcnt vmcnt(0)" ::: "memory");
        } else {
            XB_SPIN(xb_ld(&bar[XB_XGEN(b.x)]) == gen, bar);
            __builtin_amdgcn_fence(__ATOMIC_ACQUIRE, "agent");
            asm volatile("s_waitcnt vmcnt(0)" ::: "memory");
        }
    }
    __syncthreads();
}

struct Args {
    const float* in[23]; float* out; unsigned char* ws; int ph_lo, ph_hi;
};
struct Frame {
    LAS unsigned char* lds;
    int tid, lane, wave, G, wg;
    const float *x_prompt, *x_sample, *state_ret, *state_lru, *c, *c_ctx, *norm_w, *w_ada, *b_ada, *w_in, *decay_logit, *gn_w, *w_ret_down,
                *conv_w, *conv_b, *lru_wa, *lru_ba, *lru_wx, *lru_bx, *lru_a, *w_lru_down, *w_out, *final_norm_w;
    float* out; unsigned char* ws;
    bf16 *WinT, *WrdT, *WldT, *WoutT, *WlruT, *H, *Q, *K, *V, *XL, *GL, *HL, *SP, *SIGR, *SIGL, *MERGED, *OG;
    float *MOD, *AGG;
};

__device__ __forceinline__ float wave_sum(float v) {
#pragma unroll
    for (int o = 1; o < 64; o <<= 1) v += __shfl_xor(v, o);
    return v;
}
__device__ __forceinline__ const float* xrow_ptr(const Frame& F, int row) {
    return row < MCTX ? F.x_prompt + (size_t)row * D : F.x_sample + (size_t)(row - MCTX) * D;
}
__device__ __forceinline__ int mod_index(int row) { return row < MCTX ? 0 : 1 + (row - MCTX) / LLAT; }

__device__ __forceinline__ void p0_transpose_item(const float* W, int K, int N, bf16* WT, int drow0, int k0, int n0, LAS float* scr, int lane) {
#pragma unroll 8
    for (int i = 0; i < 32; ++i) { const int kk = 2 * i + (lane >> 5); scr[kk * 33 + (lane & 31)] = W[(size_t)(k0 + kk) * N + n0 + (lane & 31)]; }
    LDS_WAIT(); asm volatile("" ::: "memory");
    const int c = lane & 7;
#pragma unroll
    for (int j = 0; j < 4; ++j) { const int n = (lane >> 3) + 8 * j; const LAS float* s = scr + (8 * c) * 33 + n;
        v4u o; o.x = pk2(s[0 * 33], s[1 * 33]); o.y = pk2(s[2 * 33], s[3 * 33]); o.z = pk2(s[4 * 33], s[5 * 33]); o.w = pk2(s[6 * 33], s[7 * 33]);
        *(v4u*)(WT + (size_t)(drow0 + n) * K + k0 + 8 * c) = o; }
    LDS_WAIT(); asm volatile("" ::: "memory");
}
__device__ __forceinline__ int win_dst_row(int n) { return n < 4096 ? n : (n < 6144 ? n + 2560 : (n < 8704 ? n - 2048 : n)); }

__device__ __forceinline__ void phase_prep(Frame& F) {
    LAS float* scr = (LAS float*)(F.lds + F.wave * 16384);
    const int gw = F.wg * NWAVES + F.wave, NGW = F.G * NWAVES;
    constexpr int I_IN = (D / 64) * (DIN / 32), I_RD = (DRV / 64) * (D / 32), I_LD = (DL / 64) * (D / 32), I_OUT = (D / 64) * (D / 32), I_LRU = 40 * 8, I_MOD = 3072 / 64;
    constexpr int NITEMS = I_MOD + I_IN + I_RD + I_LD + I_OUT + I_LRU;
    for (int it = gw; it < NITEMS; it += NGW) {
        int r = it;
        if (r < I_MOD) {
            const int n = r * 64 + F.lane;
            float acc[5] = {0.f, 0.f, 0.f, 0.f, 0.f};
            for (int k = 0; k < D; ++k) {
                const float w = F.w_ada[(size_t)k * 3072 + n];
                acc[0] += siluf_(F.c_ctx[k]) * w;
#pragma unroll
                for (int v = 0; v < 4; ++v) acc[1 + v] += siluf_(F.c[v * D + k]) * w;
            }
            const float bb = F.b_ada[n];
#pragma unroll
            for (int v = 0; v < 5; ++v) F.MOD[v * 3072 + n] = acc[v] + bb;
            continue;
        }
        r -= I_MOD;
        if (r < I_IN) { const int nblk = DIN / 32, kb = r / nblk, nb = r % nblk; p0_transpose_item(F.w_in, D, DIN, F.WinT, win_dst_row(nb * 32), kb * 64, nb * 32, scr, F.lane); continue; }
        r -= I_IN;
        if (r < I_RD) { const int nblk = D / 32, kb = r / nblk, nb = r % nblk; p0_transpose_item(F.w_ret_down, DRV, D, F.WrdT, nb * 32, kb * 64, nb * 32, scr, F.lane); continue; }
        r -= I_RD;
        if (r < I_LD) { const int nblk = D / 32, kb = r / nblk, nb = r % nblk; p0_transpose_item(F.w_lru_down, DL, D, F.WldT, nb * 32, kb * 64, nb * 32, scr, F.lane); continue; }
        r -= I_LD;
        if (r < I_OUT) { const int nblk = D / 32, kb = r / nblk, nb = r % nblk; p0_transpose_item(F.w_out, D, D, F.WoutT, nb * 32, kb * 64, nb * 32, scr, F.lane); continue; }
        r -= I_OUT;
        {
            const int mi = r / 8, sub = r % 8, slot = mi / NB, hb = mi % NB, kb = sub / 4, nb = sub % 4;
            const float* W = ((slot & 1) ? F.lru_wx : F.lru_wa) + (size_t)((slot >> 1) * NB + hb) * LB * LB;
            p0_transpose_item(W, LB, LB, F.WlruT + (size_t)hb * 512 * LB, slot * 128 + nb * 32, kb * 64, nb * 32, scr, F.lane);
        }
    }
}

__device__ __forceinline__ void phase_h(Frame& F) {
    const int gw = F.wg * NWAVES + F.wave, NGW = F.G * NWAVES;
    for (int m = gw; m < M; m += NGW) {
        const f32x4* xr = (const f32x4*)xrow_ptr(F, m) + F.lane;
        const float* mod = F.MOD + mod_index(m) * 3072;
        f32x4 v[4]; float s = 0.f;
#pragma unroll
        for (int j = 0; j < 4; ++j) { v[j] = xr[64 * j]; s += (v[j].x * v[j].x + v[j].y * v[j].y) + (v[j].z * v[j].z + v[j].w * v[j].w); }
        const float rstd = 1.0f / sqrtf(wave_sum(s) * (1.f / D) + EPS);
        unsigned long long* o8 = (unsigned long long*)(F.H + (size_t)m * D) + F.lane;
#pragma unroll
        for (int j = 0; j < 4; ++j) {
            const int c0 = 4 * F.lane + 256 * j;
            const f32x4 nw = *(const f32x4*)(F.norm_w + c0), sh = *(const f32x4*)(mod + c0), sc = *(const f32x4*)(mod + 1024 + c0);
            const f32x4 h = v[j] * rstd * nw * (sc + 1.0f) + sh;
            o8[64 * j] = (unsigned long long)pk2(h.x, h.y) | ((unsigned long long)pk2(h.z, h.w) << 32);
        }
    }
}

template <class Epi>
__device__ __forceinline__ void gemm_simple(const Frame& F, const bf16* A, int lda, const bf16* Bt, int ldb, int Mr, int Nc, int K, const Epi& epi) {
    const int wr = F.wave >> 2, wc = F.wave & 3, fr = F.lane & 15, fq = F.lane >> 4;
    const int tilesN = Nc / 256, tiles = (Mr / 128) * tilesN;
    for (int t = F.wg; t < tiles; t += F.G) {
        const int tm = t / tilesN, tn = t % tilesN;
        const int row0 = tm * 128 + wr * 64, col0 = tn * 256 + wc * 64;
        f32x4 acc[4][4];
#pragma unroll
        for (int i = 0; i < 4; ++i)
#pragma unroll
            for (int j = 0; j < 4; ++j) acc[i][j] = (f32x4){0.f, 0.f, 0.f, 0.f};
        const bf16* ap = A + (size_t)(row0 + fr) * lda + 8 * fq;
        const bf16* bp = Bt + (size_t)(col0 + fr) * ldb + 8 * fq;
        for (int k0 = 0; k0 < K; k0 += 32) {
            bf16x8 a[4], b[4];
#pragma unroll
            for (int i = 0; i < 4; ++i) a[i] = *(const bf16x8*)(ap + (size_t)(16 * i) * lda + k0);
#pragma unroll
            for (int j = 0; j < 4; ++j) b[j] = *(const bf16x8*)(bp + (size_t)(16 * j) * ldb + k0);
#pragma unroll
            for (int i = 0; i < 4; ++i)
#pragma unroll
                for (int j = 0; j < 4; ++j) acc[i][j] = __builtin_amdgcn_mfma_f32_16x16x32_bf16(a[i], b[j], acc[i][j], 0, 0, 0);
        }
#pragma unroll
        for (int i = 0; i < 4; ++i)
#pragma unroll
            for (int j = 0; j < 4; ++j)
#pragma unroll
                for (int r = 0; r < 4; ++r) epi(row0 + 16 * i + 4 * fq + r, col0 + 16 * j + fr, acc[i][j][r]);
    }
}

struct EpiGemm1 {
    bf16 *Q, *K, *V, *XL, *GL;
    __device__ __forceinline__ void operator()(int row, int col, float v) const {
        if (col < 1024) Q[(size_t)row * 1024 + col] = (bf16)f2bf(v);
        else if (col < 2048) K[(size_t)row * 1024 + col - 1024] = (bf16)f2bf(v * 0.0625f);
        else if (col < 4096) V[(size_t)row * 2048 + col - 2048] = (bf16)f2bf(v);
        else if (col < 5376) XL[(size_t)row * 1280 + col - 4096] = (bf16)f2bf(v);
        else GL[(size_t)row * 1280 + col - 5376] = (bf16)f2bf(siluf_(v));
    }
};
struct EpiGemm2 {
    bf16 *OG, *SIGR, *SIGL;
    __device__ __forceinline__ void operator()(int row, int col, float v) const {
        if (col < 2048) { bf16* p = OG + (size_t)row * 2048 + col; *p = (bf16)f2bf(bf2f(*p) * siluf_(v)); }
        else if (col < 3072) SIGR[(size_t)row * 1024 + col - 2048] = (bf16)f2bf(sigmoidf_(v));
        else SIGL[(size_t)row * 1024 + col - 3072] = (bf16)f2bf(sigmoidf_(v));
    }
};
struct EpiDownR { bf16 *MERGED; const bf16* SIG;
    __device__ __forceinline__ void operator()(int row, int col, float v) const { const size_t o = (size_t)row * 1024 + col; MERGED[o] = (bf16)f2bf(bf2f(SIG[o]) * v); } };
struct EpiDownL { bf16 *MERGED; const bf16* SIG;
    __device__ __forceinline__ void operator()(int row, int col, float v) const { const size_t o = (size_t)row * 1024 + col; MERGED[o] = (bf16)f2bf(bf2f(MERGED[o]) + bf2f(SIG[o]) * v); } };
struct EpiOut { float* Y; const float *xp, *xs, *MOD;
    __device__ __forceinline__ void operator()(int row, int col, float v) const {
        const float xv = row < MCTX ? xp[(size_t)row * D + col] : xs[(size_t)(row - MCTX) * D + col];
        Y[(size_t)row * D + col] = xv + MOD[mod_index(row) * 3072 + 2048 + col] * v;
    } };

__device__ __forceinline__ void lru_item(Frame& F, int T, int hb, bool fin) {
    const int row0 = 64 * T, tid = F.tid;
    int b, seq0, L; bool lat;
    if (row0 < MCTX) { b = row0 / LCTX; seq0 = b * LCTX; L = LCTX; lat = false; } else { b = (row0 - MCTX) / LLAT; seq0 = MCTX + b * LLAT; L = LLAT; lat = true; }
    const int p0 = row0 - seq0, ti = p0 / 64, ntile = L / 64;
    LAS float* xc = (LAS float*)F.lds; LAS float* a_s = xc + 8192; LAS float* b_s = xc + 16384; LAS float* hf_s = xc + 24576;
    for (int idx = tid; idx < 64 * 128; idx += NTHR) {
        const int t = idx >> 7, c = idx & 127, ch = hb * 128 + c;
        float acc = F.conv_b[ch];
#pragma unroll
        for (int tap = 0; tap < 4; ++tap) {
            const int tt = t + tap - 2; bool ok;
            if (lat) ok = (tt >= 0 && tt < 64); else { const int p = p0 + tt; ok = (p >= 0 && p < L); }
            if (ok) acc += F.conv_w[tap * DL + ch] * bf2f(F.XL[(size_t)(row0 + tt) * DL + ch]);
        }
        xc[idx] = acc;
    }
    __syncthreads();
    const int c = tid & 127, tg = tid >> 7, ch = hb * 128 + c;
    const bf16* W = F.WlruT + (size_t)hb * 512 * LB;
#pragma unroll 1
    for (int dir = 0; dir < 2; ++dir) {
        float acc[2][16];
#pragma unroll
        for (int s = 0; s < 2; ++s)
#pragma unroll
            for (int t = 0; t < 16; ++t) acc[s][t] = 0.f;
        const bf16* W0 = W + (size_t)((2 * dir) * 128 + c) * LB; const bf16* W1 = W + (size_t)((2 * dir + 1) * 128 + c) * LB;
#pragma unroll 2
        for (int i = 0; i < 128; ++i) {
            const float w0 = bf2f(W0[i]), w1 = bf2f(W1[i]);
#pragma unroll
            for (int t = 0; t < 16; ++t) { const float xv = bfr(xc[(tg * 16 + t) * 128 + i]); acc[0][t] += xv * w0; acc[1][t] += xv * w1; }
        }
        const float ba = F.lru_ba[dir * DL + ch], bx = F.lru_bx[dir * DL + ch];
        const float sp = log1pf(expf(-F.lru_a[dir * DL + ch]));
#pragma unroll
        for (int t = 0; t < 16; ++t) {
            const int tok = tg * 16 + t;
            const float r = sigmoidf_(acc[0][t] + ba), gi = sigmoidf_(acc[1][t] + bx);
            const float la = -8.0f * r * sp;
            a_s[tok * 128 + c] = expf(la);
            b_s[tok * 128 + c] = sqrtf(-expm1f(2.0f * la)) * gi * xc[tok * 128 + c];
        }
        __syncthreads();
        if (tid < 128) {
            const int cc = tid, chh = hb * 128 + cc;
            float carry = 0.f;
            if (fin) {
                carry = lat ? F.state_lru[(size_t)(b * 2 + dir) * DL + chh] : 0.f;
                if (dir == 0) { for (int n = 0; n < ti; ++n) { const float* ag = F.AGG + ((size_t)((T - ti + n) * 2 + 0) * 2) * DL; carry = ag[chh] * carry + ag[DL + chh]; } }
                else { for (int n = ntile - 1; n > ti; --n) { const float* ag = F.AGG + ((size_t)((T - ti + n) * 2 + 1) * 2) * DL; carry = ag[chh] * carry + ag[DL + chh]; } }
            }
            float h = carry, P = 1.f;
            if (dir == 0) {
                for (int t = 0; t < 64; ++t) { const float a = a_s[t * 128 + cc]; h = a * h + b_s[t * 128 + cc]; P *= a; if (fin) hf_s[t * 128 + cc] = h; }
                if (fin && !lat && ti == ntile - 1) F.out[OUT_NSL + (size_t)(b * 2 + 0) * DL + chh] = h;
            } else {
                for (int t = 63; t >= 0; --t) { const float a = a_s[t * 128 + cc]; h = a * h + b_s[t * 128 + cc]; P *= a; if (fin) hf_s[t * 128 + cc] += h; }
                if (fin && !lat && ti == 0) F.out[OUT_NSL + (size_t)(b * 2 + 1) * DL + chh] = h;
            }
            if (!fin) { float* ag = F.AGG + ((size_t)(T * 2 + dir) * 2) * DL; ag[chh] = P; ag[DL + chh] = h; }
        }
        __syncthreads();
    }
    if (fin) {
        for (int idx = tid; idx < 64 * 128; idx += NTHR) {
            const int t = idx >> 7, cc = idx & 127; const size_t o = (size_t)(row0 + t) * DL + hb * 128 + cc;
            F.HL[o] = (bf16)f2bf(hf_s[idx] * bf2f(F.GL[o]));
        }
    }
    __syncthreads();
}
__device__ __forceinline__ void phase_lru(Frame& F, bool fin) {
    for (int it = F.wg; it < (M / 64) * NB; it += F.G) lru_item(F, it / NB, it % NB, fin);
}

__device__ __forceinline__ float log_gamma(const Frame& F, int dir, int h) { const float x = F.decay_logit[dir * NH + h]; return -log1pf(expf(-x)); }
__device__ __forceinline__ size_t sp_index(int b, int h, int dir, int n) { return ((size_t)(((b * NH + h) * 2 + dir) * NCH_LAT + n)) * (DK * DV); }
__device__ __forceinline__ void phase_r12(Frame& F) {
    const int e = F.tid;
    constexpr int ITEMS = (NCTX + NLAT) * NH * 2 * (DK / 4);
    for (int it = F.wg; it < ITEMS; it += F.G) {
        int r = it; const int dg = r % (DK / 4); r /= (DK / 4); const int dir = r & 1; r >>= 1; const int h = r % NH; const int s = r / NH;
        const bool lat = s >= NCTX; const int b = lat ? s - NCTX : s; const int L = lat ? LLAT : LCTX; const int seq0 = lat ? MCTX + b * LLAT : b * LCTX;
        const float g = expf(log_gamma(F, dir, h));
        float S[4];
#pragma unroll
        for (int u = 0; u < 4; ++u) S[u] = lat ? F.state_ret[((size_t)((b * 2 + dir) * NH + h) * DK + dg * 4 + u) * DV + e] : 0.f;
        const int nch = L / CH;
        for (int nn = 0; nn < nch; ++nn) {
            const int n = dir == 0 ? nn : nch - 1 - nn;
            if (lat) {
#pragma unroll
                for (int u = 0; u < 4; ++u) F.SP[sp_index(b, h, dir, n) + (size_t)(dg * 4 + u) * DV + e] = (bf16)f2bf(S[u]);
            }
            for (int ii = 0; ii < CH; ++ii) {
                const int i = dir == 0 ? ii : CH - 1 - ii; const size_t row = (size_t)seq0 + n * CH + i;
                const float vv = bf2f(F.V[row * DRV + h * DV + e]);
                const unsigned long long kk = *(const unsigned long long*)(F.K + row * DQK + h * DK + dg * 4);
#pragma unroll
                for (int u = 0; u < 4; ++u) S[u] = g * S[u] + bf2f((unsigned short)(kk >> (16 * u))) * vv;
            }
        }
        if (!lat) {
#pragma unroll
            for (int u = 0; u < 4; ++u) F.out[OUT_NSR + ((size_t)((b * 2 + dir) * NH + h) * DK + dg * 4 + u) * DV + e] = S[u];
        }
    }
}

__device__ __forceinline__ void phase_r3(Frame& F) {
    LAS float* qs = (LAS float*)F.lds; LAS float* Ps = qs + 256; LAS float* red = qs + 512;
    const int tid = F.tid;
    for (int it = F.wg; it < M * NH; it += F.G) {
        const int row = it / NH, h = it % NH;
        const bool lat = row >= MCTX; const int b = lat ? (row - MCTX) / LLAT : row / LCTX; const int seq0 = lat ? MCTX + b * LLAT : b * LCTX;
        const int p = row - seq0, n = p / CH, i = p % CH, crow0 = row - i;
        const float lgf = log_gamma(F, 0, h), lgb = log_gamma(F, 1, h);
        if (tid < 256) qs[tid] = bf2f(F.Q[(size_t)row * DQK + h * DK + tid]);
        __syncthreads();
        if (tid < 256) {
            const int j = tid; const bf16* kr = F.K + (size_t)(crow0 + j) * DQK + h * DK; float s = 0.f;
            for (int d = 0; d < DK; d += 8) { const v4u kv = *(const v4u*)(kr + d);
                s += qs[d] * bf2f((unsigned short)kv.x) + qs[d + 1] * bf2f((unsigned short)(kv.x >> 16)) + qs[d + 2] * bf2f((unsigned short)kv.y) + qs[d + 3] * bf2f((unsigned short)(kv.y >> 16))
                   + qs[d + 4] * bf2f((unsigned short)kv.z) + qs[d + 5] * bf2f((unsigned short)(kv.z >> 16)) + qs[d + 6] * bf2f((unsigned short)kv.w) + qs[d + 7] * bf2f((unsigned short)(kv.w >> 16)); }
            const int dj = i - j; const float dec = dj >= 0 ? expf(lgf * (float)dj) : expf(lgb * (float)(-dj));
            Ps[j] = bfr(s * dec);
        }
        __syncthreads();
        const int e = tid; float acc = 0.f;
        for (int j = 0; j < CH; ++j) acc += Ps[j] * bf2f(F.V[(size_t)(crow0 + j) * DRV + h * DV + e]);
        if (lat) {
            const bf16* sf = F.SP + sp_index(b, h, 0, n); const bf16* sb = F.SP + sp_index(b, h, 1, n);
            float af = 0.f, ab = 0.f;
            for (int d = 0; d < DK; ++d) { af += qs[d] * bf2f(sf[(size_t)d * DV + e]); ab += qs[d] * bf2f(sb[(size_t)d * DV + e]); }
            acc += expf(lgf * (float)(i + 1)) * af + expf(lgb * (float)(CH - i)) * ab;
        }
        float ss = wave_sum(acc * acc);
        if (F.lane == 0) red[F.wave] = ss;
        __syncthreads();
        ss = 0.f;
#pragma unroll
        for (int w = 0; w < NWAVES; ++w) ss += red[w];
        const float sc = 1.0f / sqrtf(ss * (1.0f / DV) + EPS);
        F.OG[(size_t)row * DRV + h * DV + e] = (bf16)f2bf(acc * sc * F.gn_w[h * DV + e]);
        __syncthreads();
    }
}

__device__ __forceinline__ void phase_norm(Frame& F) {
    const int gw = F.wg * NWAVES + F.wave, NGW = F.G * NWAVES;
    for (int m = gw; m < M; m += NGW) {
        f32x4* yr = (f32x4*)(F.out + OUT_Y + (size_t)m * D) + F.lane;
        f32x4 v[4]; float s = 0.f;
#pragma unroll
        for (int j = 0; j < 4; ++j) { v[j] = yr[64 * j]; s += (v[j].x * v[j].x + v[j].y * v[j].y) + (v[j].z * v[j].z + v[j].w * v[j].w); }
        const float rstd = 1.0f / sqrtf(wave_sum(s) * (1.f / D) + EPS);
#pragma unroll
        for (int j = 0; j < 4; ++j) { const f32x4 nw = *(const f32x4*)(F.final_norm_w + 4 * F.lane + 256 * j); yr[64 * j] = v[j] * rstd * nw; }
    }
}

constexpr int PH_PREP = 0, PH_H = 1, PH_GEMM1 = 2, PH_LRUA = 3, PH_LRUB = 4, PH_R12 = 5, PH_R3 = 6, PH_G2 = 7, PH_DOWN = 8, PH_OUT = 9, PH_NORM = 10, N_PHASES = 11;

__global__ void __launch_bounds__(NTHR, 2) fwd_kernel(Args args) {
    extern __shared__ __attribute__((aligned(16))) unsigned char lds_raw[];
    Frame F;
    F.lds = (LAS unsigned char*)lds_raw;
    F.tid = threadIdx.x; F.lane = F.tid & 63; F.wave = __builtin_amdgcn_readfirstlane(F.tid >> 6);
    F.G = gridDim.x; F.wg = blockIdx.x;
    F.x_prompt = args.in[0]; F.x_sample = args.in[1]; F.state_ret = args.in[2]; F.state_lru = args.in[3]; F.c = args.in[4]; F.c_ctx = args.in[5];
    F.norm_w = args.in[6]; F.w_ada = args.in[7]; F.b_ada = args.in[8]; F.w_in = args.in[9]; F.decay_logit = args.in[10]; F.gn_w = args.in[11];
    F.w_ret_down = args.in[12]; F.conv_w = args.in[13]; F.conv_b = args.in[14]; F.lru_wa = args.in[15]; F.lru_ba = args.in[16]; F.lru_wx = args.in[17];
    F.lru_bx = args.in[18]; F.lru_a = args.in[19]; F.w_lru_down = args.in[20]; F.w_out = args.in[21]; F.final_norm_w = args.in[22];
    F.out = args.out; F.ws = args.ws;
    unsigned char* ws = args.ws;
    F.WinT = (bf16*)(ws + WS_WINT); F.WrdT = (bf16*)(ws + WS_WRDT); F.WldT = (bf16*)(ws + WS_WLDT); F.WoutT = (bf16*)(ws + WS_WOUTT); F.WlruT = (bf16*)(ws + WS_WLRUT);
    F.MOD = (float*)(ws + WS_MOD); F.H = (bf16*)(ws + WS_H); F.Q = (bf16*)(ws + WS_Q); F.K = (bf16*)(ws + WS_K); F.V = (bf16*)(ws + WS_V);
    F.XL = (bf16*)(ws + WS_XL); F.GL = (bf16*)(ws + WS_GL); F.AGG = (float*)(ws + WS_AGG); F.HL = (bf16*)(ws + WS_HL); F.SP = (bf16*)(ws + WS_SP);
    F.SIGR = (bf16*)(ws + WS_SIGR); F.SIGL = (bf16*)(ws + WS_SIGL); F.MERGED = (bf16*)(ws + WS_MERGED); F.OG = (bf16*)(args.out + OUT_Y);

    volatile LAS unsigned* MISC = (volatile LAS unsigned*)(F.lds + MISC_OFF);
    for (int u = F.tid; u < (LDS_BYTES - 131072) / 4; u += NTHR) ((LAS unsigned*)(F.lds + 131072))[u] = 0u;
    __syncthreads();
    const int lo = args.ph_lo, hi = args.ph_hi;
    XcdBarrier bar; bar.bar = (unsigned*)(ws + WS_CTL) + CW_BAR; bar.x = 0; bar.st = nullptr;
    if (hi - lo > 1) bar = xcd_barrier_post((unsigned*)(ws + WS_CTL) + CW_BAR, MISC + 8);
#define IN(k) (lo <= (k) && (k) < hi)
#define SEAM(k) do { if (IN(k) && IN((k) + 1)) xcd_barrier(bar); } while (0)

    if (IN(PH_PREP)) { phase_prep(F); SEAM(PH_PREP); }
    if (IN(PH_H)) { phase_h(F); SEAM(PH_H); }
    if (IN(PH_GEMM1)) { EpiGemm1 E{F.Q, F.K, F.V, F.XL, F.GL}; gemm_simple(F, F.H, D, F.WinT, D, M, N1, D, E); SEAM(PH_GEMM1); }
    if (IN(PH_LRUA)) { phase_lru(F, false); SEAM(PH_LRUA); }
    if (IN(PH_LRUB)) { phase_lru(F, true); SEAM(PH_LRUB); }
    if (IN(PH_R12)) { phase_r12(F); SEAM(PH_R12); }
    if (IN(PH_R3)) { phase_r3(F); SEAM(PH_R3); }
    if (IN(PH_G2)) { EpiGemm2 E{F.OG, F.SIGR, F.SIGL}; gemm_simple(F, F.H, D, F.WinT + (size_t)N1 * D, D, M, N2, D, E); SEAM(PH_G2); }
    if (IN(PH_DOWN)) {
        { EpiDownR E{F.MERGED, F.SIGR}; gemm_simple(F, F.OG, DRV, F.WrdT, DRV, M, D, DRV, E); }
        { EpiDownL E{F.MERGED, F.SIGL}; gemm_simple(F, F.HL, DL, F.WldT, DL, M, D, DL, E); }
        SEAM(PH_DOWN);
    }
    if (IN(PH_OUT)) { EpiOut E{F.out + OUT_Y, F.x_prompt, F.x_sample, F.MOD}; gemm_simple(F, F.MERGED, D, F.WoutT, D, M, D, D, E); SEAM(PH_OUT); }
    if (IN(PH_NORM)) { phase_norm(F); }
#undef IN
#undef SEAM
}
}

extern "C" void kernel_launch(void* const* d_in, const int* in_sizes, int n_in, void* d_out, int out_size, void* d_ws, size_t ws_size, hipStream_t stream) {
    static int grid = 0;
    if (grid == 0) {
        if (n_in != 23 || (size_t)out_size != OUT_TOTAL || ws_size < WS_END) { fprintf(stderr, "kernel_launch: unexpected shapes n_in %d out %d ws %zu\n", n_in, out_size, ws_size); grid = -1; return; }
        int dev = 0, cus = 0;
        if (hipGetDevice(&dev) != hipSuccess || hipDeviceGetAttribute(&cus, hipDeviceAttributeMultiprocessorCount, dev) != hipSuccess) { grid = -1; return; }
        if (hipFuncSetAttribute((const void*)fwd_kernel, hipFuncAttributeMaxDynamicSharedMemorySize, LDS_BYTES) != hipSuccess) { fprintf(stderr, "kernel_launch: hipFuncSetAttribute failed\n"); grid = -1; return; }
        int per_cu = 0;
        (void)hipOccupancyMaxActiveBlocksPerMultiprocessor(&per_cu, (const void*)fwd_kernel, NTHR, LDS_BYTES);
        (void)hipGetLastError();
        grid = cus;
    }
    if (grid < 0) return;
    (void)hipMemsetAsync((char*)d_ws + WS_CTL, 0, CTL_ZERO_BYTES, stream);
    Args a{};
    for (int i = 0; i < 23; ++i) a.in[i] = (const float*)d_in[i];
    a.out = (float*)d_out; a.ws = (unsigned char*)d_ws;
#if MK_ONE_LAUNCH
    a.ph_lo = 0; a.ph_hi = N_PHASES;
    hipLaunchKernelGGL(fwd_kernel, dim3(grid), dim3(NTHR), LDS_BYTES, stream, a);
#else
    for (int p = 0; p < N_PHASES; ++p) { a.ph_lo = p; a.ph_hi = p + 1; hipLaunchKernelGGL(fwd_kernel, dim3(grid), dim3(NTHR), LDS_BYTES, stream, a); }
#endif
}
```

```cpp
#include <hip/hip_runtime.h>
#include <cstdint>
#include <cstdio>

#ifndef MK_ONE_LAUNCH
#define MK_ONE_LAUNCH 1
#endif

namespace {
constexpr int D = 1024, NCTX = 16, LCTX = 256, NLAT = 4, LLAT = 2048;
constexpr int MCTX = NCTX * LCTX, MLAT = NLAT * LLAT, M = MCTX + MLAT;
constexpr int NH = 4, DK = 256, DV = 512, DQK = NH * DK, DRV = NH * DV;
constexpr int NB = 10, LB = 128, DL = NB * LB;
constexpr int DIN = 10752;
constexpr int N1 = 6656;
constexpr int N2 = 4096;
constexpr int CH = 256;
constexpr int NCH_LAT = LLAT / CH;
constexpr float EPS = 1e-6f;
constexpr int NWAVES = 8, NTHR = 512;

constexpr size_t MiB = 1u << 20;
constexpr size_t WS_CTL = 0, CTL_ZERO_BYTES = 1 * MiB;
constexpr size_t WS_WINT = 1 * MiB;
constexpr size_t WS_WRDT = 22 * MiB;
constexpr size_t WS_WLDT = 26 * MiB;
constexpr size_t WS_WOUTT = 28 * MiB + 512 * 1024;
constexpr size_t WS_WLRUT = 30 * MiB + 512 * 1024;
constexpr size_t WS_MOD = 31 * MiB + 768 * 1024;
constexpr size_t WS_H = 32 * MiB;
constexpr size_t WS_Q = 56 * MiB, WS_K = 80 * MiB, WS_V = 104 * MiB;
constexpr size_t WS_XL = 152 * MiB, WS_GL = 182 * MiB;
constexpr size_t WS_AGG = 216 * MiB;
constexpr size_t WS_HL = 226 * MiB;
constexpr size_t WS_SP = 152 * MiB;
constexpr size_t WS_SIGR = 56 * MiB, WS_SIGL = 80 * MiB;
constexpr size_t WS_MERGED = 104 * MiB;
constexpr size_t WS_END = 256 * MiB;
constexpr size_t OUT_Y = 0;
constexpr size_t OUT_NSR = (size_t)M * D;
constexpr size_t OUT_NSL = OUT_NSR + (size_t)NCTX * 2 * NH * DK * DV;
constexpr size_t OUT_TOTAL = OUT_NSL + (size_t)NCTX * 2 * DL;

constexpr int CW_TMO = 0, CW_CODE = 1, CW_BAR = 4096;
constexpr int LDS_BYTES = 147456;
constexpr int MISC_OFF = 131072 + 320;

#define GAS __attribute__((address_space(1)))
#define LAS __attribute__((address_space(3)))
typedef unsigned short bf16;
typedef unsigned v4u __attribute__((ext_vector_type(4)));
typedef float f32x4 __attribute__((ext_vector_type(4)));
typedef short bf16x8 __attribute__((ext_vector_type(8)));
typedef GAS unsigned gu32;
#define RLX_AGENT __ATOMIC_RELAXED, __HIP_MEMORY_SCOPE_AGENT
#define LDS_WAIT() asm volatile("s_waitcnt lgkmcnt(0)" ::: "memory")
#define VM_WAIT() asm volatile("s_waitcnt vmcnt(0)" ::: "memory")

__device__ __forceinline__ unsigned f2bf(float f) { unsigned u = __builtin_bit_cast(unsigned, f); return (u + 0x7fffu + ((u >> 16) & 1u)) >> 16; }
__device__ __forceinline__ float bf2f(unsigned short b) { return __builtin_bit_cast(float, ((unsigned)b) << 16); }
__device__ __forceinline__ float bfr(float f) { return bf2f((unsigned short)f2bf(f)); }
__device__ __forceinline__ unsigned pk2(float lo, float hi) { return f2bf(lo) | (f2bf(hi) << 16); }
__device__ __forceinline__ float sigmoidf_(float x) { return 1.0f / (1.0f + __expf(-x)); }
__device__ __forceinline__ float siluf_(float x) { return x / (1.0f + __expf(-x)); }

#define XB_TMO      128
#define XB_XCNT(j)  (256  + 64 * (j))
#define XB_XSUB(j)  (1280 + 64 * (j))
#define XB_XGEN(j)  (2304 + 64 * (j))
#define XB_TOP      3328
#define XB_TOPGEN   3392
#define XCD_BAR_WORDS 3456
#define XB_SPIN_CAP (1u << 22)
__device__ __forceinline__ unsigned xb_ld(unsigned* p)              { return __hip_atomic_load(p, __ATOMIC_RELAXED, __HIP_MEMORY_SCOPE_AGENT); }
__device__ __forceinline__ unsigned xb_add(unsigned* p, unsigned v) { return __hip_atomic_fetch_add(p, v, __ATOMIC_RELAXED, __HIP_MEMORY_SCOPE_AGENT); }
__device__ __forceinline__ unsigned xb_xcc_id() { return (unsigned)__builtin_amdgcn_s_getreg((3 << 11) | 20) & 0xFu; }
#define XB_SPIN(cond, bar) do { unsigned _sp = 0; while (cond) { __builtin_amdgcn_s_sleep(1); \
    if ((++_sp & 255u) == 0u) { if (xb_ld(&(bar)[XB_TMO])) break; if (_sp > XB_SPIN_CAP) { atomicAdd(&(bar)[XB_TMO], 1u); break; } } } } while (0)
struct XcdBarrier { unsigned* bar; unsigned x; volatile LAS unsigned* st; };
__device__ __forceinline__ XcdBarrier xcd_barrier_post(unsigned* bar, volatile LAS unsigned* st) {
    XcdBarrier b; b.bar = bar; b.x = xb_xcc_id(); b.st = st;
    if (threadIdx.x == 0) (void)xb_add(&bar[XB_XCNT(b.x)], 1u);
    return b;
}
__device__ __forceinline__ void xcd_barrier_complete(unsigned* bar, unsigned x, unsigned& nloc, unsigned& nx) {
    const unsigned G = gridDim.x * gridDim.y * gridDim.z;
    unsigned sum, cnt, mine, sp = 0u;
    for (;;) {
        sum = 0u; cnt = 0u; mine = 0u;
#pragma unroll
        for (unsigned j = 0; j < 16; ++j) { const unsigned c = xb_ld(&bar[XB_XCNT(j)]); sum += c; cnt += (c > 0u) ? 1u : 0u; mine = (j == x) ? c : mine; }
        if (sum == G) break;
        __builtin_amdgcn_s_sleep(1);
        if ((++sp & 255u) == 0u) { if (xb_ld(&bar[XB_TMO])) break; if (sp > XB_SPIN_CAP) { atomicAdd(&bar[XB_TMO], 1u); break; } }
    }
    nloc = mine > 0u ? mine : 1u; nx = cnt > 0u ? cnt : 1u;
}
__device__ __forceinline__ void xcd_barrier(const XcdBarrier& b) {
    asm volatile("s_waitcnt vmcnt(0)" ::: "memory");
    __syncthreads();
    if (threadIdx.x == 0) {
        unsigned* bar = b.bar;
        __builtin_amdgcn_s_waitcnt(0);
        unsigned nloc = b.st[0], nx = b.st[1];
        if (nloc == 0u) { xcd_barrier_complete(bar, b.x, nloc, nx); b.st[0] = nloc; b.st[1] = nx; }
        const unsigned old = xb_add(&bar[XB_XSUB(b.x)], 1u);
        const unsigned gen = old / nloc;
        if (old + 1u == (gen + 1u) * nloc) {
            __builtin_amdgcn_fence(__ATOMIC_RELEASE, "agent");
            asm volatile("s_waitcnt vmcnt(0)" ::: "memory");
            const unsigned og = xb_add(&bar[XB_TOP], 1u);
            const unsigned tg = og / nx;
            if (og + 1u == (tg + 1u) * nx) xb_add(&bar[XB_TOPGEN], 1u);
            else XB_SPIN(xb_ld(&bar[XB_TOPGEN]) == tg, bar);
            __builtin_amdgcn_fence(__ATOMIC_ACQUIRE, "agent");
            xb_add(&bar[XB_XGEN(b.x)], 1u);
            asm volatile("s_waitcnt vmcnt(0)" ::: "memory");
        } else {
            XB_SPIN(xb_ld(&bar[XB_XGEN(b.x)]) == gen, bar);
            __builtin_amdgcn_fence(__ATOMIC_ACQUIRE, "agent");
            asm volatile("s_waitcnt vmcnt(0)" ::: "memory");
        }
    }
    __syncthreads();
}

namespace pg8 {
#define PG8_LAS __attribute__((address_space(3)))
typedef unsigned short bf16_t;
typedef short bf16x8 __attribute__((ext_vector_type(8)));
typedef float f32x4 __attribute__((ext_vector_type(4)));
typedef unsigned u32x4 __attribute__((ext_vector_type(4)));
constexpr int BM = 256, BK = 64, HALF = 128, HTB = HALF * BK * 2  , STAGE_BYTES = 8 * HTB, NXCD = 8, WGM = 8;

__host__ __device__ __forceinline__ int lds_byte(int r, int c) { const int st = (r >> 4) * 2 + (c >> 5), rr = r & 15, cc = c & 31, ob = rr * 64 + cc * 2; return st * 1024 + (ob ^ (((ob >> 9) & 1) << 5)); }
__host__ __device__ __forceinline__ void stage_rc(int b, int& R, int& C) { const int st = b / 1024, sb = b % 1024, swz = sb ^ (((sb >> 9) & 1) << 5); R = (st >> 1) * 16 + swz / 64; C = (st & 1) * 32 + (swz % 64) / 2; }
__host__ __device__ __forceinline__ int perm32(int rho) { const int n = rho >> 4, i = rho & 15; return 8 * (i >> 2) + 4 * n + (i & 3); }

struct Unit { int pm, pn; };
struct Gemm { const bf16_t* A; const bf16_t* Bt; int M, N, K; };

struct StaticOrder {
    int nM, nN, nwg, G, c;
    __host__ __device__ void init(int M, int N, int G_, int c_) { nM = M / BM; nN = N / BM; nwg = nM * nN; G = G_; c = c_; }
    __host__ __device__ bool next(int i, Unit& u) const {
        const long L = (long)i * G + c; if (L >= nwg) return false;
        int wgid = (int)L; { const int q = nwg / NXCD, r = nwg % NXCD, xcd = wgid % NXCD, off = wgid / NXCD; wgid = (xcd < r ? xcd * (q + 1) : r * (q + 1) + (xcd - r) * q) + off; }
        const int nig = WGM * nN, gid = wgid / nig, fm = gid * WGM, gsz = (nM - fm) < WGM ? (nM - fm) : WGM;
        u.pm = fm + ((wgid % nig) % gsz); u.pn = (wgid % nig) / gsz; return true;
    }
    __device__ __forceinline__ void a_ready(const Unit&) const {}
    __device__ __forceinline__ void done(const Unit&) const {}
};

__device__ __forceinline__ unsigned cvt_pk_bf16(float lo, float hi) { unsigned r; asm volatile("v_cvt_pk_bf16_f32 %0, %1, %2" : "=v"(r) : "v"(lo), "v"(hi)); return r; }

typedef float f32x2 __attribute__((ext_vector_type(2)));
__device__ __forceinline__ float pg_silu(float x) { return x * __builtin_amdgcn_rcpf(1.0f + __expf(-x)); }
__device__ __forceinline__ float pg_sigm(float x) { return __builtin_amdgcn_rcpf(1.0f + __expf(-x)); }
__device__ __forceinline__ float pg_lo(unsigned w) { return __builtin_bit_cast(float, w << 16); }
__device__ __forceinline__ float pg_hi(unsigned w) { return __builtin_bit_cast(float, w & 0xffff0000u); }
struct EpiG1 {
    static constexpr bool PERM = true, AFTER_DRAIN = false;
    bf16_t *Q, *K, *V, *XL, *GL;
    __device__ __forceinline__ void operator()(const f32x4 (&acc)[2][2][4][2], const Unit& u, int wr, int wc, int fr, int fq) const {
        const int row0 = u.pm * BM + wr * 64 + fr; int colt = u.pn * BM; bf16_t* base; int ldc; float sc = 1.f; bool act = false;
        if (colt < 1024) { base = Q; ldc = 1024; } else if (colt < 2048) { base = K; ldc = 1024; colt -= 1024; sc = 0.0625f; }
        else if (colt < 4096) { base = V; ldc = 2048; colt -= 2048; } else if (colt < 5376) { base = XL; ldc = 1280; colt -= 4096; } else { base = GL; ldc = 1280; colt -= 5376; act = true; }
        const int col0 = colt + wc * 32 + 8 * fq;
#pragma unroll
        for (int ai = 0; ai < 2; ++ai)
#pragma unroll
            for (int m = 0; m < 4; ++m) { bf16_t* rowp = base + (size_t)(row0 + ai * HALF + m * 16) * ldc + col0;
#pragma unroll
                for (int bj = 0; bj < 2; ++bj) { f32x4 v0 = acc[ai][bj][m][0], v1 = acc[ai][bj][m][1];
                    if (act) {
#pragma unroll
                        for (int j = 0; j < 4; ++j) { v0[j] = pg_silu(v0[j]); v1[j] = pg_silu(v1[j]); } }
                    v0 = v0 * sc; v1 = v1 * sc; u32x4 w; w.x = cvt_pk_bf16(v0[0], v0[1]); w.y = cvt_pk_bf16(v0[2], v0[3]); w.z = cvt_pk_bf16(v1[0], v1[1]); w.w = cvt_pk_bf16(v1[2], v1[3]);
                    *(u32x4*)(rowp + bj * HALF) = w; } }
    }
};
struct EpiG2 {
    static constexpr bool PERM = true, AFTER_DRAIN = false;
    bf16_t *OG, *SIGR, *SIGL;
    __device__ __forceinline__ void operator()(const f32x4 (&acc)[2][2][4][2], const Unit& u, int wr, int wc, int fr, int fq) const {
        const int row0 = u.pm * BM + wr * 64 + fr; int colt = u.pn * BM; bf16_t* base; int ldc; bool mul = false;
        if (colt < 2048) { base = OG; ldc = 2048; mul = true; } else if (colt < 3072) { base = SIGR; ldc = 1024; colt -= 2048; } else { base = SIGL; ldc = 1024; colt -= 3072; }
        const int col0 = colt + wc * 32 + 8 * fq;
#pragma unroll
        for (int ai = 0; ai < 2; ++ai)
#pragma unroll
            for (int m = 0; m < 4; ++m) { bf16_t* rowp = base + (size_t)(row0 + ai * HALF + m * 16) * ldc + col0;
#pragma unroll
                for (int bj = 0; bj < 2; ++bj) { f32x4 v0 = acc[ai][bj][m][0], v1 = acc[ai][bj][m][1];
                    if (mul) { const u32x4 o = *(const u32x4*)(rowp + bj * HALF);
                        v0[0] = pg_silu(v0[0]) * pg_lo(o.x); v0[1] = pg_silu(v0[1]) * pg_hi(o.x); v0[2] = pg_silu(v0[2]) * pg_lo(o.y); v0[3] = pg_silu(v0[3]) * pg_hi(o.y);
                        v1[0] = pg_silu(v1[0]) * pg_lo(o.z); v1[1] = pg_silu(v1[1]) * pg_hi(o.z); v1[2] = pg_silu(v1[2]) * pg_lo(o.w); v1[3] = pg_silu(v1[3]) * pg_hi(o.w);
                    } else {
#pragma unroll
                        for (int j = 0; j < 4; ++j) { v0[j] = pg_sigm(v0[j]); v1[j] = pg_sigm(v1[j]); } }
                    u32x4 w; w.x = cvt_pk_bf16(v0[0], v0[1]); w.y = cvt_pk_bf16(v0[2], v0[3]); w.z = cvt_pk_bf16(v1[0], v1[1]); w.w = cvt_pk_bf16(v1[2], v1[3]);
                    *(u32x4*)(rowp + bj * HALF) = w; } }
    }
};
template <bool ADD> struct EpiDown {
    static constexpr bool PERM = true, AFTER_DRAIN = false;
    bf16_t* MERGED; const bf16_t* SIG;
    __device__ __forceinline__ void operator()(const f32x4 (&acc)[2][2][4][2], const Unit& u, int wr, int wc, int fr, int fq) const {
        const int row0 = u.pm * BM + wr * 64 + fr, col0 = u.pn * BM + wc * 32 + 8 * fq;
#pragma unroll
        for (int ai = 0; ai < 2; ++ai)
#pragma unroll
            for (int m = 0; m < 4; ++m) { const size_t off = (size_t)(row0 + ai * HALF + m * 16) * 1024 + col0;
#pragma unroll
                for (int bj = 0; bj < 2; ++bj) { f32x4 v0 = acc[ai][bj][m][0], v1 = acc[ai][bj][m][1];
                    const u32x4 g = *(const u32x4*)(SIG + off + bj * HALF);
                    v0[0] *= pg_lo(g.x); v0[1] *= pg_hi(g.x); v0[2] *= pg_lo(g.y); v0[3] *= pg_hi(g.y); v1[0] *= pg_lo(g.z); v1[1] *= pg_hi(g.z); v1[2] *= pg_lo(g.w); v1[3] *= pg_hi(g.w);
                    if (ADD) { const u32x4 o = *(const u32x4*)(MERGED + off + bj * HALF);
                        v0[0] += pg_lo(o.x); v0[1] += pg_hi(o.x); v0[2] += pg_lo(o.y); v0[3] += pg_hi(o.y); v1[0] += pg_lo(o.z); v1[1] += pg_hi(o.z); v1[2] += pg_lo(o.w); v1[3] += pg_hi(o.w); }
                    u32x4 w; w.x = cvt_pk_bf16(v0[0], v0[1]); w.y = cvt_pk_bf16(v0[2], v0[3]); w.z = cvt_pk_bf16(v1[0], v1[1]); w.w = cvt_pk_bf16(v1[2], v1[3]);
                    *(u32x4*)(MERGED + off + bj * HALF) = w; } }
    }
};
struct EpiY {
    static constexpr bool PERM = false, AFTER_DRAIN = false;
    float* Y; const float *xp, *xs, *MOD; int mctx, llat;
    __device__ __forceinline__ void operator()(const f32x4 (&acc)[2][2][4][2], const Unit& u, int wr, int wc, int fr, int fq) const {
        const int row0 = u.pm * BM + wr * 64 + fr, col0 = u.pn * BM + wc * 32 + 4 * fq;
        const int rbase = u.pm * BM;
        const float* gate = MOD + (rbase < mctx ? 0 : 1 + (rbase - mctx) / llat) * 3072 + 2048;
        f32x4 gv[2][2];
#pragma unroll
        for (int bj = 0; bj < 2; ++bj)
#pragma unroll
            for (int n = 0; n < 2; ++n) gv[bj][n] = *(const f32x4*)(gate + col0 + bj * HALF + n * 16);
#pragma unroll
        for (int ai = 0; ai < 2; ++ai)
#pragma unroll
            for (int m = 0; m < 4; ++m) { const int r = row0 + ai * HALF + m * 16; const float* xr = (r < mctx ? xp + (size_t)r * 1024 : xs + (size_t)(r - mctx) * 1024) + col0; float* yr = Y + (size_t)r * 1024 + col0;
#pragma unroll
                for (int bj = 0; bj < 2; ++bj)
#pragma unroll
                    for (int n = 0; n < 2; ++n) { const f32x4 xv = *(const f32x4*)(xr + bj * HALF + n * 16); *(f32x4*)(yr + bj * HALF + n * 16) = xv + gv[bj][n] * acc[ai][bj][m][n]; } }
    }
};

template <class Epi, class Sched, bool ALIGN_EPI = false, bool SP2 = false>
__device__ __forceinline__ void gemm_phase(PG8_LAS unsigned char* lds, const Gemm g, const Sched& S, const Epi& E) {
    const int tid = threadIdx.x, wid = __builtin_amdgcn_readfirstlane(tid >> 6), lane = tid & 63, wr = wid >> 2, wc = wid & 3, fr = lane & 15, fq = lane >> 4;
    const int K = g.K, nt = K / BK;
    unsigned voffA[2], voffB[2];
#pragma unroll
    for (int i = 0; i < 2; ++i) { int R, C; stage_rc(tid * 16 + i * 8192, R, C); const int Rb = Epi::PERM ? ((R & ~31) + perm32(R & 31)) : R;
        voffA[i] = (unsigned)(R * K + C) * 2u; voffB[i] = (unsigned)(Rb * K + C) * 2u; }
    const size_t kstep = (size_t)(BK * 2);
    const size_t hstep = (size_t)HALF * K * 2;
    const size_t tstep = 2 * hstep;
    const unsigned ldsw = (unsigned)wid * 1024u;
    const int aoff = lds_byte(wr * 64 + fr, fq * 8), boff = lds_byte(wc * 32 + fr, fq * 8);
#define PG8_SA(b, h) (((b) * 2 + (h)) * HTB)
#define PG8_SB(b, h) ((4 + (b) * 2 + (h)) * HTB)
#define PG8_STAGE(bufoff, gbase, voff) do { _Pragma("unroll") for (int _i = 0; _i < 2; ++_i) \
        __builtin_amdgcn_global_load_lds((const unsigned*)((const char*)(gbase) + (voff)[_i]), (PG8_LAS unsigned*)(lds + (bufoff) + ldsw + _i * 8192), 16, 0, 0); } while (0)
#define PG8_LDA(dst, b, h) do { _Pragma("unroll") for (int m = 0; m < 4; ++m) _Pragma("unroll") for (int k = 0; k < 2; ++k) dst[m][k] = *(const PG8_LAS bf16x8*)(lds + PG8_SA(b, h) + aoff + m * 2048 + k * 1024); } while (0)
#define PG8_LDB(dst, b, h) do { _Pragma("unroll") for (int n = 0; n < 2; ++n) _Pragma("unroll") for (int k = 0; k < 2; ++k) dst[n][k] = *(const PG8_LAS bf16x8*)(lds + PG8_SB(b, h) + boff + n * 2048 + k * 1024); } while (0)
#define PG8_MMA(ai, bj, At, Bt) do { __builtin_amdgcn_s_setprio(1); _Pragma("unroll") for (int m = 0; m < 4; ++m) _Pragma("unroll") for (int n = 0; n < 2; ++n) _Pragma("unroll") for (int k = 0; k < 2; ++k) \
        acc[ai][bj][m][n] = __builtin_amdgcn_mfma_f32_16x16x32_bf16(Bt[n][k], At[m][k], acc[ai][bj][m][n], 0, 0, 0); __builtin_amdgcn_s_setprio(0); } while (0)
#define PG8_WAIT_V(n) asm volatile("s_waitcnt vmcnt(" #n ")" ::: "memory")
#define PG8_WAIT_L(n) asm volatile("s_waitcnt lgkmcnt(" #n ")" ::: "memory")
#define PG8_BAR __builtin_amdgcn_s_barrier()
#define PG8_SCHED __builtin_amdgcn_sched_barrier(0)
    Unit cur, nxt; int ui = 0;
    if (!S.next(0, cur)) return;
    f32x4 acc[2][2][4][2];
#pragma unroll
    for (int a = 0; a < 2; ++a)
#pragma unroll
        for (int b = 0; b < 2; ++b)
#pragma unroll
            for (int m = 0; m < 4; ++m)
#pragma unroll
                for (int n = 0; n < 2; ++n) acc[a][b][m][n] = (f32x4){0.f, 0.f, 0.f, 0.f};
    bf16x8 At[4][2], B0[2][2], B1[2][2];
    const char* cA = (const char*)g.A + (size_t)cur.pm * tstep; const char* cB = (const char*)g.Bt + (size_t)cur.pn * tstep;
    S.a_ready(cur);
    if constexpr (SP2) {
        PG8_STAGE(PG8_SB(0, 0), cB, voffB); PG8_STAGE(PG8_SB(0, 1), cB + hstep, voffB); PG8_STAGE(PG8_SA(0, 0), cA, voffA); PG8_STAGE(PG8_SA(0, 1), cA + hstep, voffA);
        if (wr == 1) PG8_BAR;
        PG8_WAIT_V(2); PG8_BAR;
        PG8_STAGE(PG8_SB(1, 0), cB + kstep, voffB); PG8_STAGE(PG8_SA(1, 0), cA + kstep, voffA); PG8_STAGE(PG8_SB(1, 1), cB + hstep + kstep, voffB);
        PG8_WAIT_V(6); PG8_BAR;
    } else {
        PG8_STAGE(PG8_SB(0, 0), cB, voffB); PG8_STAGE(PG8_SA(0, 0), cA, voffA); PG8_STAGE(PG8_SB(0, 1), cB + hstep, voffB); PG8_STAGE(PG8_SA(0, 1), cA + hstep, voffA);
        if (wr == 1) PG8_BAR;
        PG8_WAIT_V(4); PG8_BAR;
        PG8_STAGE(PG8_SB(1, 0), cB + kstep, voffB); PG8_STAGE(PG8_SA(1, 0), cA + kstep, voffA); PG8_STAGE(PG8_SB(1, 1), cB + hstep + kstep, voffB);
        PG8_WAIT_V(6); PG8_BAR;
    }
    for (;;) {
        const bool has_next = S.next(ui + 1, nxt);
        const char* nA = has_next ? (const char*)g.A + (size_t)nxt.pm * tstep : cA; const char* nB = has_next ? (const char*)g.Bt + (size_t)nxt.pn * tstep : cB;
        for (int t = 0; t < nt; t += 2) {
            const bool last = (t == nt - 2);
            const char* a1 = cA + (size_t)(t + 1) * kstep;
            const char* a2 = last ? nA : cA + (size_t)(t + 2) * kstep; const char* b2 = last ? nB : cB + (size_t)(t + 2) * kstep;
            const char* a3 = a2 + kstep; const char* b3 = b2 + kstep;
            if (last && has_next) S.a_ready(nxt);
            if constexpr (SP2) {
            PG8_LDB(B0, 0, 0); PG8_LDB(B1, 0, 1); PG8_SCHED; PG8_LDA(At, 0, 0); PG8_STAGE(PG8_SA(1, 1), a1 + hstep, voffA);
            PG8_WAIT_V(8); PG8_WAIT_L(0); PG8_BAR; PG8_MMA(0, 0, At, B0); PG8_MMA(0, 1, At, B1); PG8_BAR; PG8_SCHED;
            PG8_LDA(At, 0, 1); PG8_STAGE(PG8_SB(0, 0), b2, voffB); PG8_STAGE(PG8_SB(0, 1), b2 + hstep, voffB); PG8_STAGE(PG8_SA(0, 0), a2, voffA);
            PG8_WAIT_V(8); PG8_WAIT_L(0); PG8_BAR; PG8_MMA(1, 0, At, B0); PG8_MMA(1, 1, At, B1); PG8_BAR; PG8_SCHED;
            PG8_LDB(B0, 1, 0); PG8_LDB(B1, 1, 1); PG8_SCHED; PG8_LDA(At, 1, 0); PG8_STAGE(PG8_SA(0, 1), a2 + hstep, voffA);
            PG8_WAIT_V(8); PG8_WAIT_L(0); PG8_BAR; PG8_MMA(0, 0, At, B0); PG8_MMA(0, 1, At, B1); PG8_BAR; PG8_SCHED;
            PG8_LDA(At, 1, 1); PG8_STAGE(PG8_SB(1, 0), b3, voffB); PG8_STAGE(PG8_SB(1, 1), b3 + hstep, voffB); PG8_STAGE(PG8_SA(1, 0), a3, voffA);
            PG8_WAIT_V(8); PG8_WAIT_L(0); PG8_BAR; PG8_MMA(1, 0, At, B0); PG8_MMA(1, 1, At, B1); PG8_BAR; PG8_SCHED;
            } else {
            PG8_LDB(B0, 0, 0); PG8_SCHED; PG8_LDA(At, 0, 0); PG8_STAGE(PG8_SA(1, 1), a1 + hstep, voffA);
            PG8_WAIT_L(8); PG8_BAR; PG8_WAIT_L(0); PG8_MMA(0, 0, At, B0); PG8_BAR; PG8_SCHED;
            PG8_LDB(B1, 0, 1); PG8_STAGE(PG8_SB(0, 0), b2, voffB);
            PG8_BAR; PG8_WAIT_L(0); PG8_MMA(0, 1, At, B1); PG8_BAR;
            PG8_LDA(At, 0, 1); PG8_STAGE(PG8_SA(0, 0), a2, voffA);
            PG8_BAR; PG8_WAIT_L(0); PG8_MMA(1, 0, At, B0); PG8_BAR; PG8_SCHED;
            PG8_STAGE(PG8_SB(0, 1), b2 + hstep, voffB);
            PG8_WAIT_V(6); PG8_BAR; PG8_MMA(1, 1, At, B1); PG8_BAR;
            PG8_LDB(B0, 1, 0); PG8_SCHED; PG8_LDA(At, 1, 0); PG8_STAGE(PG8_SA(0, 1), a2 + hstep, voffA);
            PG8_WAIT_L(8); PG8_BAR; PG8_WAIT_L(0); PG8_MMA(0, 0, At, B0); PG8_BAR; PG8_SCHED;
            PG8_LDB(B1, 1, 1); PG8_STAGE(PG8_SB(1, 0), b3, voffB);
            PG8_BAR; PG8_WAIT_L(0); PG8_MMA(0, 1, At, B1); PG8_BAR;
            PG8_LDA(At, 1, 1); PG8_STAGE(PG8_SA(1, 0), a3, voffA);
            PG8_BAR; PG8_WAIT_L(0); PG8_MMA(1, 0, At, B0); PG8_BAR; PG8_SCHED;
            PG8_STAGE(PG8_SB(1, 1), b3 + hstep, voffB);
            PG8_WAIT_V(6); PG8_BAR; PG8_MMA(1, 1, At, B1); PG8_BAR;
            }
        }
        if constexpr (ALIGN_EPI) { if (wr == 0) PG8_BAR; }
        if constexpr (!Epi::AFTER_DRAIN) { E(acc, cur, wr, wc, fr, fq); S.done(cur); }
        if (!has_next) break;
#pragma unroll
        for (int a = 0; a < 2; ++a)
#pragma unroll
            for (int b = 0; b < 2; ++b)
#pragma unroll
                for (int m = 0; m < 4; ++m)
#pragma unroll
                    for (int n = 0; n < 2; ++n) acc[a][b][m][n] = (f32x4){0.f, 0.f, 0.f, 0.f};
        cur = nxt; cA = nA; cB = nB; ++ui;
        if constexpr (ALIGN_EPI) { if (wr == 1) PG8_BAR; }
    }
    PG8_WAIT_V(0);
    if constexpr (!ALIGN_EPI) { if (wr == 0) PG8_BAR; }
    PG8_BAR;
    if constexpr (Epi::AFTER_DRAIN) { E.fused(acc, cur, wr, wc, fr, fq, lds, wid, lane); S.done(cur); }
#undef PG8_SA
#undef PG8_SB
#undef PG8_STAGE
#undef PG8_LDA
#undef PG8_LDB
#undef PG8_MMA
#undef PG8_WAIT_V
#undef PG8_WAIT_L
#undef PG8_BAR
#undef PG8_SCHED
}
}

struct Args {
    const float* in[23]; float* out; unsigned char* ws; int ph_lo, ph_hi;
};
struct Frame {
    LAS unsigned char* lds;
    int tid, lane, wave, G, wg;
    const float *x_prompt, *x_sample, *state_ret, *state_lru, *c, *c_ctx, *norm_w, *w_ada, *b_ada, *w_in, *decay_logit, *gn_w, *w_ret_down,
                *conv_w, *conv_b, *lru_wa, *lru_ba, *lru_wx, *lru_bx, *lru_a, *w_lru_down, *w_out, *final_norm_w;
    float* out; unsigned char* ws;
    bf16 *WinT, *WrdT, *WldT, *WoutT, *WlruT, *H, *Q, *K, *V, *XL, *GL, *HL, *SP, *SIGR, *SIGL, *MERGED, *OG;
    float *MOD, *AGG;
};

__device__ __forceinline__ float wave_sum(float v) {
#pragma unroll
    for (int o = 1; o < 64; o <<= 1) v += __shfl_xor(v, o);
    return v;
}
__device__ __forceinline__ const float* xrow_ptr(const Frame& F, int row) {
    return row < MCTX ? F.x_prompt + (size_t)row * D : F.x_sample + (size_t)(row - MCTX) * D;
}
__device__ __forceinline__ int mod_index(int row) { return row < MCTX ? 0 : 1 + (row - MCTX) / LLAT; }

__device__ __forceinline__ void p0_transpose_item(const float* W, int K, int N, bf16* WT, int drow0, int k0, int n0, LAS float* scr, int lane) {
#pragma unroll 8
    for (int i = 0; i < 32; ++i) { const int kk = 2 * i + (lane >> 5); scr[kk * 33 + (lane & 31)] = W[(size_t)(k0 + kk) * N + n0 + (lane & 31)]; }
    LDS_WAIT(); asm volatile("" ::: "memory");
    const int c = lane & 7;
#pragma unroll
    for (int j = 0; j < 4; ++j) { const int n = (lane >> 3) + 8 * j; const LAS float* s = scr + (8 * c) * 33 + n;
        v4u o; o.x = pk2(s[0 * 33], s[1 * 33]); o.y = pk2(s[2 * 33], s[3 * 33]); o.z = pk2(s[4 * 33], s[5 * 33]); o.w = pk2(s[6 * 33], s[7 * 33]);
        *(v4u*)(WT + (size_t)(drow0 + n) * K + k0 + 8 * c) = o; }
    LDS_WAIT(); asm volatile("" ::: "memory");
}
__device__ __forceinline__ int win_dst_row(int n) { return n < 4096 ? n : (n < 6144 ? n + 2560 : (n < 8704 ? n - 2048 : n)); }

__device__ __forceinline__ void phase_prep(Frame& F) {
    LAS float* scr = (LAS float*)(F.lds + F.wave * 16384);
    const int gw = F.wg * NWAVES + F.wave, NGW = F.G * NWAVES;
    constexpr int I_IN = (D / 64) * (DIN / 32), I_RD = (DRV / 64) * (D / 32), I_LD = (DL / 64) * (D / 32), I_OUT = (D / 64) * (D / 32), I_LRU = 40 * 8, I_MOD = 3072 / 64;
    constexpr int NITEMS = I_MOD + I_IN + I_RD + I_LD + I_OUT + I_LRU;
    for (int it = gw; it < NITEMS; it += NGW) {
        int r = it;
        if (r < I_MOD) {
            const int n = r * 64 + F.lane;
            float acc[5] = {0.f, 0.f, 0.f, 0.f, 0.f};
            for (int k = 0; k < D; ++k) {
                const float w = F.w_ada[(size_t)k * 3072 + n];
                acc[0] += siluf_(F.c_ctx[k]) * w;
#pragma unroll
                for (int v = 0; v < 4; ++v) acc[1 + v] += siluf_(F.c[v * D + k]) * w;
            }
            const float bb = F.b_ada[n];
#pragma unroll
            for (int v = 0; v < 5; ++v) F.MOD[v * 3072 + n] = acc[v] + bb;
            continue;
        }
        r -= I_MOD;
        if (r < I_IN) { const int nblk = DIN / 32, kb = r / nblk, nb = r % nblk; p0_transpose_item(F.w_in, D, DIN, F.WinT, win_dst_row(nb * 32), kb * 64, nb * 32, scr, F.lane); continue; }
        r -= I_IN;
        if (r < I_RD) { const int nblk = D / 32, kb = r / nblk, nb = r % nblk; p0_transpose_item(F.w_ret_down, DRV, D, F.WrdT, nb * 32, kb * 64, nb * 32, scr, F.lane); continue; }
        r -= I_RD;
        if (r < I_LD) { const int nblk = D / 32, kb = r / nblk, nb = r % nblk; p0_transpose_item(F.w_lru_down, DL, D, F.WldT, nb * 32, kb * 64, nb * 32, scr, F.lane); continue; }
        r -= I_LD;
        if (r < I_OUT) { const int nblk = D / 32, kb = r / nblk, nb = r % nblk; p0_transpose_item(F.w_out, D, D, F.WoutT, nb * 32, kb * 64, nb * 32, scr, F.lane); continue; }
        r -= I_OUT;
        {
            const int mi = r / 8, sub = r % 8, slot = mi / NB, hb = mi % NB, kb = sub / 4, nb = sub % 4;
            const float* W = ((slot & 1) ? F.lru_wx : F.lru_wa) + (size_t)((slot >> 1) * NB + hb) * LB * LB;
            p0_transpose_item(W, LB, LB, F.WlruT + (size_t)hb * 512 * LB, slot * 128 + nb * 32, kb * 64, nb * 32, scr, F.lane);
        }
    }
}

__device__ __forceinline__ void phase_h(Frame& F) {
    const int gw = F.wg * NWAVES + F.wave, NGW = F.G * NWAVES;
    for (int m = gw; m < M; m += NGW) {
        const f32x4* xr = (const f32x4*)xrow_ptr(F, m) + F.lane;
        const float* mod = F.MOD + mod_index(m) * 3072;
        f32x4 v[4]; float s = 0.f;
#pragma unroll
        for (int j = 0; j < 4; ++j) { v[j] = xr[64 * j]; s += (v[j].x * v[j].x + v[j].y * v[j].y) + (v[j].z * v[j].z + v[j].w * v[j].w); }
        const float rstd = 1.0f / sqrtf(wave_sum(s) * (1.f / D) + EPS);
        unsigned long long* o8 = (unsigned long long*)(F.H + (size_t)m * D) + F.lane;
#pragma unroll
        for (int j = 0; j < 4; ++j) {
            const int c0 = 4 * F.lane + 256 * j;
            const f32x4 nw = *(const f32x4*)(F.norm_w + c0), sh = *(const f32x4*)(mod + c0), sc = *(const f32x4*)(mod + 1024 + c0);
            const f32x4 h = v[j] * rstd * nw * (sc + 1.0f) + sh;
            o8[64 * j] = (unsigned long long)pk2(h.x, h.y) | ((unsigned long long)pk2(h.z, h.w) << 32);
        }
    }
}

template <class Epi>
__device__ __forceinline__ void gemm_simple(const Frame& F, const bf16* A, int lda, const bf16* Bt, int ldb, int Mr, int Nc, int K, const Epi& epi) {
    const int wr = F.wave >> 2, wc = F.wave & 3, fr = F.lane & 15, fq = F.lane >> 4;
    const int tilesN = Nc / 256, tiles = (Mr / 128) * tilesN;
    for (int t = F.wg; t < tiles; t += F.G) {
        const int tm = t / tilesN, tn = t % tilesN;
        const int row0 = tm * 128 + wr * 64, col0 = tn * 256 + wc * 64;
        f32x4 acc[4][4];
#pragma unroll
        for (int i = 0; i < 4; ++i)
#pragma unroll
            for (int j = 0; j < 4; ++j) acc[i][j] = (f32x4){0.f, 0.f, 0.f, 0.f};
        const bf16* ap = A + (size_t)(row0 + fr) * lda + 8 * fq;
        const bf16* bp = Bt + (size_t)(col0 + fr) * ldb + 8 * fq;
        for (int k0 = 0; k0 < K; k0 += 32) {
            bf16x8 a[4], b[4];
#pragma unroll
            for (int i = 0; i < 4; ++i) a[i] = *(const bf16x8*)(ap + (size_t)(16 * i) * lda + k0);
#pragma unroll
            for (int j = 0; j < 4; ++j) b[j] = *(const bf16x8*)(bp + (size_t)(16 * j) * ldb + k0);
#pragma unroll
            for (int i = 0; i < 4; ++i)
#pragma unroll
                for (int j = 0; j < 4; ++j) acc[i][j] = __builtin_amdgcn_mfma_f32_16x16x32_bf16(a[i], b[j], acc[i][j], 0, 0, 0);
        }
#pragma unroll
        for (int i = 0; i < 4; ++i)
#pragma unroll
            for (int j = 0; j < 4; ++j)
#pragma unroll
                for (int r = 0; r < 4; ++r) epi(row0 + 16 * i + 4 * fq + r, col0 + 16 * j + fr, acc[i][j][r]);
    }
}

struct EpiGemm1 {
    bf16 *Q, *K, *V, *XL, *GL;
    __device__ __forceinline__ void operator()(int row, int col, float v) const {
        if (col < 1024) Q[(size_t)row * 1024 + col] = (bf16)f2bf(v);
        else if (col < 2048) K[(size_t)row * 1024 + col - 1024] = (bf16)f2bf(v * 0.0625f);
        else if (col < 4096) V[(size_t)row * 2048 + col - 2048] = (bf16)f2bf(v);
        else if (col < 5376) XL[(size_t)row * 1280 + col - 4096] = (bf16)f2bf(v);
        else GL[(size_t)row * 1280 + col - 5376] = (bf16)f2bf(siluf_(v));
    }
};
struct EpiGemm2 {
    bf16 *OG, *SIGR, *SIGL;
    __device__ __forceinline__ void operator()(int row, int col, float v) const {
        if (col < 2048) { bf16* p = OG + (size_t)row * 2048 + col; *p = (bf16)f2bf(bf2f(*p) * siluf_(v)); }
        else if (col < 3072) SIGR[(size_t)row * 1024 + col - 2048] = (bf16)f2bf(sigmoidf_(v));
        else SIGL[(size_t)row * 1024 + col - 3072] = (bf16)f2bf(sigmoidf_(v));
    }
};
struct EpiDownR { bf16 *MERGED; const bf16* SIG;
    __device__ __forceinline__ void operator()(int row, int col, float v) const { const size_t o = (size_t)row * 1024 + col; MERGED[o] = (bf16)f2bf(bf2f(SIG[o]) * v); } };
struct EpiDownL { bf16 *MERGED; const bf16* SIG;
    __device__ __forceinline__ void operator()(int row, int col, float v) const { const size_t o = (size_t)row * 1024 + col; MERGED[o] = (bf16)f2bf(bf2f(MERGED[o]) + bf2f(SIG[o]) * v); } };
struct EpiOut { float* Y; const float *xp, *xs, *MOD;
    __device__ __forceinline__ void operator()(int row, int col, float v) const {
        const float xv = row < MCTX ? xp[(size_t)row * D + col] : xs[(size_t)(row - MCTX) * D + col];
        Y[(size_t)row * D + col] = xv + MOD[mod_index(row) * 3072 + 2048 + col] * v;
    } };

__device__ __forceinline__ void lru_item(Frame& F, int T, int hb, bool fin) {
    const int row0 = 64 * T, tid = F.tid;
    int b, seq0, L; bool lat;
    if (row0 < MCTX) { b = row0 / LCTX; seq0 = b * LCTX; L = LCTX; lat = false; } else { b = (row0 - MCTX) / LLAT; seq0 = MCTX + b * LLAT; L = LLAT; lat = true; }
    const int p0 = row0 - seq0, ti = p0 / 64, ntile = L / 64;
    LAS float* xc = (LAS float*)F.lds; LAS float* a_s = xc + 8192; LAS float* b_s = xc + 16384; LAS float* hf_s = xc + 24576;
    for (int idx = tid; idx < 64 * 128; idx += NTHR) {
        const int t = idx >> 7, c = idx & 127, ch = hb * 128 + c;
        float acc = F.conv_b[ch];
#pragma unroll
        for (int tap = 0; tap < 4; ++tap) {
            const int tt = t + tap - 2; bool ok;
            if (lat) ok = (tt >= 0 && tt < 64); else { const int p = p0 + tt; ok = (p >= 0 && p < L); }
            if (ok) acc += F.conv_w[tap * DL + ch] * bf2f(F.XL[(size_t)(row0 + tt) * DL + ch]);
        }
        xc[idx] = acc;
    }
    __syncthreads();
    const int c = tid & 127, tg = tid >> 7, ch = hb * 128 + c;
    const bf16* W = F.WlruT + (size_t)hb * 512 * LB;
#pragma unroll 1
    for (int dir = 0; dir < 2; ++dir) {
        float acc[2][16];
#pragma unroll
        for (int s = 0; s < 2; ++s)
#pragma unroll
            for (int t = 0; t < 16; ++t) acc[s][t] = 0.f;
        const bf16* W0 = W + (size_t)((2 * dir) * 128 + c) * LB; const bf16* W1 = W + (size_t)((2 * dir + 1) * 128 + c) * LB;
#pragma unroll 2
        for (int i = 0; i < 128; ++i) {
            const float w0 = bf2f(W0[i]), w1 = bf2f(W1[i]);
#pragma unroll
            for (int t = 0; t < 16; ++t) { const float xv = bfr(xc[(tg * 16 + t) * 128 + i]); acc[0][t] += xv * w0; acc[1][t] += xv * w1; }
        }
        const float ba = F.lru_ba[dir * DL + ch], bx = F.lru_bx[dir * DL + ch];
        const float sp = log1pf(expf(-F.lru_a[dir * DL + ch]));
#pragma unroll
        for (int t = 0; t < 16; ++t) {
            const int tok = tg * 16 + t;
            const float r = sigmoidf_(acc[0][t] + ba), gi = sigmoidf_(acc[1][t] + bx);
            const float la = -8.0f * r * sp;
            a_s[tok * 128 + c] = expf(la);
            b_s[tok * 128 + c] = sqrtf(-expm1f(2.0f * la)) * gi * xc[tok * 128 + c];
        }
        __syncthreads();
        if (tid < 128) {
            const int cc = tid, chh = hb * 128 + cc;
            float carry = 0.f;
            if (fin) {
                carry = lat ? F.state_lru[(size_t)(b * 2 + dir) * DL + chh] : 0.f;
                if (dir == 0) { for (int n = 0; n < ti; ++n) { const float* ag = F.AGG + ((size_t)((T - ti + n) * 2 + 0) * 2) * DL; carry = ag[chh] * carry + ag[DL + chh]; } }
                else { for (int n = ntile - 1; n > ti; --n) { const float* ag = F.AGG + ((size_t)((T - ti + n) * 2 + 1) * 2) * DL; carry = ag[chh] * carry + ag[DL + chh]; } }
            }
            float h = carry, P = 1.f;
            if (dir == 0) {
                for (int t = 0; t < 64; ++t) { const float a = a_s[t * 128 + cc]; h = a * h + b_s[t * 128 + cc]; P *= a; if (fin) hf_s[t * 128 + cc] = h; }
                if (fin && !lat && ti == ntile - 1) F.out[OUT_NSL + (size_t)(b * 2 + 0) * DL + chh] = h;
            } else {
                for (int t = 63; t >= 0; --t) { const float a = a_s[t * 128 + cc]; h = a * h + b_s[t * 128 + cc]; P *= a; if (fin) hf_s[t * 128 + cc] += h; }
                if (fin && !lat && ti == 0) F.out[OUT_NSL + (size_t)(b * 2 + 1) * DL + chh] = h;
            }
            if (!fin) { float* ag = F.AGG + ((size_t)(T * 2 + dir) * 2) * DL; ag[chh] = P; ag[DL + chh] = h; }
        }
        __syncthreads();
    }
    if (fin) {
        for (int idx = tid; idx < 64 * 128; idx += NTHR) {
            const int t = idx >> 7, cc = idx & 127; const size_t o = (size_t)(row0 + t) * DL + hb * 128 + cc;
            F.HL[o] = (bf16)f2bf(hf_s[idx] * bf2f(F.GL[o]));
        }
    }
    __syncthreads();
}
__device__ __forceinline__ void phase_lru(Frame& F, bool fin) {
    for (int it = F.wg; it < (M / 64) * NB; it += F.G) lru_item(F, it / NB, it % NB, fin);
}

__device__ __forceinline__ float log_gamma(const Frame& F, int dir, int h) { const float x = F.decay_logit[dir * NH + h]; return -log1pf(expf(-x)); }
__device__ __forceinline__ size_t sp_index(int b, int h, int dir, int n) { return ((size_t)(((b * NH + h) * 2 + dir) * NCH_LAT + n)) * (DK * DV); }
__device__ __forceinline__ void phase_r12(Frame& F) {
    const int e = F.tid;
    constexpr int ITEMS = (NCTX + NLAT) * NH * 2 * (DK / 4);
    for (int it = F.wg; it < ITEMS; it += F.G) {
        int r = it; const int dg = r % (DK / 4); r /= (DK / 4); const int dir = r & 1; r >>= 1; const int h = r % NH; const int s = r / NH;
        const bool lat = s >= NCTX; const int b = lat ? s - NCTX : s; const int L = lat ? LLAT : LCTX; const int seq0 = lat ? MCTX + b * LLAT : b * LCTX;
        const float g = expf(log_gamma(F, dir, h));
        float S[4];
#pragma unroll
        for (int u = 0; u < 4; ++u) S[u] = lat ? F.state_ret[((size_t)((b * 2 + dir) * NH + h) * DK + dg * 4 + u) * DV + e] : 0.f;
        const int nch = L / CH;
        for (int nn = 0; nn < nch; ++nn) {
            const int n = dir == 0 ? nn : nch - 1 - nn;
            if (lat) {
#pragma unroll
                for (int u = 0; u < 4; ++u) F.SP[sp_index(b, h, dir, n) + (size_t)(dg * 4 + u) * DV + e] = (bf16)f2bf(S[u]);
            }
            for (int ii = 0; ii < CH; ++ii) {
                const int i = dir == 0 ? ii : CH - 1 - ii; const size_t row = (size_t)seq0 + n * CH + i;
                const float vv = bf2f(F.V[row * DRV + h * DV + e]);
                const unsigned long long kk = *(const unsigned long long*)(F.K + row * DQK + h * DK + dg * 4);
#pragma unroll
                for (int u = 0; u < 4; ++u) S[u] = g * S[u] + bf2f((unsigned short)(kk >> (16 * u))) * vv;
            }
        }
        if (!lat) {
#pragma unroll
            for (int u = 0; u < 4; ++u) F.out[OUT_NSR + ((size_t)((b * 2 + dir) * NH + h) * DK + dg * 4 + u) * DV + e] = S[u];
        }
    }
}

__device__ __forceinline__ void phase_r3(Frame& F) {
    LAS float* qs = (LAS float*)F.lds; LAS float* Ps = qs + 256; LAS float* red = qs + 512;
    const int tid = F.tid;
    for (int it = F.wg; it < M * NH; it += F.G) {
        const int row = it / NH, h = it % NH;
        const bool lat = row >= MCTX; const int b = lat ? (row - MCTX) / LLAT : row / LCTX; const int seq0 = lat ? MCTX + b * LLAT : b * LCTX;
        const int p = row - seq0, n = p / CH, i = p % CH, crow0 = row - i;
        const float lgf = log_gamma(F, 0, h), lgb = log_gamma(F, 1, h);
        if (tid < 256) qs[tid] = bf2f(F.Q[(size_t)row * DQK + h * DK + tid]);
        __syncthreads();
        if (tid < 256) {
            const int j = tid; const bf16* kr = F.K + (size_t)(crow0 + j) * DQK + h * DK; float s = 0.f;
            for (int d = 0; d < DK; d += 8) { const v4u kv = *(const v4u*)(kr + d);
                s += qs[d] * bf2f((unsigned short)kv.x) + qs[d + 1] * bf2f((unsigned short)(kv.x >> 16)) + qs[d + 2] * bf2f((unsigned short)kv.y) + qs[d + 3] * bf2f((unsigned short)(kv.y >> 16))
                   + qs[d + 4] * bf2f((unsigned short)kv.z) + qs[d + 5] * bf2f((unsigned short)(kv.z >> 16)) + qs[d + 6] * bf2f((unsigned short)kv.w) + qs[d + 7] * bf2f((unsigned short)(kv.w >> 16)); }
            const int dj = i - j; const float dec = dj >= 0 ? expf(lgf * (float)dj) : expf(lgb * (float)(-dj));
            Ps[j] = bfr(s * dec);
        }
        __syncthreads();
        const int e = tid; float acc = 0.f;
        for (int j = 0; j < CH; ++j) acc += Ps[j] * bf2f(F.V[(size_t)(crow0 + j) * DRV + h * DV + e]);
        if (lat) {
            const bf16* sf = F.SP + sp_index(b, h, 0, n); const bf16* sb = F.SP + sp_index(b, h, 1, n);
            float af = 0.f, ab = 0.f;
            for (int d = 0; d < DK; ++d) { af += qs[d] * bf2f(sf[(size_t)d * DV + e]); ab += qs[d] * bf2f(sb[(size_t)d * DV + e]); }
            acc += expf(lgf * (float)(i + 1)) * af + expf(lgb * (float)(CH - i)) * ab;
        }
        float ss = wave_sum(acc * acc);
        if (F.lane == 0) red[F.wave] = ss;
        __syncthreads();
        ss = 0.f;
#pragma unroll
        for (int w = 0; w < NWAVES; ++w) ss += red[w];
        const float sc = 1.0f / sqrtf(ss * (1.0f / DV) + EPS);
        F.OG[(size_t)row * DRV + h * DV + e] = (bf16)f2bf(acc * sc * F.gn_w[h * DV + e]);
        __syncthreads();
    }
}

__device__ __forceinline__ void phase_norm(Frame& F) {
    const int gw = F.wg * NWAVES + F.wave, NGW = F.G * NWAVES;
    for (int m = gw; m < M; m += NGW) {
        f32x4* yr = (f32x4*)(F.out + OUT_Y + (size_t)m * D) + F.lane;
        f32x4 v[4]; float s = 0.f;
#pragma unroll
        for (int j = 0; j < 4; ++j) { v[j] = yr[64 * j]; s += (v[j].x * v[j].x + v[j].y * v[j].y) + (v[j].z * v[j].z + v[j].w * v[j].w); }
        const float rstd = 1.0f / sqrtf(wave_sum(s) * (1.f / D) + EPS);
#pragma unroll
        for (int j = 0; j < 4; ++j) { const f32x4 nw = *(const f32x4*)(F.final_norm_w + 4 * F.lane + 256 * j); yr[64 * j] = v[j] * rstd * nw; }
    }
}

constexpr int PH_PREP = 0, PH_H = 1, PH_GEMM1 = 2, PH_LRUA = 3, PH_LRUB = 4, PH_R12 = 5, PH_R3 = 6, PH_G2 = 7, PH_DOWN = 8, PH_OUT = 9, PH_NORM = 10, N_PHASES = 11;

__global__ void __launch_bounds__(NTHR, 2) fwd_kernel(Args args) {
    extern __shared__ __attribute__((aligned(16))) unsigned char lds_raw[];
    Frame F;
    F.lds = (LAS unsigned char*)lds_raw;
    F.tid = threadIdx.x; F.lane = F.tid & 63; F.wave = __builtin_amdgcn_readfirstlane(F.tid >> 6);
    F.G = gridDim.x; F.wg = blockIdx.x;
    F.x_prompt = args.in[0]; F.x_sample = args.in[1]; F.state_ret = args.in[2]; F.state_lru = args.in[3]; F.c = args.in[4]; F.c_ctx = args.in[5];
    F.norm_w = args.in[6]; F.w_ada = args.in[7]; F.b_ada = args.in[8]; F.w_in = args.in[9]; F.decay_logit = args.in[10]; F.gn_w = args.in[11];
    F.w_ret_down = args.in[12]; F.conv_w = args.in[13]; F.conv_b = args.in[14]; F.lru_wa = args.in[15]; F.lru_ba = args.in[16]; F.lru_wx = args.in[17];
    F.lru_bx = args.in[18]; F.lru_a = args.in[19]; F.w_lru_down = args.in[20]; F.w_out = args.in[21]; F.final_norm_w = args.in[22];
    F.out = args.out; F.ws = args.ws;
    unsigned char* ws = args.ws;
    F.WinT = (bf16*)(ws + WS_WINT); F.WrdT = (bf16*)(ws + WS_WRDT); F.WldT = (bf16*)(ws + WS_WLDT); F.WoutT = (bf16*)(ws + WS_WOUTT); F.WlruT = (bf16*)(ws + WS_WLRUT);
    F.MOD = (float*)(ws + WS_MOD); F.H = (bf16*)(ws + WS_H); F.Q = (bf16*)(ws + WS_Q); F.K = (bf16*)(ws + WS_K); F.V = (bf16*)(ws + WS_V);
    F.XL = (bf16*)(ws + WS_XL); F.GL = (bf16*)(ws + WS_GL); F.AGG = (float*)(ws + WS_AGG); F.HL = (bf16*)(ws + WS_HL); F.SP = (bf16*)(ws + WS_SP);
    F.SIGR = (bf16*)(ws + WS_SIGR); F.SIGL = (bf16*)(ws + WS_SIGL); F.MERGED = (bf16*)(ws + WS_MERGED); F.OG = (bf16*)(args.out + OUT_Y);

    volatile LAS unsigned* MISC = (volatile LAS unsigned*)(F.lds + MISC_OFF);
    for (int u = F.tid; u < (LDS_BYTES - 131072) / 4; u += NTHR) ((LAS unsigned*)(F.lds + 131072))[u] = 0u;
    __syncthreads();
    const int lo = args.ph_lo, hi = args.ph_hi;
    XcdBarrier bar; bar.bar = (unsigned*)(ws + WS_CTL) + CW_BAR; bar.x = 0; bar.st = nullptr;
    if (hi - lo > 1) bar = xcd_barrier_post((unsigned*)(ws + WS_CTL) + CW_BAR, MISC + 8);
#define IN(k) (lo <= (k) && (k) < hi)
#define SEAM(k) do { if (IN(k) && IN((k) + 1)) xcd_barrier(bar); } while (0)

    if (IN(PH_PREP)) { phase_prep(F); SEAM(PH_PREP); }
    if (IN(PH_H)) { phase_h(F); SEAM(PH_H); }
    if (IN(PH_GEMM1)) { pg8::Gemm g{F.H, F.WinT, M, N1, D}; pg8::StaticOrder S; S.init(M, N1, F.G, F.wg); pg8::EpiG1 E{F.Q, F.K, F.V, F.XL, F.GL};
        pg8::gemm_phase<pg8::EpiG1, pg8::StaticOrder, true, true>(F.lds, g, S, E); SEAM(PH_GEMM1); }
    if (IN(PH_LRUA)) { phase_lru(F, false); SEAM(PH_LRUA); }
    if (IN(PH_LRUB)) { phase_lru(F, true); SEAM(PH_LRUB); }
    if (IN(PH_R12)) { phase_r12(F); SEAM(PH_R12); }
    if (IN(PH_R3)) { phase_r3(F); SEAM(PH_R3); }
    if (IN(PH_G2)) { pg8::Gemm g{F.H, F.WinT + (size_t)N1 * D, M, N2, D}; pg8::StaticOrder S; S.init(M, N2, F.G, F.wg); pg8::EpiG2 E{F.OG, F.SIGR, F.SIGL};
        pg8::gemm_phase<pg8::EpiG2, pg8::StaticOrder, true, true>(F.lds, g, S, E); SEAM(PH_G2); }
    if (IN(PH_DOWN)) {
        { pg8::Gemm g{F.OG, F.WrdT, M, D, DRV}; pg8::StaticOrder S; S.init(M, D, F.G, F.wg); pg8::EpiDown<false> E{F.MERGED, F.SIGR}; pg8::gemm_phase<pg8::EpiDown<false>, pg8::StaticOrder, true, true>(F.lds, g, S, E); }
        { pg8::Gemm g{F.HL, F.WldT, M, D, DL}; pg8::StaticOrder S; S.init(M, D, F.G, F.wg); pg8::EpiDown<true> E{F.MERGED, F.SIGL}; pg8::gemm_phase<pg8::EpiDown<true>, pg8::StaticOrder, true, true>(F.lds, g, S, E); }
        SEAM(PH_DOWN);
    }
    if (IN(PH_OUT)) { pg8::Gemm g{F.MERGED, F.WoutT, M, D, D}; pg8::StaticOrder S; S.init(M, D, F.G, F.wg); pg8::EpiY E{F.out + OUT_Y, F.x_prompt, F.x_sample, F.MOD, MCTX, LLAT};
        pg8::gemm_phase<pg8::EpiY, pg8::StaticOrder, true, true>(F.lds, g, S, E); SEAM(PH_OUT); }
    if (IN(PH_NORM)) { phase_norm(F); }
#undef IN
#undef SEAM
}
}

extern "C" void kernel_launch(void* const* d_in, const int* in_sizes, int n_in, void* d_out, int out_size, void* d_ws, size_t ws_size, hipStream_t stream) {
    static int grid = 0;
    if (grid == 0) {
        if (n_in != 23 || (size_t)out_size != OUT_TOTAL || ws_size < WS_END) { fprintf(stderr, "kernel_launch: unexpected shapes n_in %d out %d ws %zu\n", n_in, out_size, ws_size); grid = -1; return; }
        int dev = 0, cus = 0;
        if (hipGetDevice(&dev) != hipSuccess || hipDeviceGetAttribute(&cus, hipDeviceAttributeMultiprocessorCount, dev) != hipSuccess) { grid = -1; return; }
        if (hipFuncSetAttribute((const void*)fwd_kernel, hipFuncAttributeMaxDynamicSharedMemorySize, LDS_BYTES) != hipSuccess) { fprintf(stderr, "kernel_launch: hipFuncSetAttribute failed\n"); grid = -1; return; }
        int per_cu = 0;
        (void)hipOccupancyMaxActiveBlocksPerMultiprocessor(&per_cu, (const void*)fwd_kernel, NTHR, LDS_BYTES);
        (void)hipGetLastError();
        grid = cus;
    }
    if (grid < 0) return;
    (void)hipMemsetAsync((char*)d_ws + WS_CTL, 0, CTL_ZERO_BYTES, stream);
    Args a{};
    for (int i = 0; i < 23; ++i) a.in[i] = (const float*)d_in[i];
    a.out = (float*)d_out; a.ws = (unsigned char*)d_ws;
#if MK_ONE_LAUNCH
    a.ph_lo = 0; a.ph_hi = N_PHASES;
    hipLaunchKernelGGL(fwd_kernel, dim3(grid), dim3(NTHR), LDS_BYTES, stream, a);
#else
    for (int p = 0; p < N_PHASES; ++p) { a.ph_lo = p; a.ph_hi = p + 1; hipLaunchKernelGGL(fwd_kernel, dim3(grid), dim3(NTHR), LDS_BYTES, stream, a); }
#endif
}
```

```cpp
#include <hip/hip_runtime.h>
#include <cstdint>
#include <cstdio>

#ifndef MK_ONE_LAUNCH
#define MK_ONE_LAUNCH 1
#endif

namespace {
constexpr int D = 1024, NCTX = 16, LCTX = 256, NLAT = 4, LLAT = 2048;
constexpr int MCTX = NCTX * LCTX, MLAT = NLAT * LLAT, M = MCTX + MLAT;
constexpr int NH = 4, DK = 256, DV = 512, DQK = NH * DK, DRV = NH * DV;
constexpr int NB = 10, LB = 128, DL = NB * LB;
constexpr int DIN = 10752;
constexpr int N1 = 6656;
constexpr int N2 = 4096;
constexpr int CH = 256;
constexpr int NCH_LAT = LLAT / CH;
constexpr float EPS = 1e-6f;
constexpr int NWAVES = 8, NTHR = 512;

constexpr size_t MiB = 1u << 20;
constexpr size_t WS_CTL = 0, CTL_ZERO_BYTES = 1 * MiB;
constexpr size_t WS_WINT = 1 * MiB;
constexpr size_t WS_WRDT = 22 * MiB;
constexpr size_t WS_WLDT = 26 * MiB;
constexpr size_t WS_WOUTT = 28 * MiB + 512 * 1024;
constexpr size_t WS_WLRUT = 30 * MiB + 512 * 1024;
constexpr size_t WS_MOD = 31 * MiB + 768 * 1024;
constexpr size_t WS_H = 32 * MiB;
constexpr size_t WS_Q = 56 * MiB, WS_K = 80 * MiB, WS_V = 104 * MiB;
constexpr size_t WS_XL = 152 * MiB, WS_GL = 182 * MiB;
constexpr size_t WS_AGG = 216 * MiB;
constexpr size_t WS_SS = 220 * MiB;
constexpr size_t WS_HL = 226 * MiB;
constexpr size_t WS_SP = 152 * MiB;
constexpr size_t WS_SIGR = 56 * MiB, WS_SIGL = 80 * MiB;
constexpr size_t WS_MERGED = 104 * MiB;
constexpr size_t WS_END = 256 * MiB;
constexpr size_t OUT_Y = 0;
constexpr size_t OUT_NSR = (size_t)M * D;
constexpr size_t OUT_NSL = OUT_NSR + (size_t)NCTX * 2 * NH * DK * DV;
constexpr size_t OUT_TOTAL = OUT_NSL + (size_t)NCTX * 2 * DL;

constexpr int CW_TMO = 0, CW_CODE = 1, CW_BAR = 4096;
constexpr int LDS_BYTES = 147456;
constexpr int MISC_OFF = 131072 + 320;

#define GAS __attribute__((address_space(1)))
#define LAS __attribute__((address_space(3)))
typedef unsigned short bf16;
typedef unsigned v4u __attribute__((ext_vector_type(4)));
typedef float f32x4 __attribute__((ext_vector_type(4)));
typedef short bf16x8 __attribute__((ext_vector_type(8)));
typedef GAS unsigned gu32;
#define RLX_AGENT __ATOMIC_RELAXED, __HIP_MEMORY_SCOPE_AGENT
#define LDS_WAIT() asm volatile("s_waitcnt lgkmcnt(0)" ::: "memory")
#define VM_WAIT() asm volatile("s_waitcnt vmcnt(0)" ::: "memory")

__device__ __forceinline__ unsigned f2bf(float f) { unsigned u = __builtin_bit_cast(unsigned, f); return (u + 0x7fffu + ((u >> 16) & 1u)) >> 16; }
__device__ __forceinline__ float bf2f(unsigned short b) { return __builtin_bit_cast(float, ((unsigned)b) << 16); }
__device__ __forceinline__ float bfr(float f) { return bf2f((unsigned short)f2bf(f)); }
__device__ __forceinline__ unsigned pk2(float lo, float hi) { return f2bf(lo) | (f2bf(hi) << 16); }
__device__ __forceinline__ float sigmoidf_(float x) { return 1.0f / (1.0f + __expf(-x)); }
__device__ __forceinline__ float siluf_(float x) { return x / (1.0f + __expf(-x)); }

#define XB_TMO      128
#define XB_XCNT(j)  (256  + 64 * (j))
#define XB_XSUB(j)  (1280 + 64 * (j))
#define XB_XGEN(j)  (2304 + 64 * (j))
#define XB_TOP      3328
#define XB_TOPGEN   3392
#define XCD_BAR_WORDS 3456
#define XB_SPIN_CAP (1u << 22)
__device__ __forceinline__ unsigned xb_ld(unsigned* p)              { return __hip_atomic_load(p, __ATOMIC_RELAXED, __HIP_MEMORY_SCOPE_AGENT); }
__device__ __forceinline__ unsigned xb_add(unsigned* p, unsigned v) { return __hip_atomic_fetch_add(p, v, __ATOMIC_RELAXED, __HIP_MEMORY_SCOPE_AGENT); }
__device__ __forceinline__ unsigned xb_xcc_id() { return (unsigned)__builtin_amdgcn_s_getreg((3 << 11) | 20) & 0xFu; }
#define XB_SPIN(cond, bar) do { unsigned _sp = 0; while (cond) { __builtin_amdgcn_s_sleep(1); \
    if ((++_sp & 255u) == 0u) { if (xb_ld(&(bar)[XB_TMO])) break; if (_sp > XB_SPIN_CAP) { atomicAdd(&(bar)[XB_TMO], 1u); break; } } } } while (0)
struct XcdBarrier { unsigned* bar; unsigned x; volatile LAS unsigned* st; };
__device__ __forceinline__ XcdBarrier xcd_barrier_post(unsigned* bar, volatile LAS unsigned* st) {
    XcdBarrier b; b.bar = bar; b.x = xb_xcc_id(); b.st = st;
    if (threadIdx.x == 0) (void)xb_add(&bar[XB_XCNT(b.x)], 1u);
    return b;
}
__device__ __forceinline__ void xcd_barrier_complete(unsigned* bar, unsigned x, unsigned& nloc, unsigned& nx) {
    const unsigned G = gridDim.x * gridDim.y * gridDim.z;
    unsigned sum, cnt, mine, sp = 0u;
    for (;;) {
        sum = 0u; cnt = 0u; mine = 0u;
#pragma unroll
        for (unsigned j = 0; j < 16; ++j) { const unsigned c = xb_ld(&bar[XB_XCNT(j)]); sum += c; cnt += (c > 0u) ? 1u : 0u; mine = (j == x) ? c : mine; }
        if (sum == G) break;
        __builtin_amdgcn_s_sleep(1);
        if ((++sp & 255u) == 0u) { if (xb_ld(&bar[XB_TMO])) break; if (sp > XB_SPIN_CAP) { atomicAdd(&bar[XB_TMO], 1u); break; } }
    }
    nloc = mine > 0u ? mine : 1u; nx = cnt > 0u ? cnt : 1u;
}
__device__ __forceinline__ void xcd_barrier(const XcdBarrier& b) {
    asm volatile("s_waitcnt vmcnt(0)" ::: "memory");
    __syncthreads();
    if (threadIdx.x == 0) {
        unsigned* bar = b.bar;
        __builtin_amdgcn_s_waitcnt(0);
        unsigned nloc = b.st[0], nx = b.st[1];
        if (nloc == 0u) { xcd_barrier_complete(bar, b.x, nloc, nx); b.st[0] = nloc; b.st[1] = nx; }
        const unsigned old = xb_add(&bar[XB_XSUB(b.x)], 1u);
        const unsigned gen = old / nloc;
        if (old + 1u == (gen + 1u) * nloc) {
            __builtin_amdgcn_fence(__ATOMIC_RELEASE, "agent");
            asm volatile("s_waitcnt vmcnt(0)" ::: "memory");
            const unsigned og = xb_add(&bar[XB_TOP], 1u);
            const unsigned tg = og / nx;
            if (og + 1u == (tg + 1u) * nx) xb_add(&bar[XB_TOPGEN], 1u);
            else XB_SPIN(xb_ld(&bar[XB_TOPGEN]) == tg, bar);
            __builtin_amdgcn_fence(__ATOMIC_ACQUIRE, "agent");
            xb_add(&bar[XB_XGEN(b.x)], 1u);
            asm volatile("s_waitcnt vmcnt(0)" ::: "memory");
        } else {
            XB_SPIN(xb_ld(&bar[XB_XGEN(b.x)]) == gen, bar);
            __builtin_amdgcn_fence(__ATOMIC_ACQUIRE, "agent");
            asm volatile("s_waitcnt vmcnt(0)" ::: "memory");
        }
    }
    __syncthreads();
}

namespace pg8 {
#define PG8_LAS __attribute__((address_space(3)))
typedef unsigned short bf16_t;
typedef short bf16x8 __attribute__((ext_vector_type(8)));
typedef float f32x4 __attribute__((ext_vector_type(4)));
typedef unsigned u32x4 __attribute__((ext_vector_type(4)));
constexpr int BM = 256, BK = 64, HALF = 128, HTB = HALF * BK * 2  , STAGE_BYTES = 8 * HTB, NXCD = 8, WGM = 8;

__host__ __device__ __forceinline__ int lds_byte(int r, int c) { const int st = (r >> 4) * 2 + (c >> 5), rr = r & 15, cc = c & 31, ob = rr * 64 + cc * 2; return st * 1024 + (ob ^ (((ob >> 9) & 1) << 5)); }
__host__ __device__ __forceinline__ void stage_rc(int b, int& R, int& C) { const int st = b / 1024, sb = b % 1024, swz = sb ^ (((sb >> 9) & 1) << 5); R = (st >> 1) * 16 + swz / 64; C = (st & 1) * 32 + (swz % 64) / 2; }
__host__ __device__ __forceinline__ int perm32(int rho) { const int n = rho >> 4, i = rho & 15; return 8 * (i >> 2) + 4 * n + (i & 3); }

struct Unit { int pm, pn; };
struct Gemm { const bf16_t* A; const bf16_t* Bt; int M, N, K; };

struct StaticOrder {
    int nM, nN, nwg, G, c;
    __host__ __device__ void init(int M, int N, int G_, int c_) { nM = M / BM; nN = N / BM; nwg = nM * nN; G = G_; c = c_; }
    __host__ __device__ bool next(int i, Unit& u) const {
        const long L = (long)i * G + c; if (L >= nwg) return false;
        int wgid = (int)L; { const int q = nwg / NXCD, r = nwg % NXCD, xcd = wgid % NXCD, off = wgid / NXCD; wgid = (xcd < r ? xcd * (q + 1) : r * (q + 1) + (xcd - r) * q) + off; }
        const int nig = WGM * nN, gid = wgid / nig, fm = gid * WGM, gsz = (nM - fm) < WGM ? (nM - fm) : WGM;
        u.pm = fm + ((wgid % nig) % gsz); u.pn = (wgid % nig) / gsz; return true;
    }
    __device__ __forceinline__ void a_ready(const Unit&) const {}
    __device__ __forceinline__ void done(const Unit&) const {}
};

__device__ __forceinline__ unsigned cvt_pk_bf16(float lo, float hi) { unsigned r; asm volatile("v_cvt_pk_bf16_f32 %0, %1, %2" : "=v"(r) : "v"(lo), "v"(hi)); return r; }

typedef float f32x2 __attribute__((ext_vector_type(2)));
__device__ __forceinline__ float pg_silu(float x) { return x * __builtin_amdgcn_rcpf(1.0f + __expf(-x)); }
__device__ __forceinline__ float pg_sigm(float x) { return __builtin_amdgcn_rcpf(1.0f + __expf(-x)); }
__device__ __forceinline__ float pg_lo(unsigned w) { return __builtin_bit_cast(float, w << 16); }
__device__ __forceinline__ float pg_hi(unsigned w) { return __builtin_bit_cast(float, w & 0xffff0000u); }
struct EpiG1 {
    static constexpr bool PERM = true, AFTER_DRAIN = false;
    bf16_t *Q, *K, *V, *XL, *GL;
    __device__ __forceinline__ void operator()(const f32x4 (&acc)[2][2][4][2], const Unit& u, int wr, int wc, int fr, int fq) const {
        const int row0 = u.pm * BM + wr * 64 + fr; int colt = u.pn * BM; bf16_t* base; int ldc; float sc = 1.f; bool act = false;
        if (colt < 1024) { base = Q; ldc = 1024; } else if (colt < 2048) { base = K; ldc = 1024; colt -= 1024; sc = 0.0625f; }
        else if (colt < 4096) { base = V; ldc = 2048; colt -= 2048; } else if (colt < 5376) { base = XL; ldc = 1280; colt -= 4096; } else { base = GL; ldc = 1280; colt -= 5376; act = true; }
        const int col0 = colt + wc * 32 + 8 * fq;
#pragma unroll
        for (int ai = 0; ai < 2; ++ai)
#pragma unroll
            for (int m = 0; m < 4; ++m) { bf16_t* rowp = base + (size_t)(row0 + ai * HALF + m * 16) * ldc + col0;
#pragma unroll
                for (int bj = 0; bj < 2; ++bj) { f32x4 v0 = acc[ai][bj][m][0], v1 = acc[ai][bj][m][1];
                    if (act) {
#pragma unroll
                        for (int j = 0; j < 4; ++j) { v0[j] = pg_silu(v0[j]); v1[j] = pg_silu(v1[j]); } }
                    v0 = v0 * sc; v1 = v1 * sc; u32x4 w; w.x = cvt_pk_bf16(v0[0], v0[1]); w.y = cvt_pk_bf16(v0[2], v0[3]); w.z = cvt_pk_bf16(v1[0], v1[1]); w.w = cvt_pk_bf16(v1[2], v1[3]);
                    *(u32x4*)(rowp + bj * HALF) = w; } }
    }
};
struct EpiG2 {
    static constexpr bool PERM = true, AFTER_DRAIN = false;
    bf16_t *OG, *SIGR, *SIGL; const float *SS, *gnw;
    __device__ __forceinline__ void operator()(const f32x4 (&acc)[2][2][4][2], const Unit& u, int wr, int wc, int fr, int fq) const {
        const int row0 = u.pm * BM + wr * 64 + fr; int colt = u.pn * BM; bf16_t* base; int ldc; bool mul = false;
        if (colt < 2048) { base = OG; ldc = 2048; mul = true; } else if (colt < 3072) { base = SIGR; ldc = 1024; colt -= 2048; } else { base = SIGL; ldc = 1024; colt -= 3072; }
        const int col0 = colt + wc * 32 + 8 * fq, head = colt >> 9;
        f32x4 gw[2][2];
#pragma unroll
        for (int bj = 0; bj < 2; ++bj)
#pragma unroll
            for (int n = 0; n < 2; ++n) gw[bj][n] = mul ? *(const f32x4*)(gnw + col0 + bj * HALF + 4 * n) : (f32x4){1.f, 1.f, 1.f, 1.f};
#pragma unroll
        for (int ai = 0; ai < 2; ++ai)
#pragma unroll
            for (int m = 0; m < 4; ++m) { const int r = row0 + ai * HALF + m * 16; bf16_t* rowp = base + (size_t)r * ldc + col0;
                float rs = 1.f;
                if (mul) { const f32x4 sq = *(const f32x4*)(SS + ((size_t)r * 4 + head) * 4); rs = 1.0f / sqrtf(((sq[0] + sq[1]) + (sq[2] + sq[3])) * (1.0f / 512.0f) + 1e-6f); }
#pragma unroll
                for (int bj = 0; bj < 2; ++bj) { f32x4 v0 = acc[ai][bj][m][0], v1 = acc[ai][bj][m][1];
                    if (mul) { const u32x4 o = *(const u32x4*)(rowp + bj * HALF); const f32x4 g0 = gw[bj][0] * rs, g1 = gw[bj][1] * rs;
                        v0[0] = pg_silu(v0[0]) * pg_lo(o.x) * g0[0]; v0[1] = pg_silu(v0[1]) * pg_hi(o.x) * g0[1]; v0[2] = pg_silu(v0[2]) * pg_lo(o.y) * g0[2]; v0[3] = pg_silu(v0[3]) * pg_hi(o.y) * g0[3];
                        v1[0] = pg_silu(v1[0]) * pg_lo(o.z) * g1[0]; v1[1] = pg_silu(v1[1]) * pg_hi(o.z) * g1[1]; v1[2] = pg_silu(v1[2]) * pg_lo(o.w) * g1[2]; v1[3] = pg_silu(v1[3]) * pg_hi(o.w) * g1[3];
                    } else {
#pragma unroll
                        for (int j = 0; j < 4; ++j) { v0[j] = pg_sigm(v0[j]); v1[j] = pg_sigm(v1[j]); } }
                    u32x4 w; w.x = cvt_pk_bf16(v0[0], v0[1]); w.y = cvt_pk_bf16(v0[2], v0[3]); w.z = cvt_pk_bf16(v1[0], v1[1]); w.w = cvt_pk_bf16(v1[2], v1[3]);
                    *(u32x4*)(rowp + bj * HALF) = w; } }
    }
};
template <bool ADD> struct EpiDown {
    static constexpr bool PERM = true, AFTER_DRAIN = false;
    bf16_t* MERGED; const bf16_t* SIG;
    __device__ __forceinline__ void operator()(const f32x4 (&acc)[2][2][4][2], const Unit& u, int wr, int wc, int fr, int fq) const {
        const int row0 = u.pm * BM + wr * 64 + fr, col0 = u.pn * BM + wc * 32 + 8 * fq;
#pragma unroll
        for (int ai = 0; ai < 2; ++ai)
#pragma unroll
            for (int m = 0; m < 4; ++m) { const size_t off = (size_t)(row0 + ai * HALF + m * 16) * 1024 + col0;
#pragma unroll
                for (int bj = 0; bj < 2; ++bj) { f32x4 v0 = acc[ai][bj][m][0], v1 = acc[ai][bj][m][1];
                    const u32x4 g = *(const u32x4*)(SIG + off + bj * HALF);
                    v0[0] *= pg_lo(g.x); v0[1] *= pg_hi(g.x); v0[2] *= pg_lo(g.y); v0[3] *= pg_hi(g.y); v1[0] *= pg_lo(g.z); v1[1] *= pg_hi(g.z); v1[2] *= pg_lo(g.w); v1[3] *= pg_hi(g.w);
                    if (ADD) { const u32x4 o = *(const u32x4*)(MERGED + off + bj * HALF);
                        v0[0] += pg_lo(o.x); v0[1] += pg_hi(o.x); v0[2] += pg_lo(o.y); v0[3] += pg_hi(o.y); v1[0] += pg_lo(o.z); v1[1] += pg_hi(o.z); v1[2] += pg_lo(o.w); v1[3] += pg_hi(o.w); }
                    u32x4 w; w.x = cvt_pk_bf16(v0[0], v0[1]); w.y = cvt_pk_bf16(v0[2], v0[3]); w.z = cvt_pk_bf16(v1[0], v1[1]); w.w = cvt_pk_bf16(v1[2], v1[3]);
                    *(u32x4*)(MERGED + off + bj * HALF) = w; } }
    }
};
struct EpiY {
    static constexpr bool PERM = false, AFTER_DRAIN = false;
    float* Y; const float *xp, *xs, *MOD; int mctx, llat;
    __device__ __forceinline__ void operator()(const f32x4 (&acc)[2][2][4][2], const Unit& u, int wr, int wc, int fr, int fq) const {
        const int row0 = u.pm * BM + wr * 64 + fr, col0 = u.pn * BM + wc * 32 + 4 * fq;
        const int rbase = u.pm * BM;
        const float* gate = MOD + (rbase < mctx ? 0 : 1 + (rbase - mctx) / llat) * 3072 + 2048;
        f32x4 gv[2][2];
#pragma unroll
        for (int bj = 0; bj < 2; ++bj)
#pragma unroll
            for (int n = 0; n < 2; ++n) gv[bj][n] = *(const f32x4*)(gate + col0 + bj * HALF + n * 16);
#pragma unroll
        for (int ai = 0; ai < 2; ++ai)
#pragma unroll
            for (int m = 0; m < 4; ++m) { const int r = row0 + ai * HALF + m * 16; const float* xr = (r < mctx ? xp + (size_t)r * 1024 : xs + (size_t)(r - mctx) * 1024) + col0; float* yr = Y + (size_t)r * 1024 + col0;
#pragma unroll
                for (int bj = 0; bj < 2; ++bj)
#pragma unroll
                    for (int n = 0; n < 2; ++n) { const f32x4 xv = *(const f32x4*)(xr + bj * HALF + n * 16); *(f32x4*)(yr + bj * HALF + n * 16) = xv + gv[bj][n] * acc[ai][bj][m][n]; } }
    }
};

template <class Epi, class Sched, bool ALIGN_EPI = false, bool SP2 = false>
__device__ __forceinline__ void gemm_phase(PG8_LAS unsigned char* lds, const Gemm g, const Sched& S, const Epi& E) {
    const int tid = threadIdx.x, wid = __builtin_amdgcn_readfirstlane(tid >> 6), lane = tid & 63, wr = wid >> 2, wc = wid & 3, fr = lane & 15, fq = lane >> 4;
    const int K = g.K, nt = K / BK;
    unsigned voffA[2], voffB[2];
#pragma unroll
    for (int i = 0; i < 2; ++i) { int R, C; stage_rc(tid * 16 + i * 8192, R, C); const int Rb = Epi::PERM ? ((R & ~31) + perm32(R & 31)) : R;
        voffA[i] = (unsigned)(R * K + C) * 2u; voffB[i] = (unsigned)(Rb * K + C) * 2u; }
    const size_t kstep = (size_t)(BK * 2);
    const size_t hstep = (size_t)HALF * K * 2;
    const size_t tstep = 2 * hstep;
    const unsigned ldsw = (unsigned)wid * 1024u;
    const int aoff = lds_byte(wr * 64 + fr, fq * 8), boff = lds_byte(wc * 32 + fr, fq * 8);
#define PG8_SA(b, h) (((b) * 2 + (h)) * HTB)
#define PG8_SB(b, h) ((4 + (b) * 2 + (h)) * HTB)
#define PG8_STAGE(bufoff, gbase, voff) do { _Pragma("unroll") for (int _i = 0; _i < 2; ++_i) \
        __builtin_amdgcn_global_load_lds((const unsigned*)((const char*)(gbase) + (voff)[_i]), (PG8_LAS unsigned*)(lds + (bufoff) + ldsw + _i * 8192), 16, 0, 0); } while (0)
#define PG8_LDA(dst, b, h) do { _Pragma("unroll") for (int m = 0; m < 4; ++m) _Pragma("unroll") for (int k = 0; k < 2; ++k) dst[m][k] = *(const PG8_LAS bf16x8*)(lds + PG8_SA(b, h) + aoff + m * 2048 + k * 1024); } while (0)
#define PG8_LDB(dst, b, h) do { _Pragma("unroll") for (int n = 0; n < 2; ++n) _Pragma("unroll") for (int k = 0; k < 2; ++k) dst[n][k] = *(const PG8_LAS bf16x8*)(lds + PG8_SB(b, h) + boff + n * 2048 + k * 1024); } while (0)
#define PG8_MMA(ai, bj, At, Bt) do { __builtin_amdgcn_s_setprio(1); _Pragma("unroll") for (int m = 0; m < 4; ++m) _Pragma("unroll") for (int n = 0; n < 2; ++n) _Pragma("unroll") for (int k = 0; k < 2; ++k) \
        acc[ai][bj][m][n] = __builtin_amdgcn_mfma_f32_16x16x32_bf16(Bt[n][k], At[m][k], acc[ai][bj][m][n], 0, 0, 0); __builtin_amdgcn_s_setprio(0); } while (0)
#define PG8_WAIT_V(n) asm volatile("s_waitcnt vmcnt(" #n ")" ::: "memory")
#define PG8_WAIT_L(n) asm volatile("s_waitcnt lgkmcnt(" #n ")" ::: "memory")
#define PG8_BAR __builtin_amdgcn_s_barrier()
#define PG8_SCHED __builtin_amdgcn_sched_barrier(0)
    Unit cur, nxt; int ui = 0;
    if (!S.next(0, cur)) return;
    f32x4 acc[2][2][4][2];
#pragma unroll
    for (int a = 0; a < 2; ++a)
#pragma unroll
        for (int b = 0; b < 2; ++b)
#pragma unroll
            for (int m = 0; m < 4; ++m)
#pragma unroll
                for (int n = 0; n < 2; ++n) acc[a][b][m][n] = (f32x4){0.f, 0.f, 0.f, 0.f};
    bf16x8 At[4][2], B0[2][2], B1[2][2];
    const char* cA = (const char*)g.A + (size_t)cur.pm * tstep; const char* cB = (const char*)g.Bt + (size_t)cur.pn * tstep;
    S.a_ready(cur);
    if constexpr (SP2) {
        PG8_STAGE(PG8_SB(0, 0), cB, voffB); PG8_STAGE(PG8_SB(0, 1), cB + hstep, voffB); PG8_STAGE(PG8_SA(0, 0), cA, voffA); PG8_STAGE(PG8_SA(0, 1), cA + hstep, voffA);
        if (wr == 1) PG8_BAR;
        PG8_WAIT_V(2); PG8_BAR;
        PG8_STAGE(PG8_SB(1, 0), cB + kstep, voffB); PG8_STAGE(PG8_SA(1, 0), cA + kstep, voffA); PG8_STAGE(PG8_SB(1, 1), cB + hstep + kstep, voffB);
        PG8_WAIT_V(6); PG8_BAR;
    } else {
        PG8_STAGE(PG8_SB(0, 0), cB, voffB); PG8_STAGE(PG8_SA(0, 0), cA, voffA); PG8_STAGE(PG8_SB(0, 1), cB + hstep, voffB); PG8_STAGE(PG8_SA(0, 1), cA + hstep, voffA);
        if (wr == 1) PG8_BAR;
        PG8_WAIT_V(4); PG8_BAR;
        PG8_STAGE(PG8_SB(1, 0), cB + kstep, voffB); PG8_STAGE(PG8_SA(1, 0), cA + kstep, voffA); PG8_STAGE(PG8_SB(1, 1), cB + hstep + kstep, voffB);
        PG8_WAIT_V(6); PG8_BAR;
    }
    for (;;) {
        const bool has_next = S.next(ui + 1, nxt);
        const char* nA = has_next ? (const char*)g.A + (size_t)nxt.pm * tstep : cA; const char* nB = has_next ? (const char*)g.Bt + (size_t)nxt.pn * tstep : cB;
        for (int t = 0; t < nt; t += 2) {
            const bool last = (t == nt - 2);
            const char* a1 = cA + (size_t)(t + 1) * kstep;
            const char* a2 = last ? nA : cA + (size_t)(t + 2) * kstep; const char* b2 = last ? nB : cB + (size_t)(t + 2) * kstep;
            const char* a3 = a2 + kstep; const char* b3 = b2 + kstep;
            if (last && has_next) S.a_ready(nxt);
            if constexpr (SP2) {
            PG8_LDB(B0, 0, 0); PG8_LDB(B1, 0, 1); PG8_SCHED; PG8_LDA(At, 0, 0); PG8_STAGE(PG8_SA(1, 1), a1 + hstep, voffA);
            PG8_WAIT_V(8); PG8_WAIT_L(0); PG8_BAR; PG8_MMA(0, 0, At, B0); PG8_MMA(0, 1, At, B1); PG8_BAR; PG8_SCHED;
            PG8_LDA(At, 0, 1); PG8_STAGE(PG8_SB(0, 0), b2, voffB); PG8_STAGE(PG8_SB(0, 1), b2 + hstep, voffB); PG8_STAGE(PG8_SA(0, 0), a2, voffA);
            PG8_WAIT_V(8); PG8_WAIT_L(0); PG8_BAR; PG8_MMA(1, 0, At, B0); PG8_MMA(1, 1, At, B1); PG8_BAR; PG8_SCHED;
            PG8_LDB(B0, 1, 0); PG8_LDB(B1, 1, 1); PG8_SCHED; PG8_LDA(At, 1, 0); PG8_STAGE(PG8_SA(0, 1), a2 + hstep, voffA);
            PG8_WAIT_V(8); PG8_WAIT_L(0); PG8_BAR; PG8_MMA(0, 0, At, B0); PG8_MMA(0, 1, At, B1); PG8_BAR; PG8_SCHED;
            PG8_LDA(At, 1, 1); PG8_STAGE(PG8_SB(1, 0), b3, voffB); PG8_STAGE(PG8_SB(1, 1), b3 + hstep, voffB); PG8_STAGE(PG8_SA(1, 0), a3, voffA);
            PG8_WAIT_V(8); PG8_WAIT_L(0); PG8_BAR; PG8_MMA(1, 0, At, B0); PG8_MMA(1, 1, At, B1); PG8_BAR; PG8_SCHED;
            } else {
            PG8_LDB(B0, 0, 0); PG8_SCHED; PG8_LDA(At, 0, 0); PG8_STAGE(PG8_SA(1, 1), a1 + hstep, voffA);
            PG8_WAIT_L(8); PG8_BAR; PG8_WAIT_L(0); PG8_MMA(0, 0, At, B0); PG8_BAR; PG8_SCHED;
            PG8_LDB(B1, 0, 1); PG8_STAGE(PG8_SB(0, 0), b2, voffB);
            PG8_BAR; PG8_WAIT_L(0); PG8_MMA(0, 1, At, B1); PG8_BAR;
            PG8_LDA(At, 0, 1); PG8_STAGE(PG8_SA(0, 0), a2, voffA);
            PG8_BAR; PG8_WAIT_L(0); PG8_MMA(1, 0, At, B0); PG8_BAR; PG8_SCHED;
            PG8_STAGE(PG8_SB(0, 1), b2 + hstep, voffB);
            PG8_WAIT_V(6); PG8_BAR; PG8_MMA(1, 1, At, B1); PG8_BAR;
            PG8_LDB(B0, 1, 0); PG8_SCHED; PG8_LDA(At, 1, 0); PG8_STAGE(PG8_SA(0, 1), a2 + hstep, voffA);
            PG8_WAIT_L(8); PG8_BAR; PG8_WAIT_L(0); PG8_MMA(0, 0, At, B0); PG8_BAR; PG8_SCHED;
            PG8_LDB(B1, 1, 1); PG8_STAGE(PG8_SB(1, 0), b3, voffB);
            PG8_BAR; PG8_WAIT_L(0); PG8_MMA(0, 1, At, B1); PG8_BAR;
            PG8_LDA(At, 1, 1); PG8_STAGE(PG8_SA(1, 0), a3, voffA);
            PG8_BAR; PG8_WAIT_L(0); PG8_MMA(1, 0, At, B0); PG8_BAR; PG8_SCHED;
            PG8_STAGE(PG8_SB(1, 1), b3 + hstep, voffB);
            PG8_WAIT_V(6); PG8_BAR; PG8_MMA(1, 1, At, B1); PG8_BAR;
            }
        }
        if constexpr (ALIGN_EPI) { if (wr == 0) PG8_BAR; }
        if constexpr (!Epi::AFTER_DRAIN) { E(acc, cur, wr, wc, fr, fq); S.done(cur); }
        if (!has_next) break;
#pragma unroll
        for (int a = 0; a < 2; ++a)
#pragma unroll
            for (int b = 0; b < 2; ++b)
#pragma unroll
                for (int m = 0; m < 4; ++m)
#pragma unroll
                    for (int n = 0; n < 2; ++n) acc[a][b][m][n] = (f32x4){0.f, 0.f, 0.f, 0.f};
        cur = nxt; cA = nA; cB = nB; ++ui;
        if constexpr (ALIGN_EPI) { if (wr == 1) PG8_BAR; }
    }
    PG8_WAIT_V(0);
    if constexpr (!ALIGN_EPI) { if (wr == 0) PG8_BAR; }
    PG8_BAR;
    if constexpr (Epi::AFTER_DRAIN) { E.fused(acc, cur, wr, wc, fr, fq, lds, wid, lane); S.done(cur); }
#undef PG8_SA
#undef PG8_SB
#undef PG8_STAGE
#undef PG8_LDA
#undef PG8_LDB
#undef PG8_MMA
#undef PG8_WAIT_V
#undef PG8_WAIT_L
#undef PG8_BAR
#undef PG8_SCHED
}
}

struct Args {
    const float* in[23]; float* out; unsigned char* ws; int ph_lo, ph_hi;
};
struct Frame {
    LAS unsigned char* lds;
    int tid, lane, wave, G, wg;
    const float *x_prompt, *x_sample, *state_ret, *state_lru, *c, *c_ctx, *norm_w, *w_ada, *b_ada, *w_in, *decay_logit, *gn_w, *w_ret_down,
                *conv_w, *conv_b, *lru_wa, *lru_ba, *lru_wx, *lru_bx, *lru_a, *w_lru_down, *w_out, *final_norm_w;
    float* out; unsigned char* ws;
    bf16 *WinT, *WrdT, *WldT, *WoutT, *WlruT, *H, *Q, *K, *V, *XL, *GL, *HL, *SP, *SIGR, *SIGL, *MERGED, *OG;
    float *MOD, *AGG, *SS;
};

__device__ __forceinline__ float wave_sum(float v) {
#pragma unroll
    for (int o = 1; o < 64; o <<= 1) v += __shfl_xor(v, o);
    return v;
}
__device__ __forceinline__ const float* xrow_ptr(const Frame& F, int row) {
    return row < MCTX ? F.x_prompt + (size_t)row * D : F.x_sample + (size_t)(row - MCTX) * D;
}
__device__ __forceinline__ int mod_index(int row) { return row < MCTX ? 0 : 1 + (row - MCTX) / LLAT; }

__device__ __forceinline__ void p0_transpose_item(const float* W, int K, int N, bf16* WT, int drow0, int k0, int n0, LAS float* scr, int lane) {
#pragma unroll 8
    for (int i = 0; i < 32; ++i) { const int kk = 2 * i + (lane >> 5); scr[kk * 33 + (lane & 31)] = W[(size_t)(k0 + kk) * N + n0 + (lane & 31)]; }
    LDS_WAIT(); asm volatile("" ::: "memory");
    const int c = lane & 7;
#pragma unroll
    for (int j = 0; j < 4; ++j) { const int n = (lane >> 3) + 8 * j; const LAS float* s = scr + (8 * c) * 33 + n;
        v4u o; o.x = pk2(s[0 * 33], s[1 * 33]); o.y = pk2(s[2 * 33], s[3 * 33]); o.z = pk2(s[4 * 33], s[5 * 33]); o.w = pk2(s[6 * 33], s[7 * 33]);
        *(v4u*)(WT + (size_t)(drow0 + n) * K + k0 + 8 * c) = o; }
    LDS_WAIT(); asm volatile("" ::: "memory");
}
__device__ __forceinline__ int win_dst_row(int n) { return n < 4096 ? n : (n < 6144 ? n + 2560 : (n < 8704 ? n - 2048 : n)); }

__device__ __forceinline__ void phase_prep(Frame& F) {
    LAS float* scr = (LAS float*)(F.lds + F.wave * 16384);
    const int gw = F.wg * NWAVES + F.wave, NGW = F.G * NWAVES;
    constexpr int I_IN = (D / 64) * (DIN / 32), I_RD = (DRV / 64) * (D / 32), I_LD = (DL / 64) * (D / 32), I_OUT = (D / 64) * (D / 32), I_LRU = 40 * 8, I_MOD = 3072 / 64;
    constexpr int NITEMS = I_MOD + I_IN + I_RD + I_LD + I_OUT + I_LRU;
    for (int it = gw; it < NITEMS; it += NGW) {
        int r = it;
        if (r < I_MOD) {
            const int n = r * 64 + F.lane;
            float acc[5] = {0.f, 0.f, 0.f, 0.f, 0.f};
            for (int k = 0; k < D; ++k) {
                const float w = F.w_ada[(size_t)k * 3072 + n];
                acc[0] += siluf_(F.c_ctx[k]) * w;
#pragma unroll
                for (int v = 0; v < 4; ++v) acc[1 + v] += siluf_(F.c[v * D + k]) * w;
            }
            const float bb = F.b_ada[n];
#pragma unroll
            for (int v = 0; v < 5; ++v) F.MOD[v * 3072 + n] = acc[v] + bb;
            continue;
        }
        r -= I_MOD;
        if (r < I_IN) { const int nblk = DIN / 32, kb = r / nblk, nb = r % nblk; p0_transpose_item(F.w_in, D, DIN, F.WinT, win_dst_row(nb * 32), kb * 64, nb * 32, scr, F.lane); continue; }
        r -= I_IN;
        if (r < I_RD) { const int nblk = D / 32, kb = r / nblk, nb = r % nblk; p0_transpose_item(F.w_ret_down, DRV, D, F.WrdT, nb * 32, kb * 64, nb * 32, scr, F.lane); continue; }
        r -= I_RD;
        if (r < I_LD) { const int nblk = D / 32, kb = r / nblk, nb = r % nblk; p0_transpose_item(F.w_lru_down, DL, D, F.WldT, nb * 32, kb * 64, nb * 32, scr, F.lane); continue; }
        r -= I_LD;
        if (r < I_OUT) { const int nblk = D / 32, kb = r / nblk, nb = r % nblk; p0_transpose_item(F.w_out, D, D, F.WoutT, nb * 32, kb * 64, nb * 32, scr, F.lane); continue; }
        r -= I_OUT;
        {
            const int mi = r / 8, sub = r % 8, slot = mi / NB, hb = mi % NB, kb = sub / 4, nb = sub % 4;
            const float* W = ((slot & 1) ? F.lru_wx : F.lru_wa) + (size_t)((slot >> 1) * NB + hb) * LB * LB;
            p0_transpose_item(W, LB, LB, F.WlruT + (size_t)hb * 512 * LB, slot * 128 + nb * 32, kb * 64, nb * 32, scr, F.lane);
        }
    }
}

__device__ __forceinline__ void phase_h(Frame& F) {
    const int gw = F.wg * NWAVES + F.wave, NGW = F.G * NWAVES;
    for (int m = gw; m < M; m += NGW) {
        const f32x4* xr = (const f32x4*)xrow_ptr(F, m) + F.lane;
        const float* mod = F.MOD + mod_index(m) * 3072;
        f32x4 v[4]; float s = 0.f;
#pragma unroll
        for (int j = 0; j < 4; ++j) { v[j] = xr[64 * j]; s += (v[j].x * v[j].x + v[j].y * v[j].y) + (v[j].z * v[j].z + v[j].w * v[j].w); }
        const float rstd = 1.0f / sqrtf(wave_sum(s) * (1.f / D) + EPS);
        unsigned long long* o8 = (unsigned long long*)(F.H + (size_t)m * D) + F.lane;
#pragma unroll
        for (int j = 0; j < 4; ++j) {
            const int c0 = 4 * F.lane + 256 * j;
            const f32x4 nw = *(const f32x4*)(F.norm_w + c0), sh = *(const f32x4*)(mod + c0), sc = *(const f32x4*)(mod + 1024 + c0);
            const f32x4 h = v[j] * rstd * nw * (sc + 1.0f) + sh;
            o8[64 * j] = (unsigned long long)pk2(h.x, h.y) | ((unsigned long long)pk2(h.z, h.w) << 32);
        }
    }
}

template <class Epi>
__device__ __forceinline__ void gemm_simple(const Frame& F, const bf16* A, int lda, const bf16* Bt, int ldb, int Mr, int Nc, int K, const Epi& epi) {
    const int wr = F.wave >> 2, wc = F.wave & 3, fr = F.lane & 15, fq = F.lane >> 4;
    const int tilesN = Nc / 256, tiles = (Mr / 128) * tilesN;
    for (int t = F.wg; t < tiles; t += F.G) {
        const int tm = t / tilesN, tn = t % tilesN;
        const int row0 = tm * 128 + wr * 64, col0 = tn * 256 + wc * 64;
        f32x4 acc[4][4];
#pragma unroll
        for (int i = 0; i < 4; ++i)
#pragma unroll
            for (int j = 0; j < 4; ++j) acc[i][j] = (f32x4){0.f, 0.f, 0.f, 0.f};
        const bf16* ap = A + (size_t)(row0 + fr) * lda + 8 * fq;
        const bf16* bp = Bt + (size_t)(col0 + fr) * ldb + 8 * fq;
        for (int k0 = 0; k0 < K; k0 += 32) {
            bf16x8 a[4], b[4];
#pragma unroll
            for (int i = 0; i < 4; ++i) a[i] = *(const bf16x8*)(ap + (size_t)(16 * i) * lda + k0);
#pragma unroll
            for (int j = 0; j < 4; ++j) b[j] = *(const bf16x8*)(bp + (size_t)(16 * j) * ldb + k0);
#pragma unroll
            for (int i = 0; i < 4; ++i)
#pragma unroll
                for (int j = 0; j < 4; ++j) acc[i][j] = __builtin_amdgcn_mfma_f32_16x16x32_bf16(a[i], b[j], acc[i][j], 0, 0, 0);
        }
#pragma unroll
        for (int i = 0; i < 4; ++i)
#pragma unroll
            for (int j = 0; j < 4; ++j)
#pragma unroll
                for (int r = 0; r < 4; ++r) epi(row0 + 16 * i + 4 * fq + r, col0 + 16 * j + fr, acc[i][j][r]);
    }
}

struct EpiGemm1 {
    bf16 *Q, *K, *V, *XL, *GL;
    __device__ __forceinline__ void operator()(int row, int col, float v) const {
        if (col < 1024) Q[(size_t)row * 1024 + col] = (bf16)f2bf(v);
        else if (col < 2048) K[(size_t)row * 1024 + col - 1024] = (bf16)f2bf(v * 0.0625f);
        else if (col < 4096) V[(size_t)row * 2048 + col - 2048] = (bf16)f2bf(v);
        else if (col < 5376) XL[(size_t)row * 1280 + col - 4096] = (bf16)f2bf(v);
        else GL[(size_t)row * 1280 + col - 5376] = (bf16)f2bf(siluf_(v));
    }
};
struct EpiGemm2 {
    bf16 *OG, *SIGR, *SIGL;
    __device__ __forceinline__ void operator()(int row, int col, float v) const {
        if (col < 2048) { bf16* p = OG + (size_t)row * 2048 + col; *p = (bf16)f2bf(bf2f(*p) * siluf_(v)); }
        else if (col < 3072) SIGR[(size_t)row * 1024 + col - 2048] = (bf16)f2bf(sigmoidf_(v));
        else SIGL[(size_t)row * 1024 + col - 3072] = (bf16)f2bf(sigmoidf_(v));
    }
};
struct EpiDownR { bf16 *MERGED; const bf16* SIG;
    __device__ __forceinline__ void operator()(int row, int col, float v) const { const size_t o = (size_t)row * 1024 + col; MERGED[o] = (bf16)f2bf(bf2f(SIG[o]) * v); } };
struct EpiDownL { bf16 *MERGED; const bf16* SIG;
    __device__ __forceinline__ void operator()(int row, int col, float v) const { const size_t o = (size_t)row * 1024 + col; MERGED[o] = (bf16)f2bf(bf2f(MERGED[o]) + bf2f(SIG[o]) * v); } };
struct EpiOut { float* Y; const float *xp, *xs, *MOD;
    __device__ __forceinline__ void operator()(int row, int col, float v) const {
        const float xv = row < MCTX ? xp[(size_t)row * D + col] : xs[(size_t)(row - MCTX) * D + col];
        Y[(size_t)row * D + col] = xv + MOD[mod_index(row) * 3072 + 2048 + col] * v;
    } };

__device__ __forceinline__ void lru_item(Frame& F, int T, int hb, bool fin) {
    const int row0 = 64 * T, tid = F.tid;
    int b, seq0, L; bool lat;
    if (row0 < MCTX) { b = row0 / LCTX; seq0 = b * LCTX; L = LCTX; lat = false; } else { b = (row0 - MCTX) / LLAT; seq0 = MCTX + b * LLAT; L = LLAT; lat = true; }
    const int p0 = row0 - seq0, ti = p0 / 64, ntile = L / 64;
    LAS float* xc = (LAS float*)F.lds; LAS float* a_s = xc + 8192; LAS float* b_s = xc + 16384; LAS float* hf_s = xc + 24576;
    for (int idx = tid; idx < 64 * 128; idx += NTHR) {
        const int t = idx >> 7, c = idx & 127, ch = hb * 128 + c;
        float acc = F.conv_b[ch];
#pragma unroll
        for (int tap = 0; tap < 4; ++tap) {
            const int tt = t + tap - 2; bool ok;
            if (lat) ok = (tt >= 0 && tt < 64); else { const int p = p0 + tt; ok = (p >= 0 && p < L); }
            if (ok) acc += F.conv_w[tap * DL + ch] * bf2f(F.XL[(size_t)(row0 + tt) * DL + ch]);
        }
        xc[idx] = acc;
    }
    __syncthreads();
    const int c = tid & 127, tg = tid >> 7, ch = hb * 128 + c;
    const bf16* W = F.WlruT + (size_t)hb * 512 * LB;
#pragma unroll 1
    for (int dir = 0; dir < 2; ++dir) {
        float acc[2][16];
#pragma unroll
        for (int s = 0; s < 2; ++s)
#pragma unroll
            for (int t = 0; t < 16; ++t) acc[s][t] = 0.f;
        const bf16* W0 = W + (size_t)((2 * dir) * 128 + c) * LB; const bf16* W1 = W + (size_t)((2 * dir + 1) * 128 + c) * LB;
#pragma unroll 2
        for (int i = 0; i < 128; ++i) {
            const float w0 = bf2f(W0[i]), w1 = bf2f(W1[i]);
#pragma unroll
            for (int t = 0; t < 16; ++t) { const float xv = bfr(xc[(tg * 16 + t) * 128 + i]); acc[0][t] += xv * w0; acc[1][t] += xv * w1; }
        }
        const float ba = F.lru_ba[dir * DL + ch], bx = F.lru_bx[dir * DL + ch];
        const float sp = log1pf(expf(-F.lru_a[dir * DL + ch]));
#pragma unroll
        for (int t = 0; t < 16; ++t) {
            const int tok = tg * 16 + t;
            const float r = sigmoidf_(acc[0][t] + ba), gi = sigmoidf_(acc[1][t] + bx);
            const float la = -8.0f * r * sp;
            a_s[tok * 128 + c] = expf(la);
            b_s[tok * 128 + c] = sqrtf(-expm1f(2.0f * la)) * gi * xc[tok * 128 + c];
        }
        __syncthreads();
        if (tid < 128) {
            const int cc = tid, chh = hb * 128 + cc;
            float carry = 0.f;
            if (fin) {
                carry = lat ? F.state_lru[(size_t)(b * 2 + dir) * DL + chh] : 0.f;
                if (dir == 0) { for (int n = 0; n < ti; ++n) { const float* ag = F.AGG + ((size_t)((T - ti + n) * 2 + 0) * 2) * DL; carry = ag[chh] * carry + ag[DL + chh]; } }
                else { for (int n = ntile - 1; n > ti; --n) { const float* ag = F.AGG + ((size_t)((T - ti + n) * 2 + 1) * 2) * DL; carry = ag[chh] * carry + ag[DL + chh]; } }
            }
            float h = carry, P = 1.f;
            if (dir == 0) {
                for (int t = 0; t < 64; ++t) { const float a = a_s[t * 128 + cc]; h = a * h + b_s[t * 128 + cc]; P *= a; if (fin) hf_s[t * 128 + cc] = h; }
                if (fin && !lat && ti == ntile - 1) F.out[OUT_NSL + (size_t)(b * 2 + 0) * DL + chh] = h;
            } else {
                for (int t = 63; t >= 0; --t) { const float a = a_s[t * 128 + cc]; h = a * h + b_s[t * 128 + cc]; P *= a; if (fin) hf_s[t * 128 + cc] += h; }
                if (fin && !lat && ti == 0) F.out[OUT_NSL + (size_t)(b * 2 + 1) * DL + chh] = h;
            }
            if (!fin) { float* ag = F.AGG + ((size_t)(T * 2 + dir) * 2) * DL; ag[chh] = P; ag[DL + chh] = h; }
        }
        __syncthreads();
    }
    if (fin) {
        for (int idx = tid; idx < 64 * 128; idx += NTHR) {
            const int t = idx >> 7, cc = idx & 127; const size_t o = (size_t)(row0 + t) * DL + hb * 128 + cc;
            F.HL[o] = (bf16)f2bf(hf_s[idx] * bf2f(F.GL[o]));
        }
    }
    __syncthreads();
}
__device__ __forceinline__ void phase_lru(Frame& F, bool fin) {
    for (int it = F.wg; it < (M / 64) * NB; it += F.G) lru_item(F, it / NB, it % NB, fin);
}

__device__ __forceinline__ float log_gamma(const Frame& F, int dir, int h) { const float x = F.decay_logit[dir * NH + h]; return -log1pf(expf(-x)); }
__device__ __forceinline__ size_t sp_index(int b, int h, int dir, int n) { return ((size_t)(((b * NH + h) * 2 + dir) * NCH_LAT + n)) * (DK * DV); }
__device__ __forceinline__ void phase_r12(Frame& F) {
    const int e = F.tid;
    constexpr int ITEMS = (NCTX + NLAT) * NH * 2 * (DK / 4);
    for (int it = F.wg; it < ITEMS; it += F.G) {
        int r = it; const int dg = r % (DK / 4); r /= (DK / 4); const int dir = r & 1; r >>= 1; const int h = r % NH; const int s = r / NH;
        const bool lat = s >= NCTX; const int b = lat ? s - NCTX : s; const int L = lat ? LLAT : LCTX; const int seq0 = lat ? MCTX + b * LLAT : b * LCTX;
        const float g = expf(log_gamma(F, dir, h));
        float S[4];
#pragma unroll
        for (int u = 0; u < 4; ++u) S[u] = lat ? F.state_ret[((size_t)((b * 2 + dir) * NH + h) * DK + dg * 4 + u) * DV + e] : 0.f;
        const int nch = L / CH;
        for (int nn = 0; nn < nch; ++nn) {
            const int n = dir == 0 ? nn : nch - 1 - nn;
            if (lat) {
#pragma unroll
                for (int u = 0; u < 4; ++u) F.SP[sp_index(b, h, dir, n) + (size_t)(dg * 4 + u) * DV + e] = (bf16)f2bf(S[u]);
            }
            for (int ii = 0; ii < CH; ++ii) {
                const int i = dir == 0 ? ii : CH - 1 - ii; const size_t row = (size_t)seq0 + n * CH + i;
                const float vv = bf2f(F.V[row * DRV + h * DV + e]);
                const unsigned long long kk = *(const unsigned long long*)(F.K + row * DQK + h * DK + dg * 4);
#pragma unroll
                for (int u = 0; u < 4; ++u) S[u] = g * S[u] + bf2f((unsigned short)(kk >> (16 * u))) * vv;
            }
        }
        if (!lat) {
#pragma unroll
            for (int u = 0; u < 4; ++u) F.out[OUT_NSR + ((size_t)((b * 2 + dir) * NH + h) * DK + dg * 4 + u) * DV + e] = S[u];
        }
    }
}

__device__ __forceinline__ void phase_r3(Frame& F) {
    LAS float* qs = (LAS float*)F.lds; LAS float* Ps = qs + 256; LAS float* red = qs + 512;
    const int tid = F.tid;
    for (int it = F.wg; it < M * NH; it += F.G) {
        const int row = it / NH, h = it % NH;
        const bool lat = row >= MCTX; const int b = lat ? (row - MCTX) / LLAT : row / LCTX; const int seq0 = lat ? MCTX + b * LLAT : b * LCTX;
        const int p = row - seq0, n = p / CH, i = p % CH, crow0 = row - i;
        const float lgf = log_gamma(F, 0, h), lgb = log_gamma(F, 1, h);
        if (tid < 256) qs[tid] = bf2f(F.Q[(size_t)row * DQK + h * DK + tid]);
        __syncthreads();
        if (tid < 256) {
            const int j = tid; const bf16* kr = F.K + (size_t)(crow0 + j) * DQK + h * DK; float s = 0.f;
            for (int d = 0; d < DK; d += 8) { const v4u kv = *(const v4u*)(kr + d);
                s += qs[d] * bf2f((unsigned short)kv.x) + qs[d + 1] * bf2f((unsigned short)(kv.x >> 16)) + qs[d + 2] * bf2f((unsigned short)kv.y) + qs[d + 3] * bf2f((unsigned short)(kv.y >> 16))
                   + qs[d + 4] * bf2f((unsigned short)kv.z) + qs[d + 5] * bf2f((unsigned short)(kv.z >> 16)) + qs[d + 6] * bf2f((unsigned short)kv.w) + qs[d + 7] * bf2f((unsigned short)(kv.w >> 16)); }
            const int dj = i - j; const float dec = dj >= 0 ? expf(lgf * (float)dj) : expf(lgb * (float)(-dj));
            Ps[j] = bfr(s * dec);
        }
        __syncthreads();
        const int e = tid; float acc = 0.f;
        for (int j = 0; j < CH; ++j) acc += Ps[j] * bf2f(F.V[(size_t)(crow0 + j) * DRV + h * DV + e]);
        if (lat) {
            const bf16* sf = F.SP + sp_index(b, h, 0, n); const bf16* sb = F.SP + sp_index(b, h, 1, n);
            float af = 0.f, ab = 0.f;
            for (int d = 0; d < DK; ++d) { af += qs[d] * bf2f(sf[(size_t)d * DV + e]); ab += qs[d] * bf2f(sb[(size_t)d * DV + e]); }
            acc += expf(lgf * (float)(i + 1)) * af + expf(lgb * (float)(CH - i)) * ab;
        }
        float ss = wave_sum(acc * acc);
        if (F.lane == 0) red[F.wave] = ss;
        __syncthreads();
        ss = 0.f;
#pragma unroll
        for (int w = 0; w < NWAVES; ++w) ss += red[w];
        const float sc = 1.0f / sqrtf(ss * (1.0f / DV) + EPS);
        F.OG[(size_t)row * DRV + h * DV + e] = (bf16)f2bf(acc * sc * F.gn_w[h * DV + e]);
        __syncthreads();
    }
}


typedef float f32x16 __attribute__((ext_vector_type(16)));
typedef short s16x4 __attribute__((ext_vector_type(4)));
typedef short v4i16_t __attribute__((ext_vector_type(4)));
typedef float f32x2_t __attribute__((ext_vector_type(2))); typedef __bf16 bf16x2_t __attribute__((ext_vector_type(2)));
typedef LAS const char* lds_cptr;
#define MFMA32(a, b, c) __builtin_amdgcn_mfma_f32_32x32x16_bf16((a), (b), (c), 0, 0, 0)
__device__ __forceinline__ int crow(int reg, int hh) { return (reg & 3) + 8 * (reg >> 2) + 4 * hh; }
__device__ __forceinline__ s16x4 vtr(lds_cptr p) { return __builtin_bit_cast(s16x4, __builtin_amdgcn_ds_read_tr16_b64_v4i16((LAS v4i16_t*)p)); }
__device__ __forceinline__ unsigned cvtpk(float lo, float hi) { f32x2_t v = {lo, hi}; bf16x2_t b = __builtin_convertvector(v, bf16x2_t); return __builtin_bit_cast(unsigned, b); }
__device__ __forceinline__ bf16x8 cat8(s16x4 lo, s16x4 hi) { return (bf16x8){lo[0], lo[1], lo[2], lo[3], hi[0], hi[1], hi[2], hi[3]}; }
__device__ __forceinline__ float ulo(unsigned w) { return __builtin_bit_cast(float, w << 16); }
__device__ __forceinline__ float uhi(unsigned w) { return __builtin_bit_cast(float, w & 0xffff0000u); }

constexpr int EQ = 128, NET = EQ / 32;
constexpr int KSTR = 528;
constexpr int KTSTR = 576;
constexpr int VSTR = 320;
constexpr int R3_KB0 = 0, R3_KB1 = 32 * KSTR, R3_VB0 = 2 * 32 * KSTR, R3_VB1 = R3_VB0 + 32 * VSTR;
constexpr int R12_KB0 = 0, R12_KB1 = 32 * KTSTR, R12_VB0 = 2 * 32 * KTSTR, R12_VB1 = R12_VB0 + 32 * VSTR;

__device__ __forceinline__ void r3f_item(Frame& F, int it) {
    bool lat; int b, n, h, eq;
    if (it < NLAT * NCH_LAT * NH * 4) { lat = true; eq = it & 3; h = (it >> 2) & 3; n = (it >> 4) & 7; b = it >> 7; }
    else { const int i2 = it - NLAT * NCH_LAT * NH * 4; lat = false; eq = i2 & 3; h = (i2 >> 2) & 3; n = 0; b = i2 >> 4; }
    const int seq0 = lat ? MCTX + b * LLAT : b * LCTX, row0 = seq0 + n * CH;
    const int tid = F.tid, lane = F.lane, w = F.wave, r32 = lane & 31, hh = lane >> 5;
    const float lgf = log_gamma(F, 0, h), lgb = log_gamma(F, 1, h);
    LAS char* lds = (LAS char*)F.lds;
    bf16x8 qf[16];
    { const bf16* qp = F.Q + (size_t)(row0 + 32 * w + r32) * DQK + h * DK + 8 * hh;
#pragma unroll
      for (int ks = 0; ks < 16; ++ks) qf[ks] = *(const bf16x8*)(qp + 16 * ks); }
    f32x16 acc[NET];
#pragma unroll
    for (int et = 0; et < NET; ++et)
#pragma unroll
        for (int r = 0; r < 16; ++r) acc[et][r] = 0.f;
    const int vrow = tid >> 4, vch = tid & 15;
    const int blk = (lane >> 4) & 1, q4 = (lane & 15) >> 2, p4 = lane & 3;
    const int trn = (8 * hh + q4) * VSTR + 32 * blk + 8 * p4;
    const int trp = (4 * hh + q4) * VSTR + 32 * blk + 8 * p4;
    if (lat) {
#pragma unroll 1
        for (int dir = 0; dir < 2; ++dir) {
            const bf16* sp = F.SP + sp_index(b, h, dir, n) + eq * EQ;
            { const v4u v = *(const v4u*)(sp + (size_t)vrow * DV + vch * 8); *(LAS v4u*)(lds + R3_VB0 + vrow * VSTR + vch * 16) = v; }
            __syncthreads();
#pragma unroll
            for (int db = 0; db < 8; ++db) {
                v4u nv = {0u, 0u, 0u, 0u};
                if (db < 7) nv = *(const v4u*)(sp + (size_t)(32 * (db + 1) + vrow) * DV + vch * 8);
                lds_cptr vb = lds + ((db & 1) ? R3_VB1 : R3_VB0);
#pragma unroll
                for (int ks2 = 0; ks2 < 2; ++ks2)
#pragma unroll
                    for (int et = 0; et < NET; ++et) {
                        const s16x4 lo = vtr(vb + trn + (16 * ks2) * VSTR + 64 * et), hi = vtr(vb + trn + (16 * ks2 + 4) * VSTR + 64 * et);
                        acc[et] = MFMA32(qf[2 * db + ks2], cat8(lo, hi), acc[et]);
                    }
                if (db < 7) *(LAS v4u*)(lds + ((db & 1) ? R3_VB0 : R3_VB1) + vrow * VSTR + vch * 16) = nv;
                __syncthreads();
            }
#pragma unroll
            for (int r = 0; r < 16; ++r) {
                const float i = (float)(32 * w + crow(r, hh));
                const float f = dir == 0 ? __expf(lgf * (i + 1.0f) - lgb * (256.0f - i)) : __expf(lgb * (256.0f - i));
#pragma unroll
                for (int et = 0; et < NET; ++et) acc[et][r] *= f;
            }
        }
    }
    {
        const bf16* kp = F.K + (size_t)row0 * DQK + h * DK; const bf16* vp = F.V + (size_t)row0 * DRV + h * DV + eq * EQ;
        const int krow0 = tid >> 5, kch = tid & 31;
        { const v4u k0 = *(const v4u*)(kp + (size_t)krow0 * DQK + kch * 8), k1 = *(const v4u*)(kp + (size_t)(krow0 + 16) * DQK + kch * 8);
          const v4u v0 = *(const v4u*)(vp + (size_t)vrow * DRV + vch * 8);
          *(LAS v4u*)(lds + R3_KB0 + krow0 * KSTR + kch * 16) = k0; *(LAS v4u*)(lds + R3_KB0 + (krow0 + 16) * KSTR + kch * 16) = k1;
          *(LAS v4u*)(lds + R3_VB0 + vrow * VSTR + vch * 16) = v0; }
        __syncthreads();
#pragma unroll 1
        for (int jb = 0; jb < 8; ++jb) {
            const int cur = jb & 1;
            v4u k0 = {0u, 0u, 0u, 0u}, k1 = k0, v0 = k0;
            if (jb < 7) { const size_t r1 = (size_t)(32 * (jb + 1));
                k0 = *(const v4u*)(kp + (r1 + krow0) * DQK + kch * 8); k1 = *(const v4u*)(kp + (r1 + krow0 + 16) * DQK + kch * 8);
                v0 = *(const v4u*)(vp + (r1 + vrow) * DRV + vch * 8); }
            lds_cptr kb = lds + (cur ? R3_KB1 : R3_KB0) + r32 * KSTR + 16 * hh;
            lds_cptr vb = lds + (cur ? R3_VB1 : R3_VB0);
            f32x16 X;
#pragma unroll
            for (int r = 0; r < 16; ++r) X[r] = 0.f;
#pragma unroll
            for (int ks = 0; ks < 16; ++ks) { const bf16x8 a = *(const LAS bf16x8*)(kb + 32 * ks); X = MFMA32(a, qf[ks], X); }
            const int qi = 32 * w + r32;
#pragma unroll
            for (int r = 0; r < 16; ++r) { const int dj = qi - (32 * jb + crow(r, hh)); X[r] *= dj >= 0 ? __expf(lgf * (float)dj) : __expf(-lgb * (float)dj); }
            bf16x8 pa[2];
#pragma unroll
            for (int s2 = 0; s2 < 2; ++s2) { const unsigned u0 = cvtpk(X[8 * s2], X[8 * s2 + 1]), u1 = cvtpk(X[8 * s2 + 2], X[8 * s2 + 3]), u2 = cvtpk(X[8 * s2 + 4], X[8 * s2 + 5]), u3 = cvtpk(X[8 * s2 + 6], X[8 * s2 + 7]);
                pa[s2] = __builtin_bit_cast(bf16x8, (v4u){u0, u1, u2, u3}); }
#pragma unroll
            for (int s2 = 0; s2 < 2; ++s2)
#pragma unroll
                for (int et = 0; et < NET; ++et) {
                    const s16x4 lo = vtr(vb + trp + (16 * s2) * VSTR + 64 * et), hi = vtr(vb + trp + (16 * s2 + 8) * VSTR + 64 * et);
                    acc[et] = MFMA32(pa[s2], cat8(lo, hi), acc[et]);
                }
            if (jb < 7) { LAS char* kn = lds + (cur ? R3_KB0 : R3_KB1); LAS char* vn = lds + (cur ? R3_VB0 : R3_VB1);
                *(LAS v4u*)(kn + krow0 * KSTR + kch * 16) = k0; *(LAS v4u*)(kn + (krow0 + 16) * KSTR + kch * 16) = k1; *(LAS v4u*)(vn + vrow * VSTR + vch * 16) = v0; }
            __syncthreads();
        }
    }
#pragma unroll
    for (int r = 0; r < 16; ++r) {
        float ss = 0.f;
#pragma unroll
        for (int et = 0; et < NET; ++et) ss += acc[et][r] * acc[et][r];
#pragma unroll
        for (int o = 1; o < 32; o <<= 1) ss += __shfl_xor(ss, o);
        const int row = row0 + 32 * w + crow(r, hh);
        if (r32 == 0) F.SS[((size_t)row * NH + h) * 4 + eq] = ss;
        bf16* op = F.OG + (size_t)row * DRV + h * DV + eq * EQ + r32;
#pragma unroll
        for (int et = 0; et < NET; ++et) op[32 * et] = (bf16)f2bf(acc[et][r]);
    }
}
__device__ __forceinline__ void phase_r3f(Frame& F) {
    for (int it = F.wg; it < (NLAT * NCH_LAT + NCTX) * NH * 4; it += F.G) r3f_item(F, it);
}

__device__ __forceinline__ void r12f_item(Frame& F, int it) {
    bool lat; int b, h, dir, eq;
    if (it < NLAT * NH * 2 * 4) { lat = true; eq = it & 3; dir = (it >> 2) & 1; h = (it >> 3) & 3; b = it >> 5; }
    else { const int i2 = it - NLAT * NH * 2 * 4; lat = false; eq = i2 & 3; dir = (i2 >> 2) & 1; h = (i2 >> 3) & 3; b = i2 >> 5; }
    const int seq0 = lat ? MCTX + b * LLAT : b * LCTX;
    const int tid = F.tid, lane = F.lane, w = F.wave, r32 = lane & 31, hh = lane >> 5;
    const float lg = log_gamma(F, dir, h);
    LAS char* lds = (LAS char*)F.lds;
    f32x16 acc[NET];
    if (lat) {
        const float* s0 = F.state_ret + ((size_t)((b * 2 + dir) * NH + h) * DK) * DV + eq * EQ + r32;
#pragma unroll
        for (int et = 0; et < NET; ++et)
#pragma unroll
            for (int r = 0; r < 16; ++r) acc[et][r] = s0[(size_t)(32 * w + crow(r, hh)) * DV + 32 * et];
    } else {
#pragma unroll
        for (int et = 0; et < NET; ++et)
#pragma unroll
            for (int r = 0; r < 16; ++r) acc[et][r] = 0.f;
    }
    const int nproc = lat ? NCH_LAT - 1 : 1;
    const int nblocks = nproc * 8;
    const int vrow = tid >> 4, vch = tid & 15, krow0 = tid >> 5, kch = tid & 31;
    const int blk = (lane >> 4) & 1, q4 = (lane & 15) >> 2, p4 = lane & 3;
    const int tra = (8 * hh + q4) * KTSTR + 64 * w + 32 * blk + 8 * p4;
    const int trb = (8 * hh + q4) * VSTR + 32 * blk + 8 * p4;
    const bf16* kp = F.K + (size_t)seq0 * DQK + h * DK; const bf16* vp = F.V + (size_t)seq0 * DRV + h * DV + eq * EQ;
    const float g256 = __expf(lg * 256.0f);
    const int nch = lat ? NCH_LAT : 1;
    v4u k0, k1, v0;
#define R12_LOAD(t) do { const int cn_ = (t) >> 3, tb_ = (t) & 7, n_ = dir ? nch - 1 - cn_ : cn_; const size_t r_ = (size_t)(n_ * CH + 32 * tb_); \
        k0 = *(const v4u*)(kp + (r_ + krow0) * DQK + kch * 8); k1 = *(const v4u*)(kp + (r_ + krow0 + 16) * DQK + kch * 8); \
        const v4u vv_ = *(const v4u*)(vp + (r_ + vrow) * DRV + vch * 8); const int pos_ = 32 * tb_ + vrow; \
        const float dec_ = __expf(lg * (float)(dir ? pos_ : 255 - pos_)); \
        v0.x = cvtpk(ulo(vv_.x) * dec_, uhi(vv_.x) * dec_); v0.y = cvtpk(ulo(vv_.y) * dec_, uhi(vv_.y) * dec_); v0.z = cvtpk(ulo(vv_.z) * dec_, uhi(vv_.z) * dec_); v0.w = cvtpk(ulo(vv_.w) * dec_, uhi(vv_.w) * dec_); } while (0)
#define R12_STORE(buf) do { LAS char* kn_ = lds + ((buf) ? R12_KB1 : R12_KB0); LAS char* vn_ = lds + ((buf) ? R12_VB1 : R12_VB0); \
        *(LAS v4u*)(kn_ + krow0 * KTSTR + kch * 16) = k0; *(LAS v4u*)(kn_ + (krow0 + 16) * KTSTR + kch * 16) = k1; *(LAS v4u*)(vn_ + vrow * VSTR + vch * 16) = v0; } while (0)
    R12_LOAD(0); R12_STORE(0);
    __syncthreads();
#pragma unroll 1
    for (int t = 0; t < nblocks; ++t) {
        const int cur = t & 1;
        if ((t & 7) == 0) {
            if (lat) {
                const int cn = t >> 3, n = dir ? nch - 1 - cn : cn;
                bf16* sp = F.SP + sp_index(b, h, dir, n) + eq * EQ + r32;
#pragma unroll
                for (int et = 0; et < NET; ++et)
#pragma unroll
                    for (int r = 0; r < 16; ++r) sp[(size_t)(32 * w + crow(r, hh)) * DV + 32 * et] = (bf16)f2bf(acc[et][r]);
            }
#pragma unroll
            for (int et = 0; et < NET; ++et)
#pragma unroll
                for (int r = 0; r < 16; ++r) acc[et][r] *= g256;
        }
        if (t + 1 < nblocks) R12_LOAD(t + 1);
        lds_cptr kb = lds + (cur ? R12_KB1 : R12_KB0), vb = lds + (cur ? R12_VB1 : R12_VB0);
#pragma unroll
        for (int ks2 = 0; ks2 < 2; ++ks2) {
            const bf16x8 a = cat8(vtr(kb + tra + (16 * ks2) * KTSTR), vtr(kb + tra + (16 * ks2 + 4) * KTSTR));
#pragma unroll
            for (int et = 0; et < NET; ++et) {
                const bf16x8 bb = cat8(vtr(vb + trb + (16 * ks2) * VSTR + 64 * et), vtr(vb + trb + (16 * ks2 + 4) * VSTR + 64 * et));
                acc[et] = MFMA32(a, bb, acc[et]);
            }
        }
        if (t + 1 < nblocks) R12_STORE(cur ^ 1);
        __syncthreads();
    }
#undef R12_LOAD
#undef R12_STORE
    if (lat) {
        const int n = dir ? 0 : nch - 1;
        bf16* sp = F.SP + sp_index(b, h, dir, n) + eq * EQ + r32;
#pragma unroll
        for (int et = 0; et < NET; ++et)
#pragma unroll
            for (int r = 0; r < 16; ++r) sp[(size_t)(32 * w + crow(r, hh)) * DV + 32 * et] = (bf16)f2bf(acc[et][r]);
    } else {
        float* op = F.out + OUT_NSR + ((size_t)((b * 2 + dir) * NH + h) * DK) * DV + eq * EQ + r32;
#pragma unroll
        for (int et = 0; et < NET; ++et)
#pragma unroll
            for (int r = 0; r < 16; ++r) op[(size_t)(32 * w + crow(r, hh)) * DV + 32 * et] = acc[et][r];
    }
}
__device__ __forceinline__ void phase_r12f(Frame& F) {
    constexpr int NLI = NLAT * NH * 2 * 4, NCI = NCTX * NH * 2 * 4;
    if (F.G == 256) {
        if (F.wg < NLI) r12f_item(F, F.wg);
        else { for (int j = 0; j < 4; ++j) r12f_item(F, NLI + (F.wg - NLI) * 4 + j); }
    } else {
        for (int it = F.wg; it < NLI + NCI; it += F.G) r12f_item(F, it);
    }
}

__device__ __forceinline__ void phase_norm(Frame& F) {
    const int gw = F.wg * NWAVES + F.wave, NGW = F.G * NWAVES;
    for (int m = gw; m < M; m += NGW) {
        f32x4* yr = (f32x4*)(F.out + OUT_Y + (size_t)m * D) + F.lane;
        f32x4 v[4]; float s = 0.f;
#pragma unroll
        for (int j = 0; j < 4; ++j) { v[j] = yr[64 * j]; s += (v[j].x * v[j].x + v[j].y * v[j].y) + (v[j].z * v[j].z + v[j].w * v[j].w); }
        const float rstd = 1.0f / sqrtf(wave_sum(s) * (1.f / D) + EPS);
#pragma unroll
        for (int j = 0; j < 4; ++j) { const f32x4 nw = *(const f32x4*)(F.final_norm_w + 4 * F.lane + 256 * j); yr[64 * j] = v[j] * rstd * nw; }
    }
}

constexpr int PH_PREP = 0, PH_H = 1, PH_GEMM1 = 2, PH_LRUA = 3, PH_LRUB = 4, PH_R12 = 5, PH_R3 = 6, PH_G2 = 7, PH_DOWN = 8, PH_OUT = 9, PH_NORM = 10, N_PHASES = 11;

__global__ void __launch_bounds__(NTHR, 2) fwd_kernel(Args args) {
    extern __shared__ __attribute__((aligned(16))) unsigned char lds_raw[];
    Frame F;
    F.lds = (LAS unsigned char*)lds_raw;
    F.tid = threadIdx.x; F.lane = F.tid & 63; F.wave = __builtin_amdgcn_readfirstlane(F.tid >> 6);
    F.G = gridDim.x; F.wg = blockIdx.x;
    F.x_prompt = args.in[0]; F.x_sample = args.in[1]; F.state_ret = args.in[2]; F.state_lru = args.in[3]; F.c = args.in[4]; F.c_ctx = args.in[5];
    F.norm_w = args.in[6]; F.w_ada = args.in[7]; F.b_ada = args.in[8]; F.w_in = args.in[9]; F.decay_logit = args.in[10]; F.gn_w = args.in[11];
    F.w_ret_down = args.in[12]; F.conv_w = args.in[13]; F.conv_b = args.in[14]; F.lru_wa = args.in[15]; F.lru_ba = args.in[16]; F.lru_wx = args.in[17];
    F.lru_bx = args.in[18]; F.lru_a = args.in[19]; F.w_lru_down = args.in[20]; F.w_out = args.in[21]; F.final_norm_w = args.in[22];
    F.out = args.out; F.ws = args.ws;
    unsigned char* ws = args.ws;
    F.WinT = (bf16*)(ws + WS_WINT); F.WrdT = (bf16*)(ws + WS_WRDT); F.WldT = (bf16*)(ws + WS_WLDT); F.WoutT = (bf16*)(ws + WS_WOUTT); F.WlruT = (bf16*)(ws + WS_WLRUT);
    F.MOD = (float*)(ws + WS_MOD); F.H = (bf16*)(ws + WS_H); F.Q = (bf16*)(ws + WS_Q); F.K = (bf16*)(ws + WS_K); F.V = (bf16*)(ws + WS_V);
    F.XL = (bf16*)(ws + WS_XL); F.GL = (bf16*)(ws + WS_GL); F.AGG = (float*)(ws + WS_AGG); F.SS = (float*)(ws + WS_SS); F.HL = (bf16*)(ws + WS_HL); F.SP = (bf16*)(ws + WS_SP);
    F.SIGR = (bf16*)(ws + WS_SIGR); F.SIGL = (bf16*)(ws + WS_SIGL); F.MERGED = (bf16*)(ws + WS_MERGED); F.OG = (bf16*)(args.out + OUT_Y);

    volatile LAS unsigned* MISC = (volatile LAS unsigned*)(F.lds + MISC_OFF);
    for (int u = F.tid; u < (LDS_BYTES - 131072) / 4; u += NTHR) ((LAS unsigned*)(F.lds + 131072))[u] = 0u;
    __syncthreads();
    const int lo = args.ph_lo, hi = args.ph_hi;
    XcdBarrier bar; bar.bar = (unsigned*)(ws + WS_CTL) + CW_BAR; bar.x = 0; bar.st = nullptr;
    if (hi - lo > 1) bar = xcd_barrier_post((unsigned*)(ws + WS_CTL) + CW_BAR, MISC + 8);
#define IN(k) (lo <= (k) && (k) < hi)
#define SEAM(k) do { if (IN(k) && IN((k) + 1)) xcd_barrier(bar); } while (0)

    if (IN(PH_PREP)) { phase_prep(F); SEAM(PH_PREP); }
    if (IN(PH_H)) { phase_h(F); SEAM(PH_H); }
    if (IN(PH_GEMM1)) { pg8::Gemm g{F.H, F.WinT, M, N1, D}; pg8::StaticOrder S; S.init(M, N1, F.G, F.wg); pg8::EpiG1 E{F.Q, F.K, F.V, F.XL, F.GL};
        pg8::gemm_phase<pg8::EpiG1, pg8::StaticOrder, true, true>(F.lds, g, S, E); SEAM(PH_GEMM1); }
    if (IN(PH_LRUA)) { phase_lru(F, false); SEAM(PH_LRUA); }
    if (IN(PH_LRUB)) { phase_lru(F, true); SEAM(PH_LRUB); }
    if (IN(PH_R12)) { phase_r12f(F); SEAM(PH_R12); }
    if (IN(PH_R3)) { phase_r3f(F); SEAM(PH_R3); }
    if (IN(PH_G2)) { pg8::Gemm g{F.H, F.WinT + (size_t)N1 * D, M, N2, D}; pg8::StaticOrder S; S.init(M, N2, F.G, F.wg); pg8::EpiG2 E{F.OG, F.SIGR, F.SIGL, F.SS, F.gn_w};
        pg8::gemm_phase<pg8::EpiG2, pg8::StaticOrder, true, true>(F.lds, g, S, E); SEAM(PH_G2); }
    if (IN(PH_DOWN)) {
        { pg8::Gemm g{F.OG, F.WrdT, M, D, DRV}; pg8::StaticOrder S; S.init(M, D, F.G, F.wg); pg8::EpiDown<false> E{F.MERGED, F.SIGR}; pg8::gemm_phase<pg8::EpiDown<false>, pg8::StaticOrder, true, true>(F.lds, g, S, E); }
        { pg8::Gemm g{F.HL, F.WldT, M, D, DL}; pg8::StaticOrder S; S.init(M, D, F.G, F.wg); pg8::EpiDown<true> E{F.MERGED, F.SIGL}; pg8::gemm_phase<pg8::EpiDown<true>, pg8::StaticOrder, true, true>(F.lds, g, S, E); }
        SEAM(PH_DOWN);
    }
    if (IN(PH_OUT)) { pg8::Gemm g{F.MERGED, F.WoutT, M, D, D}; pg8::StaticOrder S; S.init(M, D, F.G, F.wg); pg8::EpiY E{F.out + OUT_Y, F.x_prompt, F.x_sample, F.MOD, MCTX, LLAT};
        pg8::gemm_phase<pg8::EpiY, pg8::StaticOrder, true, true>(F.lds, g, S, E); SEAM(PH_OUT); }
    if (IN(PH_NORM)) { phase_norm(F); }
#undef IN
#undef SEAM
}
}

extern "C" void kernel_launch(void* const* d_in, const int* in_sizes, int n_in, void* d_out, int out_size, void* d_ws, size_t ws_size, hipStream_t stream) {
    static int grid = 0;
    if (grid == 0) {
        if (n_in != 23 || (size_t)out_size != OUT_TOTAL || ws_size < WS_END) { fprintf(stderr, "kernel_launch: unexpected shapes n_in %d out %d ws %zu\n", n_in, out_size, ws_size); grid = -1; return; }
        int dev = 0, cus = 0;
        if (hipGetDevice(&dev) != hipSuccess || hipDeviceGetAttribute(&cus, hipDeviceAttributeMultiprocessorCount, dev) != hipSuccess) { grid = -1; return; }
        if (hipFuncSetAttribute((const void*)fwd_kernel, hipFuncAttributeMaxDynamicSharedMemorySize, LDS_BYTES) != hipSuccess) { fprintf(stderr, "kernel_launch: hipFuncSetAttribute failed\n"); grid = -1; return; }
        int per_cu = 0;
        (void)hipOccupancyMaxActiveBlocksPerMultiprocessor(&per_cu, (const void*)fwd_kernel, NTHR, LDS_BYTES);
        (void)hipGetLastError();
        grid = cus;
    }
    if (grid < 0) return;
    (void)hipMemsetAsync((char*)d_ws + WS_CTL, 0, CTL_ZERO_BYTES, stream);
    Args a{};
    for (int i = 0; i < 23; ++i) a.in[i] = (const float*)d_in[i];
    a.out = (float*)d_out; a.ws = (unsigned char*)d_ws;
#if MK_ONE_LAUNCH
    a.ph_lo = 0; a.ph_hi = N_PHASES;
    hipLaunchKernelGGL(fwd_kernel, dim3(grid), dim3(NTHR), LDS_BYTES, stream, a);
#else
    for (int p = 0; p < N_PHASES; ++p) { a.ph_lo = p; a.ph_hi = p + 1; hipLaunchKernelGGL(fwd_kernel, dim3(grid), dim3(NTHR), LDS_BYTES, stream, a); }
#endif
}
```

```cpp
#include <hip/hip_runtime.h>
#include <cstdint>
#include <cstdio>

#ifndef MK_ONE_LAUNCH
#define MK_ONE_LAUNCH 1
#endif

namespace {
constexpr int D = 1024, NCTX = 16, LCTX = 256, NLAT = 4, LLAT = 2048;
constexpr int MCTX = NCTX * LCTX, MLAT = NLAT * LLAT, M = MCTX + MLAT;
constexpr int NH = 4, DK = 256, DV = 512, DQK = NH * DK, DRV = NH * DV;
constexpr int NB = 10, LB = 128, DL = NB * LB;
constexpr int DIN = 10752;
constexpr int N1 = 6656;
constexpr int N2 = 4096;
constexpr int CH = 256;
constexpr int NCH_LAT = LLAT / CH;
constexpr float EPS = 1e-6f;
constexpr int NWAVES = 8, NTHR = 512;

constexpr size_t MiB = 1u << 20;
constexpr size_t WS_CTL = 0, CTL_ZERO_BYTES = 1 * MiB;
constexpr size_t WS_WINT = 1 * MiB;
constexpr size_t WS_WRDT = 22 * MiB;
constexpr size_t WS_WLDT = 26 * MiB;
constexpr size_t WS_WOUTT = 28 * MiB + 512 * 1024;
constexpr size_t WS_WLRUT = 30 * MiB + 512 * 1024;
constexpr size_t WS_MOD = 31 * MiB + 768 * 1024;
constexpr size_t WS_H = 32 * MiB;
constexpr size_t WS_Q = 56 * MiB, WS_K = 80 * MiB, WS_V = 104 * MiB;
constexpr size_t WS_XL = 152 * MiB, WS_GL = 182 * MiB;
constexpr size_t WS_AGG = 216 * MiB;
constexpr size_t WS_SS = 220 * MiB;
constexpr size_t WS_HL = 226 * MiB;
constexpr size_t WS_SP = 152 * MiB;
constexpr size_t WS_SIGR = 56 * MiB, WS_SIGL = 80 * MiB;
constexpr size_t WS_MERGED = 104 * MiB;
constexpr size_t WS_END = 256 * MiB;
constexpr size_t OUT_Y = 0;
constexpr size_t OUT_NSR = (size_t)M * D;
constexpr size_t OUT_NSL = OUT_NSR + (size_t)NCTX * 2 * NH * DK * DV;
constexpr size_t OUT_TOTAL = OUT_NSL + (size_t)NCTX * 2 * DL;

constexpr int CW_TMO = 0, CW_CODE = 1, CW_BAR = 4096;
constexpr int LDS_BYTES = 147456;
constexpr int MISC_OFF = 131072 + 320;

#define GAS __attribute__((address_space(1)))
#define LAS __attribute__((address_space(3)))
typedef unsigned short bf16;
typedef unsigned v4u __attribute__((ext_vector_type(4)));
typedef float f32x4 __attribute__((ext_vector_type(4)));
typedef short bf16x8 __attribute__((ext_vector_type(8)));
typedef GAS unsigned gu32;
#define RLX_AGENT __ATOMIC_RELAXED, __HIP_MEMORY_SCOPE_AGENT
#define LDS_WAIT() asm volatile("s_waitcnt lgkmcnt(0)" ::: "memory")
#define VM_WAIT() asm volatile("s_waitcnt vmcnt(0)" ::: "memory")

__device__ __forceinline__ unsigned f2bf(float f) { unsigned u = __builtin_bit_cast(unsigned, f); return (u + 0x7fffu + ((u >> 16) & 1u)) >> 16; }
__device__ __forceinline__ float bf2f(unsigned short b) { return __builtin_bit_cast(float, ((unsigned)b) << 16); }
__device__ __forceinline__ float bfr(float f) { return bf2f((unsigned short)f2bf(f)); }
__device__ __forceinline__ unsigned pk2(float lo, float hi) { return f2bf(lo) | (f2bf(hi) << 16); }
__device__ __forceinline__ float sigmoidf_(float x) { return 1.0f / (1.0f + __expf(-x)); }
__device__ __forceinline__ float siluf_(float x) { return x / (1.0f + __expf(-x)); }

#define XB_TMO      128
#define XB_XCNT(j)  (256  + 64 * (j))
#define XB_XSUB(j)  (1280 + 64 * (j))
#define XB_XGEN(j)  (2304 + 64 * (j))
#define XB_TOP      3328
#define XB_TOPGEN   3392
#define XCD_BAR_WORDS 3456
#define XB_SPIN_CAP (1u << 22)
__device__ __forceinline__ unsigned xb_ld(unsigned* p)              { return __hip_atomic_load(p, __ATOMIC_RELAXED, __HIP_MEMORY_SCOPE_AGENT); }
__device__ __forceinline__ unsigned xb_add(unsigned* p, unsigned v) { return __hip_atomic_fetch_add(p, v, __ATOMIC_RELAXED, __HIP_MEMORY_SCOPE_AGENT); }
__device__ __forceinline__ unsigned xb_xcc_id() { return (unsigned)__builtin_amdgcn_s_getreg((3 << 11) | 20) & 0xFu; }
#define XB_SPIN(cond, bar) do { unsigned _sp = 0; while (cond) { __builtin_amdgcn_s_sleep(1); \
    if ((++_sp & 255u) == 0u) { if (xb_ld(&(bar)[XB_TMO])) break; if (_sp > XB_SPIN_CAP) { atomicAdd(&(bar)[XB_TMO], 1u); break; } } } } while (0)
struct XcdBarrier { unsigned* bar; unsigned x; volatile LAS unsigned* st; };
__device__ __forceinline__ XcdBarrier xcd_barrier_post(unsigned* bar, volatile LAS unsigned* st) {
    XcdBarrier b; b.bar = bar; b.x = xb_xcc_id(); b.st = st;
    if (threadIdx.x == 0) (void)xb_add(&bar[XB_XCNT(b.x)], 1u);
    return b;
}
__device__ __forceinline__ void xcd_barrier_complete(unsigned* bar, unsigned x, unsigned& nloc, unsigned& nx) {
    const unsigned G = gridDim.x * gridDim.y * gridDim.z;
    unsigned sum, cnt, mine, sp = 0u;
    for (;;) {
        sum = 0u; cnt = 0u; mine = 0u;
#pragma unroll
        for (unsigned j = 0; j < 16; ++j) { const unsigned c = xb_ld(&bar[XB_XCNT(j)]); sum += c; cnt += (c > 0u) ? 1u : 0u; mine = (j == x) ? c : mine; }
        if (sum == G) break;
        __builtin_amdgcn_s_sleep(1);
        if ((++sp & 255u) == 0u) { if (xb_ld(&bar[XB_TMO])) break; if (sp > XB_SPIN_CAP) { atomicAdd(&bar[XB_TMO], 1u); break; } }
    }
    nloc = mine > 0u ? mine : 1u; nx = cnt > 0u ? cnt : 1u;
}
__device__ __forceinline__ void xcd_barrier(const XcdBarrier& b) {
    asm volatile("s_waitcnt vmcnt(0)" ::: "memory");
    __syncthreads();
    if (threadIdx.x == 0) {
        unsigned* bar = b.bar;
        __builtin_amdgcn_s_waitcnt(0);
        unsigned nloc = b.st[0], nx = b.st[1];
        if (nloc == 0u) { xcd_barrier_complete(bar, b.x, nloc, nx); b.st[0] = nloc; b.st[1] = nx; }
        const unsigned old = xb_add(&bar[XB_XSUB(b.x)], 1u);
        const unsigned gen = old / nloc;
        if (old + 1u == (gen + 1u) * nloc) {
            __builtin_amdgcn_fence(__ATOMIC_RELEASE, "agent");
            asm volatile("s_waitcnt vmcnt(0)" ::: "memory");
            const unsigned og = xb_add(&bar[XB_TOP], 1u);
            const unsigned tg = og / nx;
            if (og + 1u == (tg + 1u) * nx) xb_add(&bar[XB_TOPGEN], 1u);
            else XB_SPIN(xb_ld(&bar[XB_TOPGEN]) == tg, bar);
            __builtin_amdgcn_fence(__ATOMIC_ACQUIRE, "agent");
            xb_add(&bar[XB_XGEN(b.x)], 1u);
            asm volatile("s_waitcnt vmcnt(0)" ::: "memory");
        } else {
            XB_SPIN(xb_ld(&bar[XB_XGEN(b.x)]) == gen, bar);
            __builtin_amdgcn_fence(__ATOMIC_ACQUIRE, "agent");
            asm volatile("s_waitcnt vmcnt(0)" ::: "memory");
        }
    }
    __syncthreads();
}

namespace pg8 {
#define PG8_LAS __attribute__((address_space(3)))
typedef unsigned short bf16_t;
typedef short bf16x8 __attribute__((ext_vector_type(8)));
typedef float f32x4 __attribute__((ext_vector_type(4)));
typedef unsigned u32x4 __attribute__((ext_vector_type(4)));
constexpr int BM = 256, BK = 64, HALF = 128, HTB = HALF * BK * 2  , STAGE_BYTES = 8 * HTB, NXCD = 8, WGM = 8;

__host__ __device__ __forceinline__ int lds_byte(int r, int c) { const int st = (r >> 4) * 2 + (c >> 5), rr = r & 15, cc = c & 31, ob = rr * 64 + cc * 2; return st * 1024 + (ob ^ (((ob >> 9) & 1) << 5)); }
__host__ __device__ __forceinline__ void stage_rc(int b, int& R, int& C) { const int st = b / 1024, sb = b % 1024, swz = sb ^ (((sb >> 9) & 1) << 5); R = (st >> 1) * 16 + swz / 64; C = (st & 1) * 32 + (swz % 64) / 2; }
__host__ __device__ __forceinline__ int perm32(int rho) { const int n = rho >> 4, i = rho & 15; return 8 * (i >> 2) + 4 * n + (i & 3); }

struct Unit { int pm, pn; };
struct Gemm { const bf16_t* A; const bf16_t* Bt; int M, N, K; };

struct StaticOrder {
    int nM, nN, nwg, G, c;
    __host__ __device__ void init(int M, int N, int G_, int c_) { nM = M / BM; nN = N / BM; nwg = nM * nN; G = G_; c = c_; }
    __host__ __device__ bool next(int i, Unit& u) const {
        const long L = (long)i * G + c; if (L >= nwg) return false;
        int wgid = (int)L; { const int q = nwg / NXCD, r = nwg % NXCD, xcd = wgid % NXCD, off = wgid / NXCD; wgid = (xcd < r ? xcd * (q + 1) : r * (q + 1) + (xcd - r) * q) + off; }
        const int nig = WGM * nN, gid = wgid / nig, fm = gid * WGM, gsz = (nM - fm) < WGM ? (nM - fm) : WGM;
        u.pm = fm + ((wgid % nig) % gsz); u.pn = (wgid % nig) / gsz; return true;
    }
    __device__ __forceinline__ void a_ready(const Unit&) const {}
    __device__ __forceinline__ void done(const Unit&) const {}
};

__device__ __forceinline__ unsigned cvt_pk_bf16(float lo, float hi) { unsigned r; asm volatile("v_cvt_pk_bf16_f32 %0, %1, %2" : "=v"(r) : "v"(lo), "v"(hi)); return r; }

typedef float f32x2 __attribute__((ext_vector_type(2)));
__device__ __forceinline__ float pg_silu(float x) { return x * __builtin_amdgcn_rcpf(1.0f + __expf(-x)); }
__device__ __forceinline__ float pg_sigm(float x) { return __builtin_amdgcn_rcpf(1.0f + __expf(-x)); }
__device__ __forceinline__ float pg_lo(unsigned w) { return __builtin_bit_cast(float, w << 16); }
__device__ __forceinline__ float pg_hi(unsigned w) { return __builtin_bit_cast(float, w & 0xffff0000u); }
struct EpiG1 {
    static constexpr bool PERM = true, AFTER_DRAIN = false;
    bf16_t *Q, *K, *V, *XL, *GL;
    __device__ __forceinline__ void operator()(const f32x4 (&acc)[2][2][4][2], const Unit& u, int wr, int wc, int fr, int fq) const {
        const int row0 = u.pm * BM + wr * 64 + fr; int colt = u.pn * BM; bf16_t* base; int ldc; float sc = 1.f; bool act = false;
        if (colt < 1024) { base = Q; ldc = 1024; } else if (colt < 2048) { base = K; ldc = 1024; colt -= 1024; sc = 0.0625f; }
        else if (colt < 4096) { base = V; ldc = 2048; colt -= 2048; } else if (colt < 5376) { base = XL; ldc = 1280; colt -= 4096; } else { base = GL; ldc = 1280; colt -= 5376; act = true; }
        const int col0 = colt + wc * 32 + 8 * fq;
#pragma unroll
        for (int ai = 0; ai < 2; ++ai)
#pragma unroll
            for (int m = 0; m < 4; ++m) { bf16_t* rowp = base + (size_t)(row0 + ai * HALF + m * 16) * ldc + col0;
#pragma unroll
                for (int bj = 0; bj < 2; ++bj) { f32x4 v0 = acc[ai][bj][m][0], v1 = acc[ai][bj][m][1];
                    if (act) {
#pragma unroll
                        for (int j = 0; j < 4; ++j) { v0[j] = pg_silu(v0[j]); v1[j] = pg_silu(v1[j]); } }
                    v0 = v0 * sc; v1 = v1 * sc; u32x4 w; w.x = cvt_pk_bf16(v0[0], v0[1]); w.y = cvt_pk_bf16(v0[2], v0[3]); w.z = cvt_pk_bf16(v1[0], v1[1]); w.w = cvt_pk_bf16(v1[2], v1[3]);
                    *(u32x4*)(rowp + bj * HALF) = w; } }
    }
};
struct EpiG2 {
    static constexpr bool PERM = true, AFTER_DRAIN = false;
    bf16_t *OG, *SIGR, *SIGL; const float *SS, *gnw;
    __device__ __forceinline__ void operator()(const f32x4 (&acc)[2][2][4][2], const Unit& u, int wr, int wc, int fr, int fq) const {
        const int row0 = u.pm * BM + wr * 64 + fr; int colt = u.pn * BM; bf16_t* base; int ldc; bool mul = false;
        if (colt < 2048) { base = OG; ldc = 2048; mul = true; } else if (colt < 3072) { base = SIGR; ldc = 1024; colt -= 2048; } else { base = SIGL; ldc = 1024; colt -= 3072; }
        const int col0 = colt + wc * 32 + 8 * fq, head = colt >> 9;
        f32x4 gw[2][2];
#pragma unroll
        for (int bj = 0; bj < 2; ++bj)
#pragma unroll
            for (int n = 0; n < 2; ++n) gw[bj][n] = mul ? *(const f32x4*)(gnw + col0 + bj * HALF + 4 * n) : (f32x4){1.f, 1.f, 1.f, 1.f};
#pragma unroll
        for (int ai = 0; ai < 2; ++ai)
#pragma unroll
            for (int m = 0; m < 4; ++m) { const int r = row0 + ai * HALF + m * 16; bf16_t* rowp = base + (size_t)r * ldc + col0;
                float rs = 1.f;
                if (mul) { const f32x4 sq = *(const f32x4*)(SS + ((size_t)r * 4 + head) * 4); rs = 1.0f / sqrtf(((sq[0] + sq[1]) + (sq[2] + sq[3])) * (1.0f / 512.0f) + 1e-6f); }
#pragma unroll
                for (int bj = 0; bj < 2; ++bj) { f32x4 v0 = acc[ai][bj][m][0], v1 = acc[ai][bj][m][1];
                    if (mul) { const u32x4 o = *(const u32x4*)(rowp + bj * HALF); const f32x4 g0 = gw[bj][0] * rs, g1 = gw[bj][1] * rs;
                        v0[0] = pg_silu(v0[0]) * pg_lo(o.x) * g0[0]; v0[1] = pg_silu(v0[1]) * pg_hi(o.x) * g0[1]; v0[2] = pg_silu(v0[2]) * pg_lo(o.y) * g0[2]; v0[3] = pg_silu(v0[3]) * pg_hi(o.y) * g0[3];
                        v1[0] = pg_silu(v1[0]) * pg_lo(o.z) * g1[0]; v1[1] = pg_silu(v1[1]) * pg_hi(o.z) * g1[1]; v1[2] = pg_silu(v1[2]) * pg_lo(o.w) * g1[2]; v1[3] = pg_silu(v1[3]) * pg_hi(o.w) * g1[3];
                    } else {
#pragma unroll
                        for (int j = 0; j < 4; ++j) { v0[j] = pg_sigm(v0[j]); v1[j] = pg_sigm(v1[j]); } }
                    u32x4 w; w.x = cvt_pk_bf16(v0[0], v0[1]); w.y = cvt_pk_bf16(v0[2], v0[3]); w.z = cvt_pk_bf16(v1[0], v1[1]); w.w = cvt_pk_bf16(v1[2], v1[3]);
                    *(u32x4*)(rowp + bj * HALF) = w; } }
    }
};
template <bool ADD> struct EpiDown {
    static constexpr bool PERM = true, AFTER_DRAIN = false;
    bf16_t* MERGED; const bf16_t* SIG;
    __device__ __forceinline__ void operator()(const f32x4 (&acc)[2][2][4][2], const Unit& u, int wr, int wc, int fr, int fq) const {
        const int row0 = u.pm * BM + wr * 64 + fr, col0 = u.pn * BM + wc * 32 + 8 * fq;
#pragma unroll
        for (int ai = 0; ai < 2; ++ai)
#pragma unroll
            for (int m = 0; m < 4; ++m) { const size_t off = (size_t)(row0 + ai * HALF + m * 16) * 1024 + col0;
#pragma unroll
                for (int bj = 0; bj < 2; ++bj) { f32x4 v0 = acc[ai][bj][m][0], v1 = acc[ai][bj][m][1];
                    const u32x4 g = *(const u32x4*)(SIG + off + bj * HALF);
                    v0[0] *= pg_lo(g.x); v0[1] *= pg_hi(g.x); v0[2] *= pg_lo(g.y); v0[3] *= pg_hi(g.y); v1[0] *= pg_lo(g.z); v1[1] *= pg_hi(g.z); v1[2] *= pg_lo(g.w); v1[3] *= pg_hi(g.w);
                    if (ADD) { const u32x4 o = *(const u32x4*)(MERGED + off + bj * HALF);
                        v0[0] += pg_lo(o.x); v0[1] += pg_hi(o.x); v0[2] += pg_lo(o.y); v0[3] += pg_hi(o.y); v1[0] += pg_lo(o.z); v1[1] += pg_hi(o.z); v1[2] += pg_lo(o.w); v1[3] += pg_hi(o.w); }
                    u32x4 w; w.x = cvt_pk_bf16(v0[0], v0[1]); w.y = cvt_pk_bf16(v0[2], v0[3]); w.z = cvt_pk_bf16(v1[0], v1[1]); w.w = cvt_pk_bf16(v1[2], v1[3]);
                    *(u32x4*)(MERGED + off + bj * HALF) = w; } }
    }
};
struct EpiY {
    static constexpr bool PERM = false, AFTER_DRAIN = false;
    float* Y; const float *xp, *xs, *MOD; int mctx, llat;
    __device__ __forceinline__ void operator()(const f32x4 (&acc)[2][2][4][2], const Unit& u, int wr, int wc, int fr, int fq) const {
        const int row0 = u.pm * BM + wr * 64 + fr, col0 = u.pn * BM + wc * 32 + 4 * fq;
        const int rbase = u.pm * BM;
        const float* gate = MOD + (rbase < mctx ? 0 : 1 + (rbase - mctx) / llat) * 3072 + 2048;
        f32x4 gv[2][2];
#pragma unroll
        for (int bj = 0; bj < 2; ++bj)
#pragma unroll
            for (int n = 0; n < 2; ++n) gv[bj][n] = *(const f32x4*)(gate + col0 + bj * HALF + n * 16);
#pragma unroll
        for (int ai = 0; ai < 2; ++ai)
#pragma unroll
            for (int m = 0; m < 4; ++m) { const int r = row0 + ai * HALF + m * 16; const float* xr = (r < mctx ? xp + (size_t)r * 1024 : xs + (size_t)(r - mctx) * 1024) + col0; float* yr = Y + (size_t)r * 1024 + col0;
#pragma unroll
                for (int bj = 0; bj < 2; ++bj)
#pragma unroll
                    for (int n = 0; n < 2; ++n) { const f32x4 xv = *(const f32x4*)(xr + bj * HALF + n * 16); *(f32x4*)(yr + bj * HALF + n * 16) = xv + gv[bj][n] * acc[ai][bj][m][n]; } }
    }
};

template <class Epi, class Sched, bool ALIGN_EPI = false, bool SP2 = false>
__device__ __forceinline__ void gemm_phase(PG8_LAS unsigned char* lds, const Gemm g, const Sched& S, const Epi& E) {
    const int tid = threadIdx.x, wid = __builtin_amdgcn_readfirstlane(tid >> 6), lane = tid & 63, wr = wid >> 2, wc = wid & 3, fr = lane & 15, fq = lane >> 4;
    const int K = g.K, nt = K / BK;
    unsigned voffA[2], voffB[2];
#pragma unroll
    for (int i = 0; i < 2; ++i) { int R, C; stage_rc(tid * 16 + i * 8192, R, C); const int Rb = Epi::PERM ? ((R & ~31) + perm32(R & 31)) : R;
        voffA[i] = (unsigned)(R * K + C) * 2u; voffB[i] = (unsigned)(Rb * K + C) * 2u; }
    const size_t kstep = (size_t)(BK * 2);
    const size_t hstep = (size_t)HALF * K * 2;
    const size_t tstep = 2 * hstep;
    const unsigned ldsw = (unsigned)wid * 1024u;
    const int aoff = lds_byte(wr * 64 + fr, fq * 8), boff = lds_byte(wc * 32 + fr, fq * 8);
#define PG8_SA(b, h) (((b) * 2 + (h)) * HTB)
#define PG8_SB(b, h) ((4 + (b) * 2 + (h)) * HTB)
#define PG8_STAGE(bufoff, gbase, voff) do { _Pragma("unroll") for (int _i = 0; _i < 2; ++_i) \
        __builtin_amdgcn_global_load_lds((const unsigned*)((const char*)(gbase) + (voff)[_i]), (PG8_LAS unsigned*)(lds + (bufoff) + ldsw + _i * 8192), 16, 0, 0); } while (0)
#define PG8_LDA(dst, b, h) do { _Pragma("unroll") for (int m = 0; m < 4; ++m) _Pragma("unroll") for (int k = 0; k < 2; ++k) dst[m][k] = *(const PG8_LAS bf16x8*)(lds + PG8_SA(b, h) + aoff + m * 2048 + k * 1024); } while (0)
#define PG8_LDB(dst, b, h) do { _Pragma("unroll") for (int n = 0; n < 2; ++n) _Pragma("unroll") for (int k = 0; k < 2; ++k) dst[n][k] = *(const PG8_LAS bf16x8*)(lds + PG8_SB(b, h) + boff + n * 2048 + k * 1024); } while (0)
#define PG8_MMA(ai, bj, At, Bt) do { __builtin_amdgcn_s_setprio(1); _Pragma("unroll") for (int m = 0; m < 4; ++m) _Pragma("unroll") for (int n = 0; n < 2; ++n) _Pragma("unroll") for (int k = 0; k < 2; ++k) \
        acc[ai][bj][m][n] = __builtin_amdgcn_mfma_f32_16x16x32_bf16(Bt[n][k], At[m][k], acc[ai][bj][m][n], 0, 0, 0); __builtin_amdgcn_s_setprio(0); } while (0)
#define PG8_WAIT_V(n) asm volatile("s_waitcnt vmcnt(" #n ")" ::: "memory")
#define PG8_WAIT_L(n) asm volatile("s_waitcnt lgkmcnt(" #n ")" ::: "memory")
#define PG8_BAR __builtin_amdgcn_s_barrier()
#define PG8_SCHED __builtin_amdgcn_sched_barrier(0)
    Unit cur, nxt; int ui = 0;
    if (!S.next(0, cur)) return;
    f32x4 acc[2][2][4][2];
#pragma unroll
    for (int a = 0; a < 2; ++a)
#pragma unroll
        for (int b = 0; b < 2; ++b)
#pragma unroll
            for (int m = 0; m < 4; ++m)
#pragma unroll
                for (int n = 0; n < 2; ++n) acc[a][b][m][n] = (f32x4){0.f, 0.f, 0.f, 0.f};
    bf16x8 At[4][2], B0[2][2], B1[2][2];
    const char* cA = (const char*)g.A + (size_t)cur.pm * tstep; const char* cB = (const char*)g.Bt + (size_t)cur.pn * tstep;
    S.a_ready(cur);
    if constexpr (SP2) {
        PG8_STAGE(PG8_SB(0, 0), cB, voffB); PG8_STAGE(PG8_SB(0, 1), cB + hstep, voffB); PG8_STAGE(PG8_SA(0, 0), cA, voffA); PG8_STAGE(PG8_SA(0, 1), cA + hstep, voffA);
        if (wr == 1) PG8_BAR;
        PG8_WAIT_V(2); PG8_BAR;
        PG8_STAGE(PG8_SB(1, 0), cB + kstep, voffB); PG8_STAGE(PG8_SA(1, 0), cA + kstep, voffA); PG8_STAGE(PG8_SB(1, 1), cB + hstep + kstep, voffB);
        PG8_WAIT_V(6); PG8_BAR;
    } else {
        PG8_STAGE(PG8_SB(0, 0), cB, voffB); PG8_STAGE(PG8_SA(0, 0), cA, voffA); PG8_STAGE(PG8_SB(0, 1), cB + hstep, voffB); PG8_STAGE(PG8_SA(0, 1), cA + hstep, voffA);
        if (wr == 1) PG8_BAR;
        PG8_WAIT_V(4); PG8_BAR;
        PG8_STAGE(PG8_SB(1, 0), cB + kstep, voffB); PG8_STAGE(PG8_SA(1, 0), cA + kstep, voffA); PG8_STAGE(PG8_SB(1, 1), cB + hstep + kstep, voffB);
        PG8_WAIT_V(6); PG8_BAR;
    }
    for (;;) {
        const bool has_next = S.next(ui + 1, nxt);
        const char* nA = has_next ? (const char*)g.A + (size_t)nxt.pm * tstep : cA; const char* nB = has_next ? (const char*)g.Bt + (size_t)nxt.pn * tstep : cB;
        for (int t = 0; t < nt; t += 2) {
            const bool last = (t == nt - 2);
            const char* a1 = cA + (size_t)(t + 1) * kstep;
            const char* a2 = last ? nA : cA + (size_t)(t + 2) * kstep; const char* b2 = last ? nB : cB + (size_t)(t + 2) * kstep;
            const char* a3 = a2 + kstep; const char* b3 = b2 + kstep;
            if (last && has_next) S.a_ready(nxt);
            if constexpr (SP2) {
            PG8_LDB(B0, 0, 0); PG8_LDB(B1, 0, 1); PG8_SCHED; PG8_LDA(At, 0, 0); PG8_STAGE(PG8_SA(1, 1), a1 + hstep, voffA);
            PG8_WAIT_V(8); PG8_WAIT_L(0); PG8_BAR; PG8_MMA(0, 0, At, B0); PG8_MMA(0, 1, At, B1); PG8_BAR; PG8_SCHED;
            PG8_LDA(At, 0, 1); PG8_STAGE(PG8_SB(0, 0), b2, voffB); PG8_STAGE(PG8_SB(0, 1), b2 + hstep, voffB); PG8_STAGE(PG8_SA(0, 0), a2, voffA);
            PG8_WAIT_V(8); PG8_WAIT_L(0); PG8_BAR; PG8_MMA(1, 0, At, B0); PG8_MMA(1, 1, At, B1); PG8_BAR; PG8_SCHED;
            PG8_LDB(B0, 1, 0); PG8_LDB(B1, 1, 1); PG8_SCHED; PG8_LDA(At, 1, 0); PG8_STAGE(PG8_SA(0, 1), a2 + hstep, voffA);
            PG8_WAIT_V(8); PG8_WAIT_L(0); PG8_BAR; PG8_MMA(0, 0, At, B0); PG8_MMA(0, 1, At, B1); PG8_BAR; PG8_SCHED;
            PG8_LDA(At, 1, 1); PG8_STAGE(PG8_SB(1, 0), b3, voffB); PG8_STAGE(PG8_SB(1, 1), b3 + hstep, voffB); PG8_STAGE(PG8_SA(1, 0), a3, voffA);
            PG8_WAIT_V(8); PG8_WAIT_L(0); PG8_BAR; PG8_MMA(1, 0, At, B0); PG8_MMA(1, 1, At, B1); PG8_BAR; PG8_SCHED;
            } else {
            PG8_LDB(B0, 0, 0); PG8_SCHED; PG8_LDA(At, 0, 0); PG8_STAGE(PG8_SA(1, 1), a1 + hstep, voffA);
            PG8_WAIT_L(8); PG8_BAR; PG8_WAIT_L(0); PG8_MMA(0, 0, At, B0); PG8_BAR; PG8_SCHED;
            PG8_LDB(B1, 0, 1); PG8_STAGE(PG8_SB(0, 0), b2, voffB);
            PG8_BAR; PG8_WAIT_L(0); PG8_MMA(0, 1, At, B1); PG8_BAR;
            PG8_LDA(At, 0, 1); PG8_STAGE(PG8_SA(0, 0), a2, voffA);
            PG8_BAR; PG8_WAIT_L(0); PG8_MMA(1, 0, At, B0); PG8_BAR; PG8_SCHED;
            PG8_STAGE(PG8_SB(0, 1), b2 + hstep, voffB);
            PG8_WAIT_V(6); PG8_BAR; PG8_MMA(1, 1, At, B1); PG8_BAR;
            PG8_LDB(B0, 1, 0); PG8_SCHED; PG8_LDA(At, 1, 0); PG8_STAGE(PG8_SA(0, 1), a2 + hstep, voffA);
            PG8_WAIT_L(8); PG8_BAR; PG8_WAIT_L(0); PG8_MMA(0, 0, At, B0); PG8_BAR; PG8_SCHED;
            PG8_LDB(B1, 1, 1); PG8_STAGE(PG8_SB(1, 0), b3, voffB);
            PG8_BAR; PG8_WAIT_L(0); PG8_MMA(0, 1, At, B1); PG8_BAR;
            PG8_LDA(At, 1, 1); PG8_STAGE(PG8_SA(1, 0), a3, voffA);
            PG8_BAR; PG8_WAIT_L(0); PG8_MMA(1, 0, At, B0); PG8_BAR; PG8_SCHED;
            PG8_STAGE(PG8_SB(1, 1), b3 + hstep, voffB);
            PG8_WAIT_V(6); PG8_BAR; PG8_MMA(1, 1, At, B1); PG8_BAR;
            }
        }
        if constexpr (ALIGN_EPI) { if (wr == 0) PG8_BAR; }
        if constexpr (!Epi::AFTER_DRAIN) { E(acc, cur, wr, wc, fr, fq); S.done(cur); }
        if (!has_next) break;
#pragma unroll
        for (int a = 0; a < 2; ++a)
#pragma unroll
            for (int b = 0; b < 2; ++b)
#pragma unroll
                for (int m = 0; m < 4; ++m)
#pragma unroll
                    for (int n = 0; n < 2; ++n) acc[a][b][m][n] = (f32x4){0.f, 0.f, 0.f, 0.f};
        cur = nxt; cA = nA; cB = nB; ++ui;
        if constexpr (ALIGN_EPI) { if (wr == 1) PG8_BAR; }
    }
    PG8_WAIT_V(0);
    if constexpr (!ALIGN_EPI) { if (wr == 0) PG8_BAR; }
    PG8_BAR;
    if constexpr (Epi::AFTER_DRAIN) { E.fused(acc, cur, wr, wc, fr, fq, lds, wid, lane); S.done(cur); }
#undef PG8_SA
#undef PG8_SB
#undef PG8_STAGE
#undef PG8_LDA
#undef PG8_LDB
#undef PG8_MMA
#undef PG8_WAIT_V
#undef PG8_WAIT_L
#undef PG8_BAR
#undef PG8_SCHED
}
}

struct Args {
    const float* in[23]; float* out; unsigned char* ws; int ph_lo, ph_hi;
};
struct Frame {
    LAS unsigned char* lds;
    int tid, lane, wave, G, wg;
    const float *x_prompt, *x_sample, *state_ret, *state_lru, *c, *c_ctx, *norm_w, *w_ada, *b_ada, *w_in, *decay_logit, *gn_w, *w_ret_down,
                *conv_w, *conv_b, *lru_wa, *lru_ba, *lru_wx, *lru_bx, *lru_a, *w_lru_down, *w_out, *final_norm_w;
    float* out; unsigned char* ws;
    bf16 *WinT, *WrdT, *WldT, *WoutT, *WlruT, *H, *Q, *K, *V, *XL, *GL, *HL, *SP, *SIGR, *SIGL, *MERGED, *OG;
    float *MOD, *AGG, *SS;
};

__device__ __forceinline__ float wave_sum(float v) {
#pragma unroll
    for (int o = 1; o < 64; o <<= 1) v += __shfl_xor(v, o);
    return v;
}
__device__ __forceinline__ const float* xrow_ptr(const Frame& F, int row) {
    return row < MCTX ? F.x_prompt + (size_t)row * D : F.x_sample + (size_t)(row - MCTX) * D;
}
__device__ __forceinline__ int mod_index(int row) { return row < MCTX ? 0 : 1 + (row - MCTX) / LLAT; }

__device__ __forceinline__ void p0_transpose_item(const float* W, int K, int N, bf16* WT, int drow0, int k0, int n0, LAS float* scr, int lane) {
#pragma unroll 8
    for (int i = 0; i < 32; ++i) { const int kk = 2 * i + (lane >> 5); scr[kk * 33 + (lane & 31)] = W[(size_t)(k0 + kk) * N + n0 + (lane & 31)]; }
    LDS_WAIT(); asm volatile("" ::: "memory");
    const int c = lane & 7;
#pragma unroll
    for (int j = 0; j < 4; ++j) { const int n = (lane >> 3) + 8 * j; const LAS float* s = scr + (8 * c) * 33 + n;
        v4u o; o.x = pk2(s[0 * 33], s[1 * 33]); o.y = pk2(s[2 * 33], s[3 * 33]); o.z = pk2(s[4 * 33], s[5 * 33]); o.w = pk2(s[6 * 33], s[7 * 33]);
        *(v4u*)(WT + (size_t)(drow0 + n) * K + k0 + 8 * c) = o; }
    LDS_WAIT(); asm volatile("" ::: "memory");
}
__device__ __forceinline__ int win_dst_row(int n) { return n < 4096 ? n : (n < 6144 ? n + 2560 : (n < 8704 ? n - 2048 : n)); }

__device__ __forceinline__ void phase_prep(Frame& F) {
    LAS float* scr = (LAS float*)(F.lds + F.wave * 16384);
    const int gw = F.wg * NWAVES + F.wave, NGW = F.G * NWAVES;
    constexpr int I_IN = (D / 64) * (DIN / 32), I_RD = (DRV / 64) * (D / 32), I_LD = (DL / 64) * (D / 32), I_OUT = (D / 64) * (D / 32), I_LRU = 40 * 8, I_MOD = 3072 / 64;
    constexpr int NITEMS = I_MOD + I_IN + I_RD + I_LD + I_OUT + I_LRU;
    for (int it = gw; it < NITEMS; it += NGW) {
        int r = it;
        if (r < I_MOD) {
            const int n = r * 64 + F.lane;
            float acc[5] = {0.f, 0.f, 0.f, 0.f, 0.f};
            for (int k = 0; k < D; ++k) {
                const float w = F.w_ada[(size_t)k * 3072 + n];
                acc[0] += siluf_(F.c_ctx[k]) * w;
#pragma unroll
                for (int v = 0; v < 4; ++v) acc[1 + v] += siluf_(F.c[v * D + k]) * w;
            }
            const float bb = F.b_ada[n];
#pragma unroll
            for (int v = 0; v < 5; ++v) F.MOD[v * 3072 + n] = acc[v] + bb;
            continue;
        }
        r -= I_MOD;
        if (r < I_IN) { const int nblk = DIN / 32, kb = r / nblk, nb = r % nblk; p0_transpose_item(F.w_in, D, DIN, F.WinT, win_dst_row(nb * 32), kb * 64, nb * 32, scr, F.lane); continue; }
        r -= I_IN;
        if (r < I_RD) { const int nblk = D / 32, kb = r / nblk, nb = r % nblk; p0_transpose_item(F.w_ret_down, DRV, D, F.WrdT, nb * 32, kb * 64, nb * 32, scr, F.lane); continue; }
        r -= I_RD;
        if (r < I_LD) { const int nblk = D / 32, kb = r / nblk, nb = r % nblk; p0_transpose_item(F.w_lru_down, DL, D, F.WldT, nb * 32, kb * 64, nb * 32, scr, F.lane); continue; }
        r -= I_LD;
        if (r < I_OUT) { const int nblk = D / 32, kb = r / nblk, nb = r % nblk; p0_transpose_item(F.w_out, D, D, F.WoutT, nb * 32, kb * 64, nb * 32, scr, F.lane); continue; }
        r -= I_OUT;
        {
            const int mi = r / 8, sub = r % 8, slot = mi / NB, hb = mi % NB, kb = sub / 4, nb = sub % 4;
            const float* W = ((slot & 1) ? F.lru_wx : F.lru_wa) + (size_t)((slot >> 1) * NB + hb) * LB * LB;
            p0_transpose_item(W, LB, LB, F.WlruT + (size_t)hb * 512 * LB, slot * 128 + nb * 32, kb * 64, nb * 32, scr, F.lane);
        }
    }
}

__device__ __forceinline__ void phase_h(Frame& F) {
    const int gw = F.wg * NWAVES + F.wave, NGW = F.G * NWAVES;
    for (int m = gw; m < M; m += NGW) {
        const f32x4* xr = (const f32x4*)xrow_ptr(F, m) + F.lane;
        const float* mod = F.MOD + mod_index(m) * 3072;
        f32x4 v[4]; float s = 0.f;
#pragma unroll
        for (int j = 0; j < 4; ++j) { v[j] = xr[64 * j]; s += (v[j].x * v[j].x + v[j].y * v[j].y) + (v[j].z * v[j].z + v[j].w * v[j].w); }
        const float rstd = 1.0f / sqrtf(wave_sum(s) * (1.f / D) + EPS);
        unsigned long long* o8 = (unsigned long long*)(F.H + (size_t)m * D) + F.lane;
#pragma unroll
        for (int j = 0; j < 4; ++j) {
            const int c0 = 4 * F.lane + 256 * j;
            const f32x4 nw = *(const f32x4*)(F.norm_w + c0), sh = *(const f32x4*)(mod + c0), sc = *(const f32x4*)(mod + 1024 + c0);
            const f32x4 h = v[j] * rstd * nw * (sc + 1.0f) + sh;
            o8[64 * j] = (unsigned long long)pk2(h.x, h.y) | ((unsigned long long)pk2(h.z, h.w) << 32);
        }
    }
}

template <class Epi>
__device__ __forceinline__ void gemm_simple(const Frame& F, const bf16* A, int lda, const bf16* Bt, int ldb, int Mr, int Nc, int K, const Epi& epi) {
    const int wr = F.wave >> 2, wc = F.wave & 3, fr = F.lane & 15, fq = F.lane >> 4;
    const int tilesN = Nc / 256, tiles = (Mr / 128) * tilesN;
    for (int t = F.wg; t < tiles; t += F.G) {
        const int tm = t / tilesN, tn = t % tilesN;
        const int row0 = tm * 128 + wr * 64, col0 = tn * 256 + wc * 64;
        f32x4 acc[4][4];
#pragma unroll
        for (int i = 0; i < 4; ++i)
#pragma unroll
            for (int j = 0; j < 4; ++j) acc[i][j] = (f32x4){0.f, 0.f, 0.f, 0.f};
        const bf16* ap = A + (size_t)(row0 + fr) * lda + 8 * fq;
        const bf16* bp = Bt + (size_t)(col0 + fr) * ldb + 8 * fq;
        for (int k0 = 0; k0 < K; k0 += 32) {
            bf16x8 a[4], b[4];
#pragma unroll
            for (int i = 0; i < 4; ++i) a[i] = *(const bf16x8*)(ap + (size_t)(16 * i) * lda + k0);
#pragma unroll
            for (int j = 0; j < 4; ++j) b[j] = *(const bf16x8*)(bp + (size_t)(16 * j) * ldb + k0);
#pragma unroll
            for (int i = 0; i < 4; ++i)
#pragma unroll
                for (int j = 0; j < 4; ++j) acc[i][j] = __builtin_amdgcn_mfma_f32_16x16x32_bf16(a[i], b[j], acc[i][j], 0, 0, 0);
        }
#pragma unroll
        for (int i = 0; i < 4; ++i)
#pragma unroll
            for (int j = 0; j < 4; ++j)
#pragma unroll
                for (int r = 0; r < 4; ++r) epi(row0 + 16 * i + 4 * fq + r, col0 + 16 * j + fr, acc[i][j][r]);
    }
}

struct EpiGemm1 {
    bf16 *Q, *K, *V, *XL, *GL;
    __device__ __forceinline__ void operator()(int row, int col, float v) const {
        if (col < 1024) Q[(size_t)row * 1024 + col] = (bf16)f2bf(v);
        else if (col < 2048) K[(size_t)row * 1024 + col - 1024] = (bf16)f2bf(v * 0.0625f);
        else if (col < 4096) V[(size_t)row * 2048 + col - 2048] = (bf16)f2bf(v);
        else if (col < 5376) XL[(size_t)row * 1280 + col - 4096] = (bf16)f2bf(v);
        else GL[(size_t)row * 1280 + col - 5376] = (bf16)f2bf(siluf_(v));
    }
};
struct EpiGemm2 {
    bf16 *OG, *SIGR, *SIGL;
    __device__ __forceinline__ void operator()(int row, int col, float v) const {
        if (col < 2048) { bf16* p = OG + (size_t)row * 2048 + col; *p = (bf16)f2bf(bf2f(*p) * siluf_(v)); }
        else if (col < 3072) SIGR[(size_t)row * 1024 + col - 2048] = (bf16)f2bf(sigmoidf_(v));
        else SIGL[(size_t)row * 1024 + col - 3072] = (bf16)f2bf(sigmoidf_(v));
    }
};
struct EpiDownR { bf16 *MERGED; const bf16* SIG;
    __device__ __forceinline__ void operator()(int row, int col, float v) const { const size_t o = (size_t)row * 1024 + col; MERGED[o] = (bf16)f2bf(bf2f(SIG[o]) * v); } };
struct EpiDownL { bf16 *MERGED; const bf16* SIG;
    __device__ __forceinline__ void operator()(int row, int col, float v) const { const size_t o = (size_t)row * 1024 + col; MERGED[o] = (bf16)f2bf(bf2f(MERGED[o]) + bf2f(SIG[o]) * v); } };
struct EpiOut { float* Y; const float *xp, *xs, *MOD;
    __device__ __forceinline__ void operator()(int row, int col, float v) const {
        const float xv = row < MCTX ? xp[(size_t)row * D + col] : xs[(size_t)(row - MCTX) * D + col];
        Y[(size_t)row * D + col] = xv + MOD[mod_index(row) * 3072 + 2048 + col] * v;
    } };

__device__ __forceinline__ void lru_item(Frame& F, int T, int hb, bool fin) {
    const int row0 = 64 * T, tid = F.tid;
    int b, seq0, L; bool lat;
    if (row0 < MCTX) { b = row0 / LCTX; seq0 = b * LCTX; L = LCTX; lat = false; } else { b = (row0 - MCTX) / LLAT; seq0 = MCTX + b * LLAT; L = LLAT; lat = true; }
    const int p0 = row0 - seq0, ti = p0 / 64, ntile = L / 64;
    LAS float* xc = (LAS float*)F.lds; LAS float* a_s = xc + 8192; LAS float* b_s = xc + 16384; LAS float* hf_s = xc + 24576;
    for (int idx = tid; idx < 64 * 128; idx += NTHR) {
        const int t = idx >> 7, c = idx & 127, ch = hb * 128 + c;
        float acc = F.conv_b[ch];
#pragma unroll
        for (int tap = 0; tap < 4; ++tap) {
            const int tt = t + tap - 2; bool ok;
            if (lat) ok = (tt >= 0 && tt < 64); else { const int p = p0 + tt; ok = (p >= 0 && p < L); }
            if (ok) acc += F.conv_w[tap * DL + ch] * bf2f(F.XL[(size_t)(row0 + tt) * DL + ch]);
        }
        xc[idx] = acc;
    }
    __syncthreads();
    const int c = tid & 127, tg = tid >> 7, ch = hb * 128 + c;
    const bf16* W = F.WlruT + (size_t)hb * 512 * LB;
#pragma unroll 1
    for (int dir = 0; dir < 2; ++dir) {
        float acc[2][16];
#pragma unroll
        for (int s = 0; s < 2; ++s)
#pragma unroll
            for (int t = 0; t < 16; ++t) acc[s][t] = 0.f;
        const bf16* W0 = W + (size_t)((2 * dir) * 128 + c) * LB; const bf16* W1 = W + (size_t)((2 * dir + 1) * 128 + c) * LB;
#pragma unroll 2
        for (int i = 0; i < 128; ++i) {
            const float w0 = bf2f(W0[i]), w1 = bf2f(W1[i]);
#pragma unroll
            for (int t = 0; t < 16; ++t) { const float xv = bfr(xc[(tg * 16 + t) * 128 + i]); acc[0][t] += xv * w0; acc[1][t] += xv * w1; }
        }
        const float ba = F.lru_ba[dir * DL + ch], bx = F.lru_bx[dir * DL + ch];
        const float sp = log1pf(expf(-F.lru_a[dir * DL + ch]));
#pragma unroll
        for (int t = 0; t < 16; ++t) {
            const int tok = tg * 16 + t;
            const float r = sigmoidf_(acc[0][t] + ba), gi = sigmoidf_(acc[1][t] + bx);
            const float la = -8.0f * r * sp;
            a_s[tok * 128 + c] = expf(la);
            b_s[tok * 128 + c] = sqrtf(-expm1f(2.0f * la)) * gi * xc[tok * 128 + c];
        }
        __syncthreads();
        if (tid < 128) {
            const int cc = tid, chh = hb * 128 + cc;
            float carry = 0.f;
            if (fin) {
                carry = lat ? F.state_lru[(size_t)(b * 2 + dir) * DL + chh] : 0.f;
                if (dir == 0) { for (int n = 0; n < ti; ++n) { const float* ag = F.AGG + ((size_t)((T - ti + n) * 2 + 0) * 2) * DL; carry = ag[chh] * carry + ag[DL + chh]; } }
                else { for (int n = ntile - 1; n > ti; --n) { const float* ag = F.AGG + ((size_t)((T - ti + n) * 2 + 1) * 2) * DL; carry = ag[chh] * carry + ag[DL + chh]; } }
            }
            float h = carry, P = 1.f;
            if (dir == 0) {
                for (int t = 0; t < 64; ++t) { const float a = a_s[t * 128 + cc]; h = a * h + b_s[t * 128 + cc]; P *= a; if (fin) hf_s[t * 128 + cc] = h; }
                if (fin && !lat && ti == ntile - 1) F.out[OUT_NSL + (size_t)(b * 2 + 0) * DL + chh] = h;
            } else {
                for (int t = 63; t >= 0; --t) { const float a = a_s[t * 128 + cc]; h = a * h + b_s[t * 128 + cc]; P *= a; if (fin) hf_s[t * 128 + cc] += h; }
                if (fin && !lat && ti == 0) F.out[OUT_NSL + (size_t)(b * 2 + 1) * DL + chh] = h;
            }
            if (!fin) { float* ag = F.AGG + ((size_t)(T * 2 + dir) * 2) * DL; ag[chh] = P; ag[DL + chh] = h; }
        }
        __syncthreads();
    }
    if (fin) {
        for (int idx = tid; idx < 64 * 128; idx += NTHR) {
            const int t = idx >> 7, cc = idx & 127; const size_t o = (size_t)(row0 + t) * DL + hb * 128 + cc;
            F.HL[o] = (bf16)f2bf(hf_s[idx] * bf2f(F.GL[o]));
        }
    }
    __syncthreads();
}
__device__ __forceinline__ void phase_lru(Frame& F, bool fin) {
    for (int it = F.wg; it < (M / 64) * NB; it += F.G) lru_item(F, it / NB, it % NB, fin);
}

__device__ __forceinline__ float log_gamma(const Frame& F, int dir, int h) { const float x = F.decay_logit[dir * NH + h]; return -log1pf(expf(-x)); }
__device__ __forceinline__ size_t sp_index(int b, int h, int dir, int n) { return ((size_t)(((b * NH + h) * 2 + dir) * NCH_LAT + n)) * (DK * DV); }
__device__ __forceinline__ void phase_r12(Frame& F) {
    const int e = F.tid;
    constexpr int ITEMS = (NCTX + NLAT) * NH * 2 * (DK / 4);
    for (int it = F.wg; it < ITEMS; it += F.G) {
        int r = it; const int dg = r % (DK / 4); r /= (DK / 4); const int dir = r & 1; r >>= 1; const int h = r % NH; const int s = r / NH;
        const bool lat = s >= NCTX; const int b = lat ? s - NCTX : s; const int L = lat ? LLAT : LCTX; const int seq0 = lat ? MCTX + b * LLAT : b * LCTX;
        const float g = expf(log_gamma(F, dir, h));
        float S[4];
#pragma unroll
        for (int u = 0; u < 4; ++u) S[u] = lat ? F.state_ret[((size_t)((b * 2 + dir) * NH + h) * DK + dg * 4 + u) * DV + e] : 0.f;
        const int nch = L / CH;
        for (int nn = 0; nn < nch; ++nn) {
            const int n = dir == 0 ? nn : nch - 1 - nn;
            if (lat) {
#pragma unroll
                for (int u = 0; u < 4; ++u) F.SP[sp_index(b, h, dir, n) + (size_t)(dg * 4 + u) * DV + e] = (bf16)f2bf(S[u]);
            }
            for (int ii = 0; ii < CH; ++ii) {
                const int i = dir == 0 ? ii : CH - 1 - ii; const size_t row = (size_t)seq0 + n * CH + i;
                const float vv = bf2f(F.V[row * DRV + h * DV + e]);
                const unsigned long long kk = *(const unsigned long long*)(F.K + row * DQK + h * DK + dg * 4);
#pragma unroll
                for (int u = 0; u < 4; ++u) S[u] = g * S[u] + bf2f((unsigned short)(kk >> (16 * u))) * vv;
            }
        }
        if (!lat) {
#pragma unroll
            for (int u = 0; u < 4; ++u) F.out[OUT_NSR + ((size_t)((b * 2 + dir) * NH + h) * DK + dg * 4 + u) * DV + e] = S[u];
        }
    }
}

__device__ __forceinline__ void phase_r3(Frame& F) {
    LAS float* qs = (LAS float*)F.lds; LAS float* Ps = qs + 256; LAS float* red = qs + 512;
    const int tid = F.tid;
    for (int it = F.wg; it < M * NH; it += F.G) {
        const int row = it / NH, h = it % NH;
        const bool lat = row >= MCTX; const int b = lat ? (row - MCTX) / LLAT : row / LCTX; const int seq0 = lat ? MCTX + b * LLAT : b * LCTX;
        const int p = row - seq0, n = p / CH, i = p % CH, crow0 = row - i;
        const float lgf = log_gamma(F, 0, h), lgb = log_gamma(F, 1, h);
        if (tid < 256) qs[tid] = bf2f(F.Q[(size_t)row * DQK + h * DK + tid]);
        __syncthreads();
        if (tid < 256) {
            const int j = tid; const bf16* kr = F.K + (size_t)(crow0 + j) * DQK + h * DK; float s = 0.f;
            for (int d = 0; d < DK; d += 8) { const v4u kv = *(const v4u*)(kr + d);
                s += qs[d] * bf2f((unsigned short)kv.x) + qs[d + 1] * bf2f((unsigned short)(kv.x >> 16)) + qs[d + 2] * bf2f((unsigned short)kv.y) + qs[d + 3] * bf2f((unsigned short)(kv.y >> 16))
                   + qs[d + 4] * bf2f((unsigned short)kv.z) + qs[d + 5] * bf2f((unsigned short)(kv.z >> 16)) + qs[d + 6] * bf2f((unsigned short)kv.w) + qs[d + 7] * bf2f((unsigned short)(kv.w >> 16)); }
            const int dj = i - j; const float dec = dj >= 0 ? expf(lgf * (float)dj) : expf(lgb * (float)(-dj));
            Ps[j] = bfr(s * dec);
        }
        __syncthreads();
        const int e = tid; float acc = 0.f;
        for (int j = 0; j < CH; ++j) acc += Ps[j] * bf2f(F.V[(size_t)(crow0 + j) * DRV + h * DV + e]);
        if (lat) {
            const bf16* sf = F.SP + sp_index(b, h, 0, n); const bf16* sb = F.SP + sp_index(b, h, 1, n);
            float af = 0.f, ab = 0.f;
            for (int d = 0; d < DK; ++d) { af += qs[d] * bf2f(sf[(size_t)d * DV + e]); ab += qs[d] * bf2f(sb[(size_t)d * DV + e]); }
            acc += expf(lgf * (float)(i + 1)) * af + expf(lgb * (float)(CH - i)) * ab;
        }
        float ss = wave_sum(acc * acc);
        if (F.lane == 0) red[F.wave] = ss;
        __syncthreads();
        ss = 0.f;
#pragma unroll
        for (int w = 0; w < NWAVES; ++w) ss += red[w];
        const float sc = 1.0f / sqrtf(ss * (1.0f / DV) + EPS);
        F.OG[(size_t)row * DRV + h * DV + e] = (bf16)f2bf(acc * sc * F.gn_w[h * DV + e]);
        __syncthreads();
    }
}


typedef float f32x16 __attribute__((ext_vector_type(16)));
typedef short s16x4 __attribute__((ext_vector_type(4)));
typedef short v4i16_t __attribute__((ext_vector_type(4)));
typedef float f32x2_t __attribute__((ext_vector_type(2))); typedef __bf16 bf16x2_t __attribute__((ext_vector_type(2)));
typedef LAS const char* lds_cptr;
#define MFMA32(a, b, c) __builtin_amdgcn_mfma_f32_32x32x16_bf16((a), (b), (c), 0, 0, 0)
__device__ __forceinline__ int crow(int reg, int hh) { return (reg & 3) + 8 * (reg >> 2) + 4 * hh; }
__device__ __forceinline__ s16x4 vtr(lds_cptr p) { return __builtin_bit_cast(s16x4, __builtin_amdgcn_ds_read_tr16_b64_v4i16((LAS v4i16_t*)p)); }
__device__ __forceinline__ unsigned cvtpk(float lo, float hi) { f32x2_t v = {lo, hi}; bf16x2_t b = __builtin_convertvector(v, bf16x2_t); return __builtin_bit_cast(unsigned, b); }
__device__ __forceinline__ bf16x8 cat8(s16x4 lo, s16x4 hi) { return (bf16x8){lo[0], lo[1], lo[2], lo[3], hi[0], hi[1], hi[2], hi[3]}; }
__device__ __forceinline__ float ulo(unsigned w) { return __builtin_bit_cast(float, w << 16); }
__device__ __forceinline__ float uhi(unsigned w) { return __builtin_bit_cast(float, w & 0xffff0000u); }

constexpr int EQ = 128, NET = EQ / 32;
constexpr int KSTR = 528;
constexpr int KTSTR = 576;
constexpr int VSTR = 320;
constexpr int R3_KB0 = 0, R3_KB1 = 32 * KSTR, R3_VB0 = 2 * 32 * KSTR, R3_VB1 = R3_VB0 + 32 * VSTR;
constexpr int R12_KB0 = 0, R12_KB1 = 32 * KTSTR, R12_VB0 = 2 * 32 * KTSTR, R12_VB1 = R12_VB0 + 32 * VSTR;

__device__ __forceinline__ void r3f_item(Frame& F, int it) {
    bool lat; int b, n, h, eq;
    if (it < NLAT * NCH_LAT * NH * 4) { lat = true; eq = it & 3; h = (it >> 2) & 3; n = (it >> 4) & 7; b = it >> 7; }
    else { const int i2 = it - NLAT * NCH_LAT * NH * 4; lat = false; eq = i2 & 3; h = (i2 >> 2) & 3; n = 0; b = i2 >> 4; }
    const int seq0 = lat ? MCTX + b * LLAT : b * LCTX, row0 = seq0 + n * CH;
    const int tid = F.tid, lane = F.lane, w = F.wave, r32 = lane & 31, hh = lane >> 5;
    const float lgf = log_gamma(F, 0, h), lgb = log_gamma(F, 1, h);
    LAS char* lds = (LAS char*)F.lds;
    bf16x8 qf[16];
    { const bf16* qp = F.Q + (size_t)(row0 + 32 * w + r32) * DQK + h * DK + 8 * hh;
#pragma unroll
      for (int ks = 0; ks < 16; ++ks) qf[ks] = *(const bf16x8*)(qp + 16 * ks); }
    f32x16 acc[NET];
#pragma unroll
    for (int et = 0; et < NET; ++et)
#pragma unroll
        for (int r = 0; r < 16; ++r) acc[et][r] = 0.f;
    const int vrow = tid >> 4, vch = tid & 15;
    const int blk = (lane >> 4) & 1, q4 = (lane & 15) >> 2, p4 = lane & 3;
    const int trn = (8 * hh + q4) * VSTR + 32 * blk + 8 * p4;
    const int trp = (4 * hh + q4) * VSTR + 32 * blk + 8 * p4;
    if (lat) {
#pragma unroll 1
        for (int dir = 0; dir < 2; ++dir) {
            const bf16* sp = F.SP + sp_index(b, h, dir, n) + eq * EQ;
            { const v4u v = *(const v4u*)(sp + (size_t)vrow * DV + vch * 8); *(LAS v4u*)(lds + R3_VB0 + vrow * VSTR + vch * 16) = v; }
            __syncthreads();
#pragma unroll
            for (int db = 0; db < 8; ++db) {
                v4u nv = {0u, 0u, 0u, 0u};
                if (db < 7) nv = *(const v4u*)(sp + (size_t)(32 * (db + 1) + vrow) * DV + vch * 8);
                lds_cptr vb = lds + ((db & 1) ? R3_VB1 : R3_VB0);
#pragma unroll
                for (int ks2 = 0; ks2 < 2; ++ks2)
#pragma unroll
                    for (int et = 0; et < NET; ++et) {
                        const s16x4 lo = vtr(vb + trn + (16 * ks2) * VSTR + 64 * et), hi = vtr(vb + trn + (16 * ks2 + 4) * VSTR + 64 * et);
                        acc[et] = MFMA32(qf[2 * db + ks2], cat8(lo, hi), acc[et]);
                    }
                if (db < 7) *(LAS v4u*)(lds + ((db & 1) ? R3_VB0 : R3_VB1) + vrow * VSTR + vch * 16) = nv;
                __syncthreads();
            }
#pragma unroll
            for (int r = 0; r < 16; ++r) {
                const float i = (float)(32 * w + crow(r, hh));
                const float f = dir == 0 ? __expf(lgf * (i + 1.0f) - lgb * (256.0f - i)) : __expf(lgb * (256.0f - i));
#pragma unroll
                for (int et = 0; et < NET; ++et) acc[et][r] *= f;
            }
        }
    }
    {
        const bf16* kp = F.K + (size_t)row0 * DQK + h * DK; const bf16* vp = F.V + (size_t)row0 * DRV + h * DV + eq * EQ;
        const int krow0 = tid >> 5, kch = tid & 31;
        { const v4u k0 = *(const v4u*)(kp + (size_t)krow0 * DQK + kch * 8), k1 = *(const v4u*)(kp + (size_t)(krow0 + 16) * DQK + kch * 8);
          const v4u v0 = *(const v4u*)(vp + (size_t)vrow * DRV + vch * 8);
          *(LAS v4u*)(lds + R3_KB0 + krow0 * KSTR + kch * 16) = k0; *(LAS v4u*)(lds + R3_KB0 + (krow0 + 16) * KSTR + kch * 16) = k1;
          *(LAS v4u*)(lds + R3_VB0 + vrow * VSTR + vch * 16) = v0; }
        __syncthreads();
#pragma unroll 1
        for (int jb = 0; jb < 8; ++jb) {
            const int cur = jb & 1;
            v4u k0 = {0u, 0u, 0u, 0u}, k1 = k0, v0 = k0;
            if (jb < 7) { const size_t r1 = (size_t)(32 * (jb + 1));
                k0 = *(const v4u*)(kp + (r1 + krow0) * DQK + kch * 8); k1 = *(const v4u*)(kp + (r1 + krow0 + 16) * DQK + kch * 8);
                v0 = *(const v4u*)(vp + (r1 + vrow) * DRV + vch * 8); }
            lds_cptr kb = lds + (cur ? R3_KB1 : R3_KB0) + r32 * KSTR + 16 * hh;
            lds_cptr vb = lds + (cur ? R3_VB1 : R3_VB0);
            f32x16 X;
#pragma unroll
            for (int r = 0; r < 16; ++r) X[r] = 0.f;
#pragma unroll
            for (int ks = 0; ks < 16; ++ks) { const bf16x8 a = *(const LAS bf16x8*)(kb + 32 * ks); X = MFMA32(a, qf[ks], X); }
            const int qi = 32 * w + r32;
#pragma unroll
            for (int r = 0; r < 16; ++r) { const int dj = qi - (32 * jb + crow(r, hh)); X[r] *= dj >= 0 ? __expf(lgf * (float)dj) : __expf(-lgb * (float)dj); }
            bf16x8 pa[2];
#pragma unroll
            for (int s2 = 0; s2 < 2; ++s2) { const unsigned u0 = cvtpk(X[8 * s2], X[8 * s2 + 1]), u1 = cvtpk(X[8 * s2 + 2], X[8 * s2 + 3]), u2 = cvtpk(X[8 * s2 + 4], X[8 * s2 + 5]), u3 = cvtpk(X[8 * s2 + 6], X[8 * s2 + 7]);
                pa[s2] = __builtin_bit_cast(bf16x8, (v4u){u0, u1, u2, u3}); }
#pragma unroll
            for (int s2 = 0; s2 < 2; ++s2)
#pragma unroll
                for (int et = 0; et < NET; ++et) {
                    const s16x4 lo = vtr(vb + trp + (16 * s2) * VSTR + 64 * et), hi = vtr(vb + trp + (16 * s2 + 8) * VSTR + 64 * et);
                    acc[et] = MFMA32(pa[s2], cat8(lo, hi), acc[et]);
                }
            if (jb < 7) { LAS char* kn = lds + (cur ? R3_KB0 : R3_KB1); LAS char* vn = lds + (cur ? R3_VB0 : R3_VB1);
                *(LAS v4u*)(kn + krow0 * KSTR + kch * 16) = k0; *(LAS v4u*)(kn + (krow0 + 16) * KSTR + kch * 16) = k1; *(LAS v4u*)(vn + vrow * VSTR + vch * 16) = v0; }
            __syncthreads();
        }
    }
#pragma unroll
    for (int r = 0; r < 16; ++r) {
        float ss = 0.f;
#pragma unroll
        for (int et = 0; et < NET; ++et) ss += acc[et][r] * acc[et][r];
#pragma unroll
        for (int o = 1; o < 32; o <<= 1) ss += __shfl_xor(ss, o);
        const int row = row0 + 32 * w + crow(r, hh);
        if (r32 == 0) F.SS[((size_t)row * NH + h) * 4 + eq] = ss;
        bf16* op = F.OG + (size_t)row * DRV + h * DV + eq * EQ + r32;
#pragma unroll
        for (int et = 0; et < NET; ++et) op[32 * et] = (bf16)f2bf(acc[et][r]);
    }
}
__device__ __forceinline__ void phase_r3f(Frame& F) {
    for (int it = F.wg; it < (NLAT * NCH_LAT + NCTX) * NH * 4; it += F.G) r3f_item(F, it);
}

__device__ __forceinline__ void r12f_item(Frame& F, int it) {
    bool lat; int b, h, dir, eq;
    if (it < NLAT * NH * 2 * 4) { lat = true; eq = it & 3; dir = (it >> 2) & 1; h = (it >> 3) & 3; b = it >> 5; }
    else { const int i2 = it - NLAT * NH * 2 * 4; lat = false; eq = i2 & 3; dir = (i2 >> 2) & 1; h = (i2 >> 3) & 3; b = i2 >> 5; }
    const int seq0 = lat ? MCTX + b * LLAT : b * LCTX;
    const int tid = F.tid, lane = F.lane, w = F.wave, r32 = lane & 31, hh = lane >> 5;
    const float lg = log_gamma(F, dir, h);
    LAS char* lds = (LAS char*)F.lds;
    f32x16 acc[NET];
    if (lat) {
        const float* s0 = F.state_ret + ((size_t)((b * 2 + dir) * NH + h) * DK) * DV + eq * EQ + r32;
#pragma unroll
        for (int et = 0; et < NET; ++et)
#pragma unroll
            for (int r = 0; r < 16; ++r) acc[et][r] = s0[(size_t)(32 * w + crow(r, hh)) * DV + 32 * et];
    } else {
#pragma unroll
        for (int et = 0; et < NET; ++et)
#pragma unroll
            for (int r = 0; r < 16; ++r) acc[et][r] = 0.f;
    }
    const int nproc = lat ? NCH_LAT - 1 : 1;
    const int nblocks = nproc * 8;
    const int vrow = tid >> 4, vch = tid & 15, krow0 = tid >> 5, kch = tid & 31;
    const int blk = (lane >> 4) & 1, q4 = (lane & 15) >> 2, p4 = lane & 3;
    const int tra = (8 * hh + q4) * KTSTR + 64 * w + 32 * blk + 8 * p4;
    const int trb = (8 * hh + q4) * VSTR + 32 * blk + 8 * p4;
    const bf16* kp = F.K + (size_t)seq0 * DQK + h * DK; const bf16* vp = F.V + (size_t)seq0 * DRV + h * DV + eq * EQ;
    const float g256 = __expf(lg * 256.0f);
    const int nch = lat ? NCH_LAT : 1;
    v4u k0, k1, v0;
#define R12_LOAD(t) do { const int cn_ = (t) >> 3, tb_ = (t) & 7, n_ = dir ? nch - 1 - cn_ : cn_; const size_t r_ = (size_t)(n_ * CH + 32 * tb_); \
        k0 = *(const v4u*)(kp + (r_ + krow0) * DQK + kch * 8); k1 = *(const v4u*)(kp + (r_ + krow0 + 16) * DQK + kch * 8); \
        const v4u vv_ = *(const v4u*)(vp + (r_ + vrow) * DRV + vch * 8); const int pos_ = 32 * tb_ + vrow; \
        const float dec_ = __expf(lg * (float)(dir ? pos_ : 255 - pos_)); \
        v0.x = cvtpk(ulo(vv_.x) * dec_, uhi(vv_.x) * dec_); v0.y = cvtpk(ulo(vv_.y) * dec_, uhi(vv_.y) * dec_); v0.z = cvtpk(ulo(vv_.z) * dec_, uhi(vv_.z) * dec_); v0.w = cvtpk(ulo(vv_.w) * dec_, uhi(vv_.w) * dec_); } while (0)
#define R12_STORE(buf) do { LAS char* kn_ = lds + ((buf) ? R12_KB1 : R12_KB0); LAS char* vn_ = lds + ((buf) ? R12_VB1 : R12_VB0); \
        *(LAS v4u*)(kn_ + krow0 * KTSTR + kch * 16) = k0; *(LAS v4u*)(kn_ + (krow0 + 16) * KTSTR + kch * 16) = k1; *(LAS v4u*)(vn_ + vrow * VSTR + vch * 16) = v0; } while (0)
    R12_LOAD(0); R12_STORE(0);
    __syncthreads();
#pragma unroll 1
    for (int t = 0; t < nblocks; ++t) {
        const int cur = t & 1;
        if ((t & 7) == 0) {
            if (lat) {
                const int cn = t >> 3, n = dir ? nch - 1 - cn : cn;
                bf16* sp = F.SP + sp_index(b, h, dir, n) + eq * EQ + r32;
#pragma unroll
                for (int et = 0; et < NET; ++et)
#pragma unroll
                    for (int r = 0; r < 16; ++r) sp[(size_t)(32 * w + crow(r, hh)) * DV + 32 * et] = (bf16)f2bf(acc[et][r]);
            }
#pragma unroll
            for (int et = 0; et < NET; ++et)
#pragma unroll
                for (int r = 0; r < 16; ++r) acc[et][r] *= g256;
        }
        if (t + 1 < nblocks) R12_LOAD(t + 1);
        lds_cptr kb = lds + (cur ? R12_KB1 : R12_KB0), vb = lds + (cur ? R12_VB1 : R12_VB0);
#pragma unroll
        for (int ks2 = 0; ks2 < 2; ++ks2) {
            const bf16x8 a = cat8(vtr(kb + tra + (16 * ks2) * KTSTR), vtr(kb + tra + (16 * ks2 + 4) * KTSTR));
#pragma unroll
            for (int et = 0; et < NET; ++et) {
                const bf16x8 bb = cat8(vtr(vb + trb + (16 * ks2) * VSTR + 64 * et), vtr(vb + trb + (16 * ks2 + 4) * VSTR + 64 * et));
                acc[et] = MFMA32(a, bb, acc[et]);
            }
        }
        if (t + 1 < nblocks) R12_STORE(cur ^ 1);
        __syncthreads();
    }
#undef R12_LOAD
#undef R12_STORE
    if (lat) {
        const int n = dir ? 0 : nch - 1;
        bf16* sp = F.SP + sp_index(b, h, dir, n) + eq * EQ + r32;
#pragma unroll
        for (int et = 0; et < NET; ++et)
#pragma unroll
            for (int r = 0; r < 16; ++r) sp[(size_t)(32 * w + crow(r, hh)) * DV + 32 * et] = (bf16)f2bf(acc[et][r]);
    } else {
        float* op = F.out + OUT_NSR + ((size_t)((b * 2 + dir) * NH + h) * DK) * DV + eq * EQ + r32;
#pragma unroll
        for (int et = 0; et < NET; ++et)
#pragma unroll
            for (int r = 0; r < 16; ++r) op[(size_t)(32 * w + crow(r, hh)) * DV + 32 * et] = acc[et][r];
    }
}
__device__ __forceinline__ void phase_r12f(Frame& F) {
    constexpr int NLI = NLAT * NH * 2 * 4, NCI = NCTX * NH * 2 * 4;
    if (F.G == 256) {
        if (F.wg < NLI) r12f_item(F, F.wg);
        else { for (int j = 0; j < 4; ++j) r12f_item(F, NLI + (F.wg - NLI) * 4 + j); }
    } else {
        for (int it = F.wg; it < NLI + NCI; it += F.G) r12f_item(F, it);
    }
}


constexpr int XSTR = 272, LRU_XCB = 0, LRU_AS = 64 * XSTR, LRU_BS = LRU_AS + 32768, LRU_HF = LRU_BS + 32768;
__device__ __forceinline__ void lruf_item(Frame& F, int T, int hb, bool fin) {
    const int row0 = 64 * T, tid = F.tid, lane = F.lane, w = F.wave, r32 = lane & 31, hh = lane >> 5;
    int b, seq0, L; bool lat;
    if (row0 < MCTX) { b = row0 / LCTX; seq0 = b * LCTX; L = LCTX; lat = false; } else { b = (row0 - MCTX) / LLAT; seq0 = MCTX + b * LLAT; L = LLAT; lat = true; }
    const int p0 = row0 - seq0, ti = p0 / 64, ntile = L / 64;
    LAS char* lds = (LAS char*)F.lds;
    LAS float* a_s = (LAS float*)(lds + LRU_AS); LAS float* b_s = (LAS float*)(lds + LRU_BS); LAS float* hf_s = (LAS float*)(lds + LRU_HF);
#pragma unroll
    for (int pp = 0; pp < 2; ++pp) {
        const int piece = tid + 512 * pp, t = piece >> 4, c8 = piece & 15, ch0 = hb * 128 + 8 * c8;
        f32x4 x0 = *(const f32x4*)(F.conv_b + ch0), x1 = *(const f32x4*)(F.conv_b + ch0 + 4);
#pragma unroll
        for (int tap = 0; tap < 4; ++tap) {
            const int tt = t + tap - 2; bool ok;
            if (lat) ok = (tt >= 0 && tt < 64); else { const int p = p0 + tt; ok = (p >= 0 && p < L); }
            if (ok) {
                const v4u raw = *(const v4u*)(F.XL + (size_t)(row0 + tt) * DL + ch0);
                const f32x4 w0 = *(const f32x4*)(F.conv_w + tap * DL + ch0), w1 = *(const f32x4*)(F.conv_w + tap * DL + ch0 + 4);
                x0[0] += w0[0] * ulo(raw.x); x0[1] += w0[1] * uhi(raw.x); x0[2] += w0[2] * ulo(raw.y); x0[3] += w0[3] * uhi(raw.y);
                x1[0] += w1[0] * ulo(raw.z); x1[1] += w1[1] * uhi(raw.z); x1[2] += w1[2] * ulo(raw.w); x1[3] += w1[3] * uhi(raw.w);
            }
        }
        v4u o; o.x = cvtpk(x0[0], x0[1]); o.y = cvtpk(x0[2], x0[3]); o.z = cvtpk(x1[0], x1[1]); o.w = cvtpk(x1[2], x1[3]);
        *(LAS v4u*)(lds + LRU_XCB + t * XSTR + c8 * 16) = o;
    }
    __syncthreads();
    const int rt = w >> 2, cg = w & 3, c = 32 * cg + r32, ch = hb * 128 + c;
#pragma unroll 1
    for (int dir = 0; dir < 2; ++dir) {
        f32x16 acc0, acc1;
#pragma unroll
        for (int r = 0; r < 16; ++r) { acc0[r] = 0.f; acc1[r] = 0.f; }
        const bf16* wb = F.WlruT + (size_t)hb * 512 * LB + (size_t)((2 * dir) * 128 + c) * LB + 8 * hh;
        lds_cptr xa = lds + LRU_XCB + (32 * rt + r32) * XSTR + 16 * hh;
#pragma unroll
        for (int ks = 0; ks < 8; ++ks) {
            const bf16x8 a = *(const LAS bf16x8*)(xa + 32 * ks);
            const bf16x8 b0 = *(const bf16x8*)(wb + 16 * ks), b1 = *(const bf16x8*)(wb + 128 * LB + 16 * ks);
            acc0 = MFMA32(a, b0, acc0); acc1 = MFMA32(a, b1, acc1);
        }
        const float ba = F.lru_ba[dir * DL + ch], bx = F.lru_bx[dir * DL + ch];
        const float sp = log1pf(expf(-F.lru_a[dir * DL + ch]));
#pragma unroll
        for (int r = 0; r < 16; ++r) {
            const int tok = 32 * rt + crow(r, hh);
            const float rr = sigmoidf_(acc0[r] + ba), gi = sigmoidf_(acc1[r] + bx);
            const float la = -8.0f * rr * sp;
            const float xv = bf2f(*(const LAS bf16*)(lds + LRU_XCB + tok * XSTR + c * 2));
            a_s[tok * 128 + c] = __expf(la);
            b_s[tok * 128 + c] = sqrtf(-expm1f(2.0f * la)) * gi * xv;
        }
        __syncthreads();
        if (tid < 128) {
            const int cc = tid, chh = hb * 128 + cc;
            float carry = 0.f;
            if (fin) {
                carry = lat ? F.state_lru[(size_t)(b * 2 + dir) * DL + chh] : 0.f;
                if (dir == 0) { for (int n = 0; n < ti; ++n) { const float* ag = F.AGG + ((size_t)((T - ti + n) * 2 + 0) * 2) * DL; carry = ag[chh] * carry + ag[DL + chh]; } }
                else { for (int n = ntile - 1; n > ti; --n) { const float* ag = F.AGG + ((size_t)((T - ti + n) * 2 + 1) * 2) * DL; carry = ag[chh] * carry + ag[DL + chh]; } }
            }
            float h = carry, P = 1.f;
            if (dir == 0) {
#pragma unroll 8
                for (int t = 0; t < 64; ++t) { const float a = a_s[t * 128 + cc]; h = a * h + b_s[t * 128 + cc]; P *= a; if (fin) hf_s[t * 128 + cc] = h; }
                if (fin && !lat && ti == ntile - 1) F.out[OUT_NSL + (size_t)(b * 2 + 0) * DL + chh] = h;
            } else {
#pragma unroll 8
                for (int t = 63; t >= 0; --t) { const float a = a_s[t * 128 + cc]; h = a * h + b_s[t * 128 + cc]; P *= a; if (fin) hf_s[t * 128 + cc] += h; }
                if (fin && !lat && ti == 0) F.out[OUT_NSL + (size_t)(b * 2 + 1) * DL + chh] = h;
            }
            if (!fin) { float* ag = F.AGG + ((size_t)(T * 2 + dir) * 2) * DL; ag[chh] = P; ag[DL + chh] = h; }
        }
        __syncthreads();
    }
    if (fin) {
#pragma unroll
        for (int pp = 0; pp < 2; ++pp) {
            const int piece = tid + 512 * pp, t = piece >> 4, c8 = piece & 15; const size_t o = (size_t)(row0 + t) * DL + hb * 128 + 8 * c8;
            const v4u g = *(const v4u*)(F.GL + o); const LAS float* hp = hf_s + t * 128 + 8 * c8;
            const f32x4 h0 = *(const LAS f32x4*)hp, h1 = *(const LAS f32x4*)(hp + 4);
            v4u r; r.x = cvtpk(h0[0] * ulo(g.x), h0[1] * uhi(g.x)); r.y = cvtpk(h0[2] * ulo(g.y), h0[3] * uhi(g.y)); r.z = cvtpk(h1[0] * ulo(g.z), h1[1] * uhi(g.z)); r.w = cvtpk(h1[2] * ulo(g.w), h1[3] * uhi(g.w));
            *(v4u*)(F.HL + o) = r;
        }
    }
    __syncthreads();
}
__device__ __forceinline__ void phase_lruf(Frame& F, bool fin) {
    for (int it = F.wg; it < (M / 64) * NB; it += F.G) lruf_item(F, it / NB, it % NB, fin);
}

__device__ __forceinline__ void phase_norm(Frame& F) {
    const int gw = F.wg * NWAVES + F.wave, NGW = F.G * NWAVES;
    for (int m = gw; m < M; m += NGW) {
        f32x4* yr = (f32x4*)(F.out + OUT_Y + (size_t)m * D) + F.lane;
        f32x4 v[4]; float s = 0.f;
#pragma unroll
        for (int j = 0; j < 4; ++j) { v[j] = yr[64 * j]; s += (v[j].x * v[j].x + v[j].y * v[j].y) + (v[j].z * v[j].z + v[j].w * v[j].w); }
        const float rstd = 1.0f / sqrtf(wave_sum(s) * (1.f / D) + EPS);
#pragma unroll
        for (int j = 0; j < 4; ++j) { const f32x4 nw = *(const f32x4*)(F.final_norm_w + 4 * F.lane + 256 * j); yr[64 * j] = v[j] * rstd * nw; }
    }
}

constexpr int PH_PREP = 0, PH_H = 1, PH_GEMM1 = 2, PH_LRUA = 3, PH_LRUB = 4, PH_R12 = 5, PH_R3 = 6, PH_G2 = 7, PH_DOWN = 8, PH_OUT = 9, PH_NORM = 10, N_PHASES = 11;

__global__ void __launch_bounds__(NTHR, 2) fwd_kernel(Args args) {
    extern __shared__ __attribute__((aligned(16))) unsigned char lds_raw[];
    Frame F;
    F.lds = (LAS unsigned char*)lds_raw;
    F.tid = threadIdx.x; F.lane = F.tid & 63; F.wave = __builtin_amdgcn_readfirstlane(F.tid >> 6);
    F.G = gridDim.x; F.wg = blockIdx.x;
    F.x_prompt = args.in[0]; F.x_sample = args.in[1]; F.state_ret = args.in[2]; F.state_lru = args.in[3]; F.c = args.in[4]; F.c_ctx = args.in[5];
    F.norm_w = args.in[6]; F.w_ada = args.in[7]; F.b_ada = args.in[8]; F.w_in = args.in[9]; F.decay_logit = args.in[10]; F.gn_w = args.in[11];
    F.w_ret_down = args.in[12]; F.conv_w = args.in[13]; F.conv_b = args.in[14]; F.lru_wa = args.in[15]; F.lru_ba = args.in[16]; F.lru_wx = args.in[17];
    F.lru_bx = args.in[18]; F.lru_a = args.in[19]; F.w_lru_down = args.in[20]; F.w_out = args.in[21]; F.final_norm_w = args.in[22];
    F.out = args.out; F.ws = args.ws;
    unsigned char* ws = args.ws;
    F.WinT = (bf16*)(ws + WS_WINT); F.WrdT = (bf16*)(ws + WS_WRDT); F.WldT = (bf16*)(ws + WS_WLDT); F.WoutT = (bf16*)(ws + WS_WOUTT); F.WlruT = (bf16*)(ws + WS_WLRUT);
    F.MOD = (float*)(ws + WS_MOD); F.H = (bf16*)(ws + WS_H); F.Q = (bf16*)(ws + WS_Q); F.K = (bf16*)(ws + WS_K); F.V = (bf16*)(ws + WS_V);
    F.XL = (bf16*)(ws + WS_XL); F.GL = (bf16*)(ws + WS_GL); F.AGG = (float*)(ws + WS_AGG); F.SS = (float*)(ws + WS_SS); F.HL = (bf16*)(ws + WS_HL); F.SP = (bf16*)(ws + WS_SP);
    F.SIGR = (bf16*)(ws + WS_SIGR); F.SIGL = (bf16*)(ws + WS_SIGL); F.MERGED = (bf16*)(ws + WS_MERGED); F.OG = (bf16*)(args.out + OUT_Y);

    volatile LAS unsigned* MISC = (volatile LAS unsigned*)(F.lds + MISC_OFF);
    for (int u = F.tid; u < (LDS_BYTES - 131072) / 4; u += NTHR) ((LAS unsigned*)(F.lds + 131072))[u] = 0u;
    __syncthreads();
    const int lo = args.ph_lo, hi = args.ph_hi;
    XcdBarrier bar; bar.bar = (unsigned*)(ws + WS_CTL) + CW_BAR; bar.x = 0; bar.st = nullptr;
    if (hi - lo > 1) bar = xcd_barrier_post((unsigned*)(ws + WS_CTL) + CW_BAR, MISC + 8);
#define IN(k) (lo <= (k) && (k) < hi)
#define SEAM(k) do { if (IN(k) && IN((k) + 1)) xcd_barrier(bar); } while (0)

    if (IN(PH_PREP)) { phase_prep(F); SEAM(PH_PREP); }
    if (IN(PH_H)) { phase_h(F); SEAM(PH_H); }
    if (IN(PH_GEMM1)) { pg8::Gemm g{F.H, F.WinT, M, N1, D}; pg8::StaticOrder S; S.init(M, N1, F.G, F.wg); pg8::EpiG1 E{F.Q, F.K, F.V, F.XL, F.GL};
        pg8::gemm_phase<pg8::EpiG1, pg8::StaticOrder, true, true>(F.lds, g, S, E); SEAM(PH_GEMM1); }
    if (IN(PH_LRUA)) { phase_lruf(F, false); SEAM(PH_LRUA); }
    if (IN(PH_LRUB)) { phase_lruf(F, true); SEAM(PH_LRUB); }
    if (IN(PH_R12)) { phase_r12f(F); SEAM(PH_R12); }
    if (IN(PH_R3)) { phase_r3f(F); SEAM(PH_R3); }
    if (IN(PH_G2)) { pg8::Gemm g{F.H, F.WinT + (size_t)N1 * D, M, N2, D}; pg8::StaticOrder S; S.init(M, N2, F.G, F.wg); pg8::EpiG2 E{F.OG, F.SIGR, F.SIGL, F.SS, F.gn_w};
        pg8::gemm_phase<pg8::EpiG2, pg8::StaticOrder, true, true>(F.lds, g, S, E); SEAM(PH_G2); }
    if (IN(PH_DOWN)) {
        { pg8::Gemm g{F.OG, F.WrdT, M, D, DRV}; pg8::StaticOrder S; S.init(M, D, F.G, F.wg); pg8::EpiDown<false> E{F.MERGED, F.SIGR}; pg8::gemm_phase<pg8::EpiDown<false>, pg8::StaticOrder, true, true>(F.lds, g, S, E); }
        { pg8::Gemm g{F.HL, F.WldT, M, D, DL}; pg8::StaticOrder S; S.init(M, D, F.G, F.wg); pg8::EpiDown<true> E{F.MERGED, F.SIGL}; pg8::gemm_phase<pg8::EpiDown<true>, pg8::StaticOrder, true, true>(F.lds, g, S, E); }
        SEAM(PH_DOWN);
    }
    if (IN(PH_OUT)) { pg8::Gemm g{F.MERGED, F.WoutT, M, D, D}; pg8::StaticOrder S; S.init(M, D, F.G, F.wg); pg8::EpiY E{F.out + OUT_Y, F.x_prompt, F.x_sample, F.MOD, MCTX, LLAT};
        pg8::gemm_phase<pg8::EpiY, pg8::StaticOrder, true, true>(F.lds, g, S, E); SEAM(PH_OUT); }
    if (IN(PH_NORM)) { phase_norm(F); }
#undef IN
#undef SEAM
}
}

extern "C" void kernel_launch(void* const* d_in, const int* in_sizes, int n_in, void* d_out, int out_size, void* d_ws, size_t ws_size, hipStream_t stream) {
    static int grid = 0;
    if (grid == 0) {
        if (n_in != 23 || (size_t)out_size != OUT_TOTAL || ws_size < WS_END) { fprintf(stderr, "kernel_launch: unexpected shapes n_in %d out %d ws %zu\n", n_in, out_size, ws_size); grid = -1; return; }
        int dev = 0, cus = 0;
        if (hipGetDevice(&dev) != hipSuccess || hipDeviceGetAttribute(&cus, hipDeviceAttributeMultiprocessorCount, dev) != hipSuccess) { grid = -1; return; }
        if (hipFuncSetAttribute((const void*)fwd_kernel, hipFuncAttributeMaxDynamicSharedMemorySize, LDS_BYTES) != hipSuccess) { fprintf(stderr, "kernel_launch: hipFuncSetAttribute failed\n"); grid = -1; return; }
        int per_cu = 0;
        (void)hipOccupancyMaxActiveBlocksPerMultiprocessor(&per_cu, (const void*)fwd_kernel, NTHR, LDS_BYTES);
        (void)hipGetLastError();
        grid = cus;
    }
    if (grid < 0) return;
    (void)hipMemsetAsync((char*)d_ws + WS_CTL, 0, CTL_ZERO_BYTES, stream);
    Args a{};
    for (int i = 0; i < 23; ++i) a.in[i] = (const float*)d_in[i];
    a.out = (float*)d_out; a.ws = (unsigned char*)d_ws;
#if MK_ONE_LAUNCH
    a.ph_lo = 0; a.ph_hi = N_PHASES;
    hipLaunchKernelGGL(fwd_kernel, dim3(grid), dim3(NTHR), LDS_BYTES, stream, a);
#else
    for (int p = 0; p < N_PHASES; ++p) { a.ph_lo = p; a.ph_hi = p + 1; hipLaunchKernelGGL(fwd_kernel, dim3(grid), dim3(NTHR), LDS_BYTES, stream, a); }
#endif
}
```

```cpp
#include <hip/hip_runtime.h>
#include <cstdint>
#include <cstdio>

#ifndef PROBE_REP
#define PROBE_REP 1,1,1,1,1,1,1,1,1,1,1,1
#endif
#ifndef MK_ONE_LAUNCH
#define MK_ONE_LAUNCH 1
#endif

namespace {
constexpr int D = 1024, NCTX = 16, LCTX = 256, NLAT = 4, LLAT = 2048;
constexpr int MCTX = NCTX * LCTX, MLAT = NLAT * LLAT, M = MCTX + MLAT;
constexpr int NH = 4, DK = 256, DV = 512, DQK = NH * DK, DRV = NH * DV;
constexpr int NB = 10, LB = 128, DL = NB * LB;
constexpr int DIN = 10752;
constexpr int N1 = 6656;
constexpr int N2 = 4096;
constexpr int CH = 256;
constexpr int NCH_LAT = LLAT / CH;
constexpr float EPS = 1e-6f;
constexpr int NWAVES = 8, NTHR = 512;

constexpr size_t MiB = 1u << 20;
constexpr size_t WS_CTL = 0, CTL_ZERO_BYTES = 1 * MiB;
constexpr size_t WS_WINT = 1 * MiB;
constexpr size_t WS_WRDT = 22 * MiB;
constexpr size_t WS_WLDT = 26 * MiB;
constexpr size_t WS_WOUTT = 28 * MiB + 512 * 1024;
constexpr size_t WS_WLRUT = 30 * MiB + 512 * 1024;
constexpr size_t WS_MOD = 31 * MiB + 768 * 1024;
constexpr size_t WS_H = 32 * MiB;
constexpr size_t WS_Q = 56 * MiB, WS_K = 80 * MiB, WS_V = 104 * MiB;
constexpr size_t WS_XL = 152 * MiB, WS_GL = 182 * MiB;
constexpr size_t WS_AGG = 216 * MiB;
constexpr size_t WS_SS = 220 * MiB;
constexpr size_t WS_MODP = 224 * MiB;
constexpr size_t WS_HL = 226 * MiB;
constexpr size_t WS_SP = 152 * MiB;
constexpr size_t WS_SIGR = 56 * MiB, WS_SIGL = 80 * MiB;
constexpr size_t WS_MERGED = 104 * MiB;
constexpr size_t WS_END = 256 * MiB;
constexpr size_t OUT_Y = 0;
constexpr size_t OUT_NSR = (size_t)M * D;
constexpr size_t OUT_NSL = OUT_NSR + (size_t)NCTX * 2 * NH * DK * DV;
constexpr size_t OUT_TOTAL = OUT_NSL + (size_t)NCTX * 2 * DL;

constexpr int CW_TMO = 0, CW_CODE = 1, CW_BAR = 4096;
constexpr int LDS_BYTES = 147456;
constexpr int MISC_OFF = 131072 + 320;

#define GAS __attribute__((address_space(1)))
#define LAS __attribute__((address_space(3)))
typedef unsigned short bf16;
typedef unsigned v4u __attribute__((ext_vector_type(4)));
typedef float f32x4 __attribute__((ext_vector_type(4)));
typedef short bf16x8 __attribute__((ext_vector_type(8)));
typedef GAS unsigned gu32;
#define RLX_AGENT __ATOMIC_RELAXED, __HIP_MEMORY_SCOPE_AGENT
#define LDS_WAIT() asm volatile("s_waitcnt lgkmcnt(0)" ::: "memory")
#define VM_WAIT() asm volatile("s_waitcnt vmcnt(0)" ::: "memory")

__device__ __forceinline__ unsigned f2bf(float f) { unsigned u = __builtin_bit_cast(unsigned, f); return (u + 0x7fffu + ((u >> 16) & 1u)) >> 16; }
__device__ __forceinline__ float bf2f(unsigned short b) { return __builtin_bit_cast(float, ((unsigned)b) << 16); }
__device__ __forceinline__ float bfr(float f) { return bf2f((unsigned short)f2bf(f)); }
__device__ __forceinline__ unsigned pk2(float lo, float hi) { return f2bf(lo) | (f2bf(hi) << 16); }
__device__ __forceinline__ float sigmoidf_(float x) { return 1.0f / (1.0f + __expf(-x)); }
__device__ __forceinline__ float siluf_(float x) { return x / (1.0f + __expf(-x)); }

#define XB_TMO      128
#define XB_XCNT(j)  (256  + 64 * (j))
#define XB_XSUB(j)  (1280 + 64 * (j))
#define XB_XGEN(j)  (2304 + 64 * (j))
#define XB_TOP      3328
#define XB_TOPGEN   3392
#define XCD_BAR_WORDS 3456
#define XB_SPIN_CAP (1u << 22)
__device__ __forceinline__ unsigned xb_ld(unsigned* p)              { return __hip_atomic_load(p, __ATOMIC_RELAXED, __HIP_MEMORY_SCOPE_AGENT); }
__device__ __forceinline__ unsigned xb_add(unsigned* p, unsigned v) { return __hip_atomic_fetch_add(p, v, __ATOMIC_RELAXED, __HIP_MEMORY_SCOPE_AGENT); }
__device__ __forceinline__ unsigned xb_xcc_id() { return (unsigned)__builtin_amdgcn_s_getreg((3 << 11) | 20) & 0xFu; }
#define XB_SPIN(cond, bar) do { unsigned _sp = 0; while (cond) { __builtin_amdgcn_s_sleep(1); \
    if ((++_sp & 255u) == 0u) { if (xb_ld(&(bar)[XB_TMO])) break; if (_sp > XB_SPIN_CAP) { atomicAdd(&(bar)[XB_TMO], 1u); break; } } } } while (0)
struct XcdBarrier { unsigned* bar; unsigned x; volatile LAS unsigned* st; };
__device__ __forceinline__ XcdBarrier xcd_barrier_post(unsigned* bar, volatile LAS unsigned* st) {
    XcdBarrier b; b.bar = bar; b.x = xb_xcc_id(); b.st = st;
    if (threadIdx.x == 0) (void)xb_add(&bar[XB_XCNT(b.x)], 1u);
    return b;
}
__device__ __forceinline__ void xcd_barrier_complete(unsigned* bar, unsigned x, unsigned& nloc, unsigned& nx) {
    const unsigned G = gridDim.x * gridDim.y * gridDim.z;
    unsigned sum, cnt, mine, sp = 0u;
    for (;;) {
        sum = 0u; cnt = 0u; mine = 0u;
#pragma unroll
        for (unsigned j = 0; j < 16; ++j) { const unsigned c = xb_ld(&bar[XB_XCNT(j)]); sum += c; cnt += (c > 0u) ? 1u : 0u; mine = (j == x) ? c : mine; }
        if (sum == G) break;
        __builtin_amdgcn_s_sleep(1);
        if ((++sp & 255u) == 0u) { if (xb_ld(&bar[XB_TMO])) break; if (sp > XB_SPIN_CAP) { atomicAdd(&bar[XB_TMO], 1u); break; } }
    }
    nloc = mine > 0u ? mine : 1u; nx = cnt > 0u ? cnt : 1u;
}
__device__ __forceinline__ void xcd_barrier(const XcdBarrier& b) {
    asm volatile("s_waitcnt vmcnt(0)" ::: "memory");
    __syncthreads();
    if (threadIdx.x == 0) {
        unsigned* bar = b.bar;
        __builtin_amdgcn_s_waitcnt(0);
        unsigned nloc = b.st[0], nx = b.st[1];
        if (nloc == 0u) { xcd_barrier_complete(bar, b.x, nloc, nx); b.st[0] = nloc; b.st[1] = nx; }
        const unsigned old = xb_add(&bar[XB_XSUB(b.x)], 1u);
        const unsigned gen = old / nloc;
        if (old + 1u == (gen + 1u) * nloc) {
            __builtin_amdgcn_fence(__ATOMIC_RELEASE, "agent");
            asm volatile("s_waitcnt vmcnt(0)" ::: "memory");
            const unsigned og = xb_add(&bar[XB_TOP], 1u);
            const unsigned tg = og / nx;
            if (og + 1u == (tg + 1u) * nx) xb_add(&bar[XB_TOPGEN], 1u);
            else XB_SPIN(xb_ld(&bar[XB_TOPGEN]) == tg, bar);
            __builtin_amdgcn_fence(__ATOMIC_ACQUIRE, "agent");
            xb_add(&bar[XB_XGEN(b.x)], 1u);
            asm volatile("s_waitcnt vmcnt(0)" ::: "memory");
        } else {
            XB_SPIN(xb_ld(&bar[XB_XGEN(b.x)]) == gen, bar);
            __builtin_amdgcn_fence(__ATOMIC_ACQUIRE, "agent");
            asm volatile("s_waitcnt vmcnt(0)" ::: "memory");
        }
    }
    __syncthreads();
}

namespace pg8 {
#define PG8_LAS __attribute__((address_space(3)))
typedef unsigned short bf16_t;
typedef short bf16x8 __attribute__((ext_vector_type(8)));
typedef float f32x4 __attribute__((ext_vector_type(4)));
typedef unsigned u32x4 __attribute__((ext_vector_type(4)));
constexpr int BM = 256, BK = 64, HALF = 128, HTB = HALF * BK * 2  , STAGE_BYTES = 8 * HTB, NXCD = 8, WGM = 8;

__host__ __device__ __forceinline__ int lds_byte(int r, int c) { const int st = (r >> 4) * 2 + (c >> 5), rr = r & 15, cc = c & 31, ob = rr * 64 + cc * 2; return st * 1024 + (ob ^ (((ob >> 9) & 1) << 5)); }
__host__ __device__ __forceinline__ void stage_rc(int b, int& R, int& C) { const int st = b / 1024, sb = b % 1024, swz = sb ^ (((sb >> 9) & 1) << 5); R = (st >> 1) * 16 + swz / 64; C = (st & 1) * 32 + (swz % 64) / 2; }
__host__ __device__ __forceinline__ int perm32(int rho) { const int n = rho >> 4, i = rho & 15; return 8 * (i >> 2) + 4 * n + (i & 3); }

struct Unit { int pm, pn; };
struct Gemm { const bf16_t* A; const bf16_t* Bt; int M, N, K; };

struct StaticOrder {
    int nM, nN, nwg, G, c;
    __host__ __device__ void init(int M, int N, int G_, int c_) { nM = M / BM; nN = N / BM; nwg = nM * nN; G = G_; c = c_; }
    __host__ __device__ bool next(int i, Unit& u) const {
        const long L = (long)i * G + c; if (L >= nwg) return false;
        int wgid = (int)L; { const int q = nwg / NXCD, r = nwg % NXCD, xcd = wgid % NXCD, off = wgid / NXCD; wgid = (xcd < r ? xcd * (q + 1) : r * (q + 1) + (xcd - r) * q) + off; }
        const int nig = WGM * nN, gid = wgid / nig, fm = gid * WGM, gsz = (nM - fm) < WGM ? (nM - fm) : WGM;
        u.pm = fm + ((wgid % nig) % gsz); u.pn = (wgid % nig) / gsz; return true;
    }
    __device__ __forceinline__ void a_ready(const Unit&) const {}
    __device__ __forceinline__ void done(const Unit&) const {}
};

__device__ __forceinline__ unsigned cvt_pk_bf16(float lo, float hi) { unsigned r; asm volatile("v_cvt_pk_bf16_f32 %0, %1, %2" : "=v"(r) : "v"(lo), "v"(hi)); return r; }

typedef float f32x2 __attribute__((ext_vector_type(2)));
__device__ __forceinline__ float pg_silu(float x) { return x * __builtin_amdgcn_rcpf(1.0f + __expf(-x)); }
__device__ __forceinline__ float pg_sigm(float x) { return __builtin_amdgcn_rcpf(1.0f + __expf(-x)); }
__device__ __forceinline__ float pg_lo(unsigned w) { return __builtin_bit_cast(float, w << 16); }
__device__ __forceinline__ float pg_hi(unsigned w) { return __builtin_bit_cast(float, w & 0xffff0000u); }
struct EpiG1 {
    static constexpr bool PERM = true, AFTER_DRAIN = false;
    bf16_t *Q, *K, *V, *XL, *GL;
    __device__ __forceinline__ void operator()(const f32x4 (&acc)[2][2][4][2], const Unit& u, int wr, int wc, int fr, int fq) const {
        const int row0 = u.pm * BM + wr * 64 + fr; int colt = u.pn * BM; bf16_t* base; int ldc; float sc = 1.f; bool act = false;
        if (colt < 1024) { base = Q; ldc = 1024; } else if (colt < 2048) { base = K; ldc = 1024; colt -= 1024; sc = 0.0625f; }
        else if (colt < 4096) { base = V; ldc = 2048; colt -= 2048; } else if (colt < 5376) { base = XL; ldc = 1280; colt -= 4096; } else { base = GL; ldc = 1280; colt -= 5376; act = true; }
        const int col0 = colt + wc * 32 + 8 * fq;
#pragma unroll
        for (int ai = 0; ai < 2; ++ai)
#pragma unroll
            for (int m = 0; m < 4; ++m) { bf16_t* rowp = base + (size_t)(row0 + ai * HALF + m * 16) * ldc + col0;
#pragma unroll
                for (int bj = 0; bj < 2; ++bj) { f32x4 v0 = acc[ai][bj][m][0], v1 = acc[ai][bj][m][1];
                    if (act) {
#pragma unroll
                        for (int j = 0; j < 4; ++j) { v0[j] = pg_silu(v0[j]); v1[j] = pg_silu(v1[j]); } }
                    v0 = v0 * sc; v1 = v1 * sc; u32x4 w; w.x = cvt_pk_bf16(v0[0], v0[1]); w.y = cvt_pk_bf16(v0[2], v0[3]); w.z = cvt_pk_bf16(v1[0], v1[1]); w.w = cvt_pk_bf16(v1[2], v1[3]);
                    *(u32x4*)(rowp + bj * HALF) = w; } }
    }
};
struct EpiG2 {
    static constexpr bool PERM = true, AFTER_DRAIN = false;
    bf16_t *OG, *SIGR, *SIGL; const float *SS, *gnw;
    __device__ __forceinline__ void operator()(const f32x4 (&acc)[2][2][4][2], const Unit& u, int wr, int wc, int fr, int fq) const {
        const int row0 = u.pm * BM + wr * 64 + fr; int colt = u.pn * BM; bf16_t* base; int ldc; bool mul = false;
        if (colt < 2048) { base = OG; ldc = 2048; mul = true; } else if (colt < 3072) { base = SIGR; ldc = 1024; colt -= 2048; } else { base = SIGL; ldc = 1024; colt -= 3072; }
        const int col0 = colt + wc * 32 + 8 * fq, head = colt >> 9;
        f32x4 gw[2][2];
#pragma unroll
        for (int bj = 0; bj < 2; ++bj)
#pragma unroll
            for (int n = 0; n < 2; ++n) gw[bj][n] = mul ? *(const f32x4*)(gnw + col0 + bj * HALF + 4 * n) : (f32x4){1.f, 1.f, 1.f, 1.f};
#pragma unroll
        for (int ai = 0; ai < 2; ++ai)
#pragma unroll
            for (int m = 0; m < 4; ++m) { const int r = row0 + ai * HALF + m * 16; bf16_t* rowp = base + (size_t)r * ldc + col0;
                float rs = 1.f;
                if (mul) { const f32x4 sq = *(const f32x4*)(SS + ((size_t)r * 4 + head) * 4); rs = 1.0f / sqrtf(((sq[0] + sq[1]) + (sq[2] + sq[3])) * (1.0f / 512.0f) + 1e-6f); }
#pragma unroll
                for (int bj = 0; bj < 2; ++bj) { f32x4 v0 = acc[ai][bj][m][0], v1 = acc[ai][bj][m][1];
                    if (mul) { const u32x4 o = *(const u32x4*)(rowp + bj * HALF); const f32x4 g0 = gw[bj][0] * rs, g1 = gw[bj][1] * rs;
                        v0[0] = pg_silu(v0[0]) * pg_lo(o.x) * g0[0]; v0[1] = pg_silu(v0[1]) * pg_hi(o.x) * g0[1]; v0[2] = pg_silu(v0[2]) * pg_lo(o.y) * g0[2]; v0[3] = pg_silu(v0[3]) * pg_hi(o.y) * g0[3];
                        v1[0] = pg_silu(v1[0]) * pg_lo(o.z) * g1[0]; v1[1] = pg_silu(v1[1]) * pg_hi(o.z) * g1[1]; v1[2] = pg_silu(v1[2]) * pg_lo(o.w) * g1[2]; v1[3] = pg_silu(v1[3]) * pg_hi(o.w) * g1[3];
                    } else {
#pragma unroll
                        for (int j = 0; j < 4; ++j) { v0[j] = pg_sigm(v0[j]); v1[j] = pg_sigm(v1[j]); } }
                    u32x4 w; w.x = cvt_pk_bf16(v0[0], v0[1]); w.y = cvt_pk_bf16(v0[2], v0[3]); w.z = cvt_pk_bf16(v1[0], v1[1]); w.w = cvt_pk_bf16(v1[2], v1[3]);
                    *(u32x4*)(rowp + bj * HALF) = w; } }
    }
};
template <bool ADD> struct EpiDown {
    static constexpr bool PERM = true, AFTER_DRAIN = false;
    bf16_t* MERGED; const bf16_t* SIG;
    __device__ __forceinline__ void operator()(const f32x4 (&acc)[2][2][4][2], const Unit& u, int wr, int wc, int fr, int fq) const {
        const int row0 = u.pm * BM + wr * 64 + fr, col0 = u.pn * BM + wc * 32 + 8 * fq;
#pragma unroll
        for (int ai = 0; ai < 2; ++ai)
#pragma unroll
            for (int m = 0; m < 4; ++m) { const size_t off = (size_t)(row0 + ai * HALF + m * 16) * 1024 + col0;
#pragma unroll
                for (int bj = 0; bj < 2; ++bj) { f32x4 v0 = acc[ai][bj][m][0], v1 = acc[ai][bj][m][1];
                    const u32x4 g = *(const u32x4*)(SIG + off + bj * HALF);
                    v0[0] *= pg_lo(g.x); v0[1] *= pg_hi(g.x); v0[2] *= pg_lo(g.y); v0[3] *= pg_hi(g.y); v1[0] *= pg_lo(g.z); v1[1] *= pg_hi(g.z); v1[2] *= pg_lo(g.w); v1[3] *= pg_hi(g.w);
                    if (ADD) { const u32x4 o = *(const u32x4*)(MERGED + off + bj * HALF);
                        v0[0] += pg_lo(o.x); v0[1] += pg_hi(o.x); v0[2] += pg_lo(o.y); v0[3] += pg_hi(o.y); v1[0] += pg_lo(o.z); v1[1] += pg_hi(o.z); v1[2] += pg_lo(o.w); v1[3] += pg_hi(o.w); }
                    u32x4 w; w.x = cvt_pk_bf16(v0[0], v0[1]); w.y = cvt_pk_bf16(v0[2], v0[3]); w.z = cvt_pk_bf16(v1[0], v1[1]); w.w = cvt_pk_bf16(v1[2], v1[3]);
                    *(u32x4*)(MERGED + off + bj * HALF) = w; } }
    }
};
struct EpiY {
    static constexpr bool PERM = false, AFTER_DRAIN = false;
    float* Y; const float *xp, *xs, *MOD; int mctx, llat;
    __device__ __forceinline__ void operator()(const f32x4 (&acc)[2][2][4][2], const Unit& u, int wr, int wc, int fr, int fq) const {
        const int row0 = u.pm * BM + wr * 64 + fr, col0 = u.pn * BM + wc * 32 + 4 * fq;
        const int rbase = u.pm * BM;
        const float* gate = MOD + (rbase < mctx ? 0 : 1 + (rbase - mctx) / llat) * 3072 + 2048;
        f32x4 gv[2][2];
#pragma unroll
        for (int bj = 0; bj < 2; ++bj)
#pragma unroll
            for (int n = 0; n < 2; ++n) gv[bj][n] = *(const f32x4*)(gate + col0 + bj * HALF + n * 16);
#pragma unroll
        for (int ai = 0; ai < 2; ++ai)
#pragma unroll
            for (int m = 0; m < 4; ++m) { const int r = row0 + ai * HALF + m * 16; const float* xr = (r < mctx ? xp + (size_t)r * 1024 : xs + (size_t)(r - mctx) * 1024) + col0; float* yr = Y + (size_t)r * 1024 + col0;
#pragma unroll
                for (int bj = 0; bj < 2; ++bj)
#pragma unroll
                    for (int n = 0; n < 2; ++n) { const f32x4 xv = *(const f32x4*)(xr + bj * HALF + n * 16); *(f32x4*)(yr + bj * HALF + n * 16) = xv + gv[bj][n] * acc[ai][bj][m][n]; } }
    }
};

template <class Epi, class Sched, bool ALIGN_EPI = false, bool SP2 = false>
__device__ __forceinline__ void gemm_phase(PG8_LAS unsigned char* lds, const Gemm g, const Sched& S, const Epi& E) {
    const int tid = threadIdx.x, wid = __builtin_amdgcn_readfirstlane(tid >> 6), lane = tid & 63, wr = wid >> 2, wc = wid & 3, fr = lane & 15, fq = lane >> 4;
    const int K = g.K, nt = K / BK;
    unsigned voffA[2], voffB[2];
#pragma unroll
    for (int i = 0; i < 2; ++i) { int R, C; stage_rc(tid * 16 + i * 8192, R, C); const int Rb = Epi::PERM ? ((R & ~31) + perm32(R & 31)) : R;
        voffA[i] = (unsigned)(R * K + C) * 2u; voffB[i] = (unsigned)(Rb * K + C) * 2u; }
    const size_t kstep = (size_t)(BK * 2);
    const size_t hstep = (size_t)HALF * K * 2;
    const size_t tstep = 2 * hstep;
    const unsigned ldsw = (unsigned)wid * 1024u;
    const int aoff = lds_byte(wr * 64 + fr, fq * 8), boff = lds_byte(wc * 32 + fr, fq * 8);
#define PG8_SA(b, h) (((b) * 2 + (h)) * HTB)
#define PG8_SB(b, h) ((4 + (b) * 2 + (h)) * HTB)
#define PG8_STAGE(bufoff, gbase, voff) do { _Pragma("unroll") for (int _i = 0; _i < 2; ++_i) \
        __builtin_amdgcn_global_load_lds((const unsigned*)((const char*)(gbase) + (voff)[_i]), (PG8_LAS unsigned*)(lds + (bufoff) + ldsw + _i * 8192), 16, 0, 0); } while (0)
#define PG8_LDA(dst, b, h) do { _Pragma("unroll") for (int m = 0; m < 4; ++m) _Pragma("unroll") for (int k = 0; k < 2; ++k) dst[m][k] = *(const PG8_LAS bf16x8*)(lds + PG8_SA(b, h) + aoff + m * 2048 + k * 1024); } while (0)
#define PG8_LDB(dst, b, h) do { _Pragma("unroll") for (int n = 0; n < 2; ++n) _Pragma("unroll") for (int k = 0; k < 2; ++k) dst[n][k] = *(const PG8_LAS bf16x8*)(lds + PG8_SB(b, h) + boff + n * 2048 + k * 1024); } while (0)
#define PG8_MMA(ai, bj, At, Bt) do { __builtin_amdgcn_s_setprio(1); _Pragma("unroll") for (int m = 0; m < 4; ++m) _Pragma("unroll") for (int n = 0; n < 2; ++n) _Pragma("unroll") for (int k = 0; k < 2; ++k) \
        acc[ai][bj][m][n] = __builtin_amdgcn_mfma_f32_16x16x32_bf16(Bt[n][k], At[m][k], acc[ai][bj][m][n], 0, 0, 0); __builtin_amdgcn_s_setprio(0); } while (0)
#define PG8_WAIT_V(n) asm volatile("s_waitcnt vmcnt(" #n ")" ::: "memory")
#define PG8_WAIT_L(n) asm volatile("s_waitcnt lgkmcnt(" #n ")" ::: "memory")
#define PG8_BAR __builtin_amdgcn_s_barrier()
#define PG8_SCHED __builtin_amdgcn_sched_barrier(0)
    Unit cur, nxt; int ui = 0;
    if (!S.next(0, cur)) return;
    f32x4 acc[2][2][4][2];
#pragma unroll
    for (int a = 0; a < 2; ++a)
#pragma unroll
        for (int b = 0; b < 2; ++b)
#pragma unroll
            for (int m = 0; m < 4; ++m)
#pragma unroll
                for (int n = 0; n < 2; ++n) acc[a][b][m][n] = (f32x4){0.f, 0.f, 0.f, 0.f};
    bf16x8 At[4][2], B0[2][2], B1[2][2];
    const char* cA = (const char*)g.A + (size_t)cur.pm * tstep; const char* cB = (const char*)g.Bt + (size_t)cur.pn * tstep;
    S.a_ready(cur);
    if constexpr (SP2) {
        PG8_STAGE(PG8_SB(0, 0), cB, voffB); PG8_STAGE(PG8_SB(0, 1), cB + hstep, voffB); PG8_STAGE(PG8_SA(0, 0), cA, voffA); PG8_STAGE(PG8_SA(0, 1), cA + hstep, voffA);
        if (wr == 1) PG8_BAR;
        PG8_WAIT_V(2); PG8_BAR;
        PG8_STAGE(PG8_SB(1, 0), cB + kstep, voffB); PG8_STAGE(PG8_SA(1, 0), cA + kstep, voffA); PG8_STAGE(PG8_SB(1, 1), cB + hstep + kstep, voffB);
        PG8_WAIT_V(6); PG8_BAR;
    } else {
        PG8_STAGE(PG8_SB(0, 0), cB, voffB); PG8_STAGE(PG8_SA(0, 0), cA, voffA); PG8_STAGE(PG8_SB(0, 1), cB + hstep, voffB); PG8_STAGE(PG8_SA(0, 1), cA + hstep, voffA);
        if (wr == 1) PG8_BAR;
        PG8_WAIT_V(4); PG8_BAR;
        PG8_STAGE(PG8_SB(1, 0), cB + kstep, voffB); PG8_STAGE(PG8_SA(1, 0), cA + kstep, voffA); PG8_STAGE(PG8_SB(1, 1), cB + hstep + kstep, voffB);
        PG8_WAIT_V(6); PG8_BAR;
    }
    for (;;) {
        const bool has_next = S.next(ui + 1, nxt);
        const char* nA = has_next ? (const char*)g.A + (size_t)nxt.pm * tstep : cA; const char* nB = has_next ? (const char*)g.Bt + (size_t)nxt.pn * tstep : cB;
        for (int t = 0; t < nt; t += 2) {
            const bool last = (t == nt - 2);
            const char* a1 = cA + (size_t)(t + 1) * kstep;
            const char* a2 = last ? nA : cA + (size_t)(t + 2) * kstep; const char* b2 = last ? nB : cB + (size_t)(t + 2) * kstep;
            const char* a3 = a2 + kstep; const char* b3 = b2 + kstep;
            if (last && has_next) S.a_ready(nxt);
            if constexpr (SP2) {
            PG8_LDB(B0, 0, 0); PG8_LDB(B1, 0, 1); PG8_SCHED; PG8_LDA(At, 0, 0); PG8_STAGE(PG8_SA(1, 1), a1 + hstep, voffA);
            PG8_WAIT_V(8); PG8_WAIT_L(0); PG8_BAR; PG8_MMA(0, 0, At, B0); PG8_MMA(0, 1, At, B1); PG8_BAR; PG8_SCHED;
            PG8_LDA(At, 0, 1); PG8_STAGE(PG8_SB(0, 0), b2, voffB); PG8_STAGE(PG8_SB(0, 1), b2 + hstep, voffB); PG8_STAGE(PG8_SA(0, 0), a2, voffA);
            PG8_WAIT_V(8); PG8_WAIT_L(0); PG8_BAR; PG8_MMA(1, 0, At, B0); PG8_MMA(1, 1, At, B1); PG8_BAR; PG8_SCHED;
            PG8_LDB(B0, 1, 0); PG8_LDB(B1, 1, 1); PG8_SCHED; PG8_LDA(At, 1, 0); PG8_STAGE(PG8_SA(0, 1), a2 + hstep, voffA);
            PG8_WAIT_V(8); PG8_WAIT_L(0); PG8_BAR; PG8_MMA(0, 0, At, B0); PG8_MMA(0, 1, At, B1); PG8_BAR; PG8_SCHED;
            PG8_LDA(At, 1, 1); PG8_STAGE(PG8_SB(1, 0), b3, voffB); PG8_STAGE(PG8_SB(1, 1), b3 + hstep, voffB); PG8_STAGE(PG8_SA(1, 0), a3, voffA);
            PG8_WAIT_V(8); PG8_WAIT_L(0); PG8_BAR; PG8_MMA(1, 0, At, B0); PG8_MMA(1, 1, At, B1); PG8_BAR; PG8_SCHED;
            } else {
            PG8_LDB(B0, 0, 0); PG8_SCHED; PG8_LDA(At, 0, 0); PG8_STAGE(PG8_SA(1, 1), a1 + hstep, voffA);
            PG8_WAIT_L(8); PG8_BAR; PG8_WAIT_L(0); PG8_MMA(0, 0, At, B0); PG8_BAR; PG8_SCHED;
            PG8_LDB(B1, 0, 1); PG8_STAGE(PG8_SB(0, 0), b2, voffB);
            PG8_BAR; PG8_WAIT_L(0); PG8_MMA(0, 1, At, B1); PG8_BAR;
            PG8_LDA(At, 0, 1); PG8_STAGE(PG8_SA(0, 0), a2, voffA);
            PG8_BAR; PG8_WAIT_L(0); PG8_MMA(1, 0, At, B0); PG8_BAR; PG8_SCHED;
            PG8_STAGE(PG8_SB(0, 1), b2 + hstep, voffB);
            PG8_WAIT_V(6); PG8_BAR; PG8_MMA(1, 1, At, B1); PG8_BAR;
            PG8_LDB(B0, 1, 0); PG8_SCHED; PG8_LDA(At, 1, 0); PG8_STAGE(PG8_SA(0, 1), a2 + hstep, voffA);
            PG8_WAIT_L(8); PG8_BAR; PG8_WAIT_L(0); PG8_MMA(0, 0, At, B0); PG8_BAR; PG8_SCHED;
            PG8_LDB(B1, 1, 1); PG8_STAGE(PG8_SB(1, 0), b3, voffB);
            PG8_BAR; PG8_WAIT_L(0); PG8_MMA(0, 1, At, B1); PG8_BAR;
            PG8_LDA(At, 1, 1); PG8_STAGE(PG8_SA(1, 0), a3, voffA);
            PG8_BAR; PG8_WAIT_L(0); PG8_MMA(1, 0, At, B0); PG8_BAR; PG8_SCHED;
            PG8_STAGE(PG8_SB(1, 1), b3 + hstep, voffB);
            PG8_WAIT_V(6); PG8_BAR; PG8_MMA(1, 1, At, B1); PG8_BAR;
            }
        }
        if constexpr (ALIGN_EPI) { if (wr == 0) PG8_BAR; }
        if constexpr (!Epi::AFTER_DRAIN) { E(acc, cur, wr, wc, fr, fq); S.done(cur); }
        if (!has_next) break;
#pragma unroll
        for (int a = 0; a < 2; ++a)
#pragma unroll
            for (int b = 0; b < 2; ++b)
#pragma unroll
                for (int m = 0; m < 4; ++m)
#pragma unroll
                    for (int n = 0; n < 2; ++n) acc[a][b][m][n] = (f32x4){0.f, 0.f, 0.f, 0.f};
        cur = nxt; cA = nA; cB = nB; ++ui;
        if constexpr (ALIGN_EPI) { if (wr == 1) PG8_BAR; }
    }
    PG8_WAIT_V(0);
    if constexpr (!ALIGN_EPI) { if (wr == 0) PG8_BAR; }
    PG8_BAR;
    if constexpr (Epi::AFTER_DRAIN) { E.fused(acc, cur, wr, wc, fr, fq, lds, wid, lane); S.done(cur); }
#undef PG8_SA
#undef PG8_SB
#undef PG8_STAGE
#undef PG8_LDA
#undef PG8_LDB
#undef PG8_MMA
#undef PG8_WAIT_V
#undef PG8_WAIT_L
#undef PG8_BAR
#undef PG8_SCHED
}
}

struct Args {
    const float* in[23]; float* out; unsigned char* ws; int ph_lo, ph_hi; int rep[12];
};
struct Frame {
    LAS unsigned char* lds;
    int tid, lane, wave, G, wg;
    const float *x_prompt, *x_sample, *state_ret, *state_lru, *c, *c_ctx, *norm_w, *w_ada, *b_ada, *w_in, *decay_logit, *gn_w, *w_ret_down,
                *conv_w, *conv_b, *lru_wa, *lru_ba, *lru_wx, *lru_bx, *lru_a, *w_lru_down, *w_out, *final_norm_w;
    float* out; unsigned char* ws;
    bf16 *WinT, *WrdT, *WldT, *WoutT, *WlruT, *H, *Q, *K, *V, *XL, *GL, *HL, *SP, *SIGR, *SIGL, *MERGED, *OG;
    float *MOD, *MODP, *AGG, *SS;
};

__device__ __forceinline__ float wave_sum(float v) {
#pragma unroll
    for (int o = 1; o < 64; o <<= 1) v += __shfl_xor(v, o);
    return v;
}
__device__ __forceinline__ const float* xrow_ptr(const Frame& F, int row) {
    return row < MCTX ? F.x_prompt + (size_t)row * D : F.x_sample + (size_t)(row - MCTX) * D;
}
__device__ __forceinline__ int mod_index(int row) { return row < MCTX ? 0 : 1 + (row - MCTX) / LLAT; }

__device__ __forceinline__ void p0_transpose_item(const float* W, int K, int N, bf16* WT, int drow0, int k0, int n0, LAS float* scr, int lane) {
#pragma unroll 8
    for (int i = 0; i < 32; ++i) { const int kk = 2 * i + (lane >> 5); scr[kk * 33 + (lane & 31)] = W[(size_t)(k0 + kk) * N + n0 + (lane & 31)]; }
    LDS_WAIT(); asm volatile("" ::: "memory");
    const int c = lane & 7;
#pragma unroll
    for (int j = 0; j < 4; ++j) { const int n = (lane >> 3) + 8 * j; const LAS float* s = scr + (8 * c) * 33 + n;
        v4u o; o.x = pk2(s[0 * 33], s[1 * 33]); o.y = pk2(s[2 * 33], s[3 * 33]); o.z = pk2(s[4 * 33], s[5 * 33]); o.w = pk2(s[6 * 33], s[7 * 33]);
        *(v4u*)(WT + (size_t)(drow0 + n) * K + k0 + 8 * c) = o; }
    LDS_WAIT(); asm volatile("" ::: "memory");
}
__device__ __forceinline__ int win_dst_row(int n) { return n < 4096 ? n : (n < 6144 ? n + 2560 : (n < 8704 ? n - 2048 : n)); }

constexpr int MOD_KQ = 4;
__device__ __forceinline__ void phase_prep(Frame& F) {
    LAS float* scr = (LAS float*)(F.lds + F.wave * 8448);
    LAS float* tab = (LAS float*)(F.lds + 8 * 8448);
    for (int i = F.tid; i < 5 * D; i += NTHR) { const float cv = i < D ? F.c_ctx[i] : F.c[i - D]; tab[i] = siluf_(cv); }
    __syncthreads();
    const int gw = F.wg * NWAVES + F.wave, NGW = F.G * NWAVES;
    constexpr int I_IN = (D / 64) * (DIN / 32), I_RD = (DRV / 64) * (D / 32), I_LD = (DL / 64) * (D / 32), I_OUT = (D / 64) * (D / 32), I_LRU = 40 * 8, I_MOD = MOD_KQ * (3072 / 64);
    constexpr int NITEMS = I_MOD + I_IN + I_RD + I_LD + I_OUT + I_LRU;
    for (int it = gw; it < NITEMS; it += NGW) {
        int r = it;
        if (r < I_MOD) {
            const int kq = r / 48, n = (r % 48) * 64 + F.lane;
            float acc[5] = {0.f, 0.f, 0.f, 0.f, 0.f};
            const float* wp = F.w_ada + (size_t)(kq * (D / MOD_KQ)) * 3072 + n; const LAS float* tp = tab + kq * (D / MOD_KQ);
#pragma unroll 16
            for (int k = 0; k < D / MOD_KQ; ++k) {
                const float w = wp[(size_t)k * 3072];
#pragma unroll
                for (int v = 0; v < 5; ++v) acc[v] += tp[v * D + k] * w;
            }
#pragma unroll
            for (int v = 0; v < 5; ++v) F.MODP[(kq * 5 + v) * 3072 + n] = acc[v];
            continue;
        }
        r -= I_MOD;
        if (r < I_IN) { const int nblk = DIN / 32, kb = r / nblk, nb = r % nblk; p0_transpose_item(F.w_in, D, DIN, F.WinT, win_dst_row(nb * 32), kb * 64, nb * 32, scr, F.lane); continue; }
        r -= I_IN;
        if (r < I_RD) { const int nblk = D / 32, kb = r / nblk, nb = r % nblk; p0_transpose_item(F.w_ret_down, DRV, D, F.WrdT, nb * 32, kb * 64, nb * 32, scr, F.lane); continue; }
        r -= I_RD;
        if (r < I_LD) { const int nblk = D / 32, kb = r / nblk, nb = r % nblk; p0_transpose_item(F.w_lru_down, DL, D, F.WldT, nb * 32, kb * 64, nb * 32, scr, F.lane); continue; }
        r -= I_LD;
        if (r < I_OUT) { const int nblk = D / 32, kb = r / nblk, nb = r % nblk; p0_transpose_item(F.w_out, D, D, F.WoutT, nb * 32, kb * 64, nb * 32, scr, F.lane); continue; }
        r -= I_OUT;
        {
            const int mi = r / 8, sub = r % 8, slot = mi / NB, hb = mi % NB, kb = sub / 4, nb = sub % 4;
            const float* W = ((slot & 1) ? F.lru_wx : F.lru_wa) + (size_t)((slot >> 1) * NB + hb) * LB * LB;
            p0_transpose_item(W, LB, LB, F.WlruT + (size_t)hb * 512 * LB, slot * 128 + nb * 32, kb * 64, nb * 32, scr, F.lane);
        }
    }
}

__device__ __forceinline__ void phase_h(Frame& F) {
    LAS float* tab = (LAS float*)F.lds;
    for (int i = F.tid; i < 5 * 2048; i += NTHR) { const int v = i >> 11, n = i & 2047; float a = F.b_ada[n];
#pragma unroll
        for (int kq = 0; kq < MOD_KQ; ++kq) a += F.MODP[(kq * 5 + v) * 3072 + n];
        tab[i] = a; }
    if (F.wg == 0) for (int i = F.tid; i < 5 * 1024; i += NTHR) { const int v = i >> 10, n = 2048 + (i & 1023); float a = F.b_ada[n];
#pragma unroll
        for (int kq = 0; kq < MOD_KQ; ++kq) a += F.MODP[(kq * 5 + v) * 3072 + n];
        F.MOD[v * 3072 + n] = a; }
    __syncthreads();
    const int gw = F.wg * NWAVES + F.wave, NGW = F.G * NWAVES;
    for (int m = gw; m < M; m += NGW) {
        const f32x4* xr = (const f32x4*)xrow_ptr(F, m) + F.lane;
        const LAS float* mod = tab + mod_index(m) * 2048;
        f32x4 v[4]; float s = 0.f;
#pragma unroll
        for (int j = 0; j < 4; ++j) { v[j] = xr[64 * j]; s += (v[j].x * v[j].x + v[j].y * v[j].y) + (v[j].z * v[j].z + v[j].w * v[j].w); }
        const float rstd = 1.0f / sqrtf(wave_sum(s) * (1.f / D) + EPS);
        unsigned long long* o8 = (unsigned long long*)(F.H + (size_t)m * D) + F.lane;
#pragma unroll
        for (int j = 0; j < 4; ++j) {
            const int c0 = 4 * F.lane + 256 * j;
            const f32x4 nw = *(const f32x4*)(F.norm_w + c0), sh = *(const LAS f32x4*)(mod + c0), sc = *(const LAS f32x4*)(mod + 1024 + c0);
            const f32x4 h = v[j] * rstd * nw * (sc + 1.0f) + sh;
            o8[64 * j] = (unsigned long long)pk2(h.x, h.y) | ((unsigned long long)pk2(h.z, h.w) << 32);
        }
    }
    __syncthreads();
}

template <class Epi>
__device__ __forceinline__ void gemm_simple(const Frame& F, const bf16* A, int lda, const bf16* Bt, int ldb, int Mr, int Nc, int K, const Epi& epi) {
    const int wr = F.wave >> 2, wc = F.wave & 3, fr = F.lane & 15, fq = F.lane >> 4;
    const int tilesN = Nc / 256, tiles = (Mr / 128) * tilesN;
    for (int t = F.wg; t < tiles; t += F.G) {
        const int tm = t / tilesN, tn = t % tilesN;
        const int row0 = tm * 128 + wr * 64, col0 = tn * 256 + wc * 64;
        f32x4 acc[4][4];
#pragma unroll
        for (int i = 0; i < 4; ++i)
#pragma unroll
            for (int j = 0; j < 4; ++j) acc[i][j] = (f32x4){0.f, 0.f, 0.f, 0.f};
        const bf16* ap = A + (size_t)(row0 + fr) * lda + 8 * fq;
        const bf16* bp = Bt + (size_t)(col0 + fr) * ldb + 8 * fq;
        for (int k0 = 0; k0 < K; k0 += 32) {
            bf16x8 a[4], b[4];
#pragma unroll
            for (int i = 0; i < 4; ++i) a[i] = *(const bf16x8*)(ap + (size_t)(16 * i) * lda + k0);
#pragma unroll
            for (int j = 0; j < 4; ++j) b[j] = *(const bf16x8*)(bp + (size_t)(16 * j) * ldb + k0);
#pragma unroll
            for (int i = 0; i < 4; ++i)
#pragma unroll
                for (int j = 0; j < 4; ++j) acc[i][j] = __builtin_amdgcn_mfma_f32_16x16x32_bf16(a[i], b[j], acc[i][j], 0, 0, 0);
        }
#pragma unroll
        for (int i = 0; i < 4; ++i)
#pragma unroll
            for (int j = 0; j < 4; ++j)
#pragma unroll
                for (int r = 0; r < 4; ++r) epi(row0 + 16 * i + 4 * fq + r, col0 + 16 * j + fr, acc[i][j][r]);
    }
}

struct EpiGemm1 {
    bf16 *Q, *K, *V, *XL, *GL;
    __device__ __forceinline__ void operator()(int row, int col, float v) const {
        if (col < 1024) Q[(size_t)row * 1024 + col] = (bf16)f2bf(v);
        else if (col < 2048) K[(size_t)row * 1024 + col - 1024] = (bf16)f2bf(v * 0.0625f);
        else if (col < 4096) V[(size_t)row * 2048 + col - 2048] = (bf16)f2bf(v);
        else if (col < 5376) XL[(size_t)row * 1280 + col - 4096] = (bf16)f2bf(v);
        else GL[(size_t)row * 1280 + col - 5376] = (bf16)f2bf(siluf_(v));
    }
};
struct EpiGemm2 {
    bf16 *OG, *SIGR, *SIGL;
    __device__ __forceinline__ void operator()(int row, int col, float v) const {
        if (col < 2048) { bf16* p = OG + (size_t)row * 2048 + col; *p = (bf16)f2bf(bf2f(*p) * siluf_(v)); }
        else if (col < 3072) SIGR[(size_t)row * 1024 + col - 2048] = (bf16)f2bf(sigmoidf_(v));
        else SIGL[(size_t)row * 1024 + col - 3072] = (bf16)f2bf(sigmoidf_(v));
    }
};
struct EpiDownR { bf16 *MERGED; const bf16* SIG;
    __device__ __forceinline__ void operator()(int row, int col, float v) const { const size_t o = (size_t)row * 1024 + col; MERGED[o] = (bf16)f2bf(bf2f(SIG[o]) * v); } };
struct EpiDownL { bf16 *MERGED; const bf16* SIG;
    __device__ __forceinline__ void operator()(int row, int col, float v) const { const size_t o = (size_t)row * 1024 + col; MERGED[o] = (bf16)f2bf(bf2f(MERGED[o]) + bf2f(SIG[o]) * v); } };
struct EpiOut { float* Y; const float *xp, *xs, *MOD;
    __device__ __forceinline__ void operator()(int row, int col, float v) const {
        const float xv = row < MCTX ? xp[(size_t)row * D + col] : xs[(size_t)(row - MCTX) * D + col];
        Y[(size_t)row * D + col] = xv + MOD[mod_index(row) * 3072 + 2048 + col] * v;
    } };

__device__ __forceinline__ void lru_item(Frame& F, int T, int hb, bool fin) {
    const int row0 = 64 * T, tid = F.tid;
    int b, seq0, L; bool lat;
    if (row0 < MCTX) { b = row0 / LCTX; seq0 = b * LCTX; L = LCTX; lat = false; } else { b = (row0 - MCTX) / LLAT; seq0 = MCTX + b * LLAT; L = LLAT; lat = true; }
    const int p0 = row0 - seq0, ti = p0 / 64, ntile = L / 64;
    LAS float* xc = (LAS float*)F.lds; LAS float* a_s = xc + 8192; LAS float* b_s = xc + 16384; LAS float* hf_s = xc + 24576;
    for (int idx = tid; idx < 64 * 128; idx += NTHR) {
        const int t = idx >> 7, c = idx & 127, ch = hb * 128 + c;
        float acc = F.conv_b[ch];
#pragma unroll
        for (int tap = 0; tap < 4; ++tap) {
            const int tt = t + tap - 2; bool ok;
            if (lat) ok = (tt >= 0 && tt < 64); else { const int p = p0 + tt; ok = (p >= 0 && p < L); }
            if (ok) acc += F.conv_w[tap * DL + ch] * bf2f(F.XL[(size_t)(row0 + tt) * DL + ch]);
        }
        xc[idx] = acc;
    }
    __syncthreads();
    const int c = tid & 127, tg = tid >> 7, ch = hb * 128 + c;
    const bf16* W = F.WlruT + (size_t)hb * 512 * LB;
#pragma unroll 1
    for (int dir = 0; dir < 2; ++dir) {
        float acc[2][16];
#pragma unroll
        for (int s = 0; s < 2; ++s)
#pragma unroll
            for (int t = 0; t < 16; ++t) acc[s][t] = 0.f;
        const bf16* W0 = W + (size_t)((2 * dir) * 128 + c) * LB; const bf16* W1 = W + (size_t)((2 * dir + 1) * 128 + c) * LB;
#pragma unroll 2
        for (int i = 0; i < 128; ++i) {
            const float w0 = bf2f(W0[i]), w1 = bf2f(W1[i]);
#pragma unroll
            for (int t = 0; t < 16; ++t) { const float xv = bfr(xc[(tg * 16 + t) * 128 + i]); acc[0][t] += xv * w0; acc[1][t] += xv * w1; }
        }
        const float ba = F.lru_ba[dir * DL + ch], bx = F.lru_bx[dir * DL + ch];
        const float sp = log1pf(expf(-F.lru_a[dir * DL + ch]));
#pragma unroll
        for (int t = 0; t < 16; ++t) {
            const int tok = tg * 16 + t;
            const float r = sigmoidf_(acc[0][t] + ba), gi = sigmoidf_(acc[1][t] + bx);
            const float la = -8.0f * r * sp;
            a_s[tok * 128 + c] = expf(la);
            b_s[tok * 128 + c] = sqrtf(-expm1f(2.0f * la)) * gi * xc[tok * 128 + c];
        }
        __syncthreads();
        if (tid < 128) {
            const int cc = tid, chh = hb * 128 + cc;
            float carry = 0.f;
            if (fin) {
                carry = lat ? F.state_lru[(size_t)(b * 2 + dir) * DL + chh] : 0.f;
                if (dir == 0) { for (int n = 0; n < ti; ++n) { const float* ag = F.AGG + ((size_t)((T - ti + n) * 2 + 0) * 2) * DL; carry = ag[chh] * carry + ag[DL + chh]; } }
                else { for (int n = ntile - 1; n > ti; --n) { const float* ag = F.AGG + ((size_t)((T - ti + n) * 2 + 1) * 2) * DL; carry = ag[chh] * carry + ag[DL + chh]; } }
            }
            float h = carry, P = 1.f;
            if (dir == 0) {
                for (int t = 0; t < 64; ++t) { const float a = a_s[t * 128 + cc]; h = a * h + b_s[t * 128 + cc]; P *= a; if (fin) hf_s[t * 128 + cc] = h; }
                if (fin && !lat && ti == ntile - 1) F.out[OUT_NSL + (size_t)(b * 2 + 0) * DL + chh] = h;
            } else {
                for (int t = 63; t >= 0; --t) { const float a = a_s[t * 128 + cc]; h = a * h + b_s[t * 128 + cc]; P *= a; if (fin) hf_s[t * 128 + cc] += h; }
                if (fin && !lat && ti == 0) F.out[OUT_NSL + (size_t)(b * 2 + 1) * DL + chh] = h;
            }
            if (!fin) { float* ag = F.AGG + ((size_t)(T * 2 + dir) * 2) * DL; ag[chh] = P; ag[DL + chh] = h; }
        }
        __syncthreads();
    }
    if (fin) {
        for (int idx = tid; idx < 64 * 128; idx += NTHR) {
            const int t = idx >> 7, cc = idx & 127; const size_t o = (size_t)(row0 + t) * DL + hb * 128 + cc;
            F.HL[o] = (bf16)f2bf(hf_s[idx] * bf2f(F.GL[o]));
        }
    }
    __syncthreads();
}
__device__ __forceinline__ void phase_lru(Frame& F, bool fin) {
    for (int it = F.wg; it < (M / 64) * NB; it += F.G) lru_item(F, it / NB, it % NB, fin);
}

__device__ __forceinline__ float log_gamma(const Frame& F, int dir, int h) { const float x = F.decay_logit[dir * NH + h]; return -log1pf(expf(-x)); }
__device__ __forceinline__ size_t sp_index(int b, int h, int dir, int n) { return ((size_t)(((b * NH + h) * 2 + dir) * NCH_LAT + n)) * (DK * DV); }
__device__ __forceinline__ void phase_r12(Frame& F) {
    const int e = F.tid;
    constexpr int ITEMS = (NCTX + NLAT) * NH * 2 * (DK / 4);
    for (int it = F.wg; it < ITEMS; it += F.G) {
        int r = it; const int dg = r % (DK / 4); r /= (DK / 4); const int dir = r & 1; r >>= 1; const int h = r % NH; const int s = r / NH;
        const bool lat = s >= NCTX; const int b = lat ? s - NCTX : s; const int L = lat ? LLAT : LCTX; const int seq0 = lat ? MCTX + b * LLAT : b * LCTX;
        const float g = expf(log_gamma(F, dir, h));
        float S[4];
#pragma unroll
        for (int u = 0; u < 4; ++u) S[u] = lat ? F.state_ret[((size_t)((b * 2 + dir) * NH + h) * DK + dg * 4 + u) * DV + e] : 0.f;
        const int nch = L / CH;
        for (int nn = 0; nn < nch; ++nn) {
            const int n = dir == 0 ? nn : nch - 1 - nn;
            if (lat) {
#pragma unroll
                for (int u = 0; u < 4; ++u) F.SP[sp_index(b, h, dir, n) + (size_t)(dg * 4 + u) * DV + e] = (bf16)f2bf(S[u]);
            }
            for (int ii = 0; ii < CH; ++ii) {
                const int i = dir == 0 ? ii : CH - 1 - ii; const size_t row = (size_t)seq0 + n * CH + i;
                const float vv = bf2f(F.V[row * DRV + h * DV + e]);
                const unsigned long long kk = *(const unsigned long long*)(F.K + row * DQK + h * DK + dg * 4);
#pragma unroll
                for (int u = 0; u < 4; ++u) S[u] = g * S[u] + bf2f((unsigned short)(kk >> (16 * u))) * vv;
            }
        }
        if (!lat) {
#pragma unroll
            for (int u = 0; u < 4; ++u) F.out[OUT_NSR + ((size_t)((b * 2 + dir) * NH + h) * DK + dg * 4 + u) * DV + e] = S[u];
        }
    }
}

__device__ __forceinline__ void phase_r3(Frame& F) {
    LAS float* qs = (LAS float*)F.lds; LAS float* Ps = qs + 256; LAS float* red = qs + 512;
    const int tid = F.tid;
    for (int it = F.wg; it < M * NH; it += F.G) {
        const int row = it / NH, h = it % NH;
        const bool lat = row >= MCTX; const int b = lat ? (row - MCTX) / LLAT : row / LCTX; const int seq0 = lat ? MCTX + b * LLAT : b * LCTX;
        const int p = row - seq0, n = p / CH, i = p % CH, crow0 = row - i;
        const float lgf = log_gamma(F, 0, h), lgb = log_gamma(F, 1, h);
        if (tid < 256) qs[tid] = bf2f(F.Q[(size_t)row * DQK + h * DK + tid]);
        __syncthreads();
        if (tid < 256) {
            const int j = tid; const bf16* kr = F.K + (size_t)(crow0 + j) * DQK + h * DK; float s = 0.f;
            for (int d = 0; d < DK; d += 8) { const v4u kv = *(const v4u*)(kr + d);
                s += qs[d] * bf2f((unsigned short)kv.x) + qs[d + 1] * bf2f((unsigned short)(kv.x >> 16)) + qs[d + 2] * bf2f((unsigned short)kv.y) + qs[d + 3] * bf2f((unsigned short)(kv.y >> 16))
                   + qs[d + 4] * bf2f((unsigned short)kv.z) + qs[d + 5] * bf2f((unsigned short)(kv.z >> 16)) + qs[d + 6] * bf2f((unsigned short)kv.w) + qs[d + 7] * bf2f((unsigned short)(kv.w >> 16)); }
            const int dj = i - j; const float dec = dj >= 0 ? expf(lgf * (float)dj) : expf(lgb * (float)(-dj));
            Ps[j] = bfr(s * dec);
        }
        __syncthreads();
        const int e = tid; float acc = 0.f;
        for (int j = 0; j < CH; ++j) acc += Ps[j] * bf2f(F.V[(size_t)(crow0 + j) * DRV + h * DV + e]);
        if (lat) {
            const bf16* sf = F.SP + sp_index(b, h, 0, n); const bf16* sb = F.SP + sp_index(b, h, 1, n);
            float af = 0.f, ab = 0.f;
            for (int d = 0; d < DK; ++d) { af += qs[d] * bf2f(sf[(size_t)d * DV + e]); ab += qs[d] * bf2f(sb[(size_t)d * DV + e]); }
            acc += expf(lgf * (float)(i + 1)) * af + expf(lgb * (float)(CH - i)) * ab;
        }
        float ss = wave_sum(acc * acc);
        if (F.lane == 0) red[F.wave] = ss;
        __syncthreads();
        ss = 0.f;
#pragma unroll
        for (int w = 0; w < NWAVES; ++w) ss += red[w];
        const float sc = 1.0f / sqrtf(ss * (1.0f / DV) + EPS);
        F.OG[(size_t)row * DRV + h * DV + e] = (bf16)f2bf(acc * sc * F.gn_w[h * DV + e]);
        __syncthreads();
    }
}


typedef float f32x16 __attribute__((ext_vector_type(16)));
typedef short s16x4 __attribute__((ext_vector_type(4)));
typedef short v4i16_t __attribute__((ext_vector_type(4)));
typedef float f32x2_t __attribute__((ext_vector_type(2))); typedef __bf16 bf16x2_t __attribute__((ext_vector_type(2)));
typedef LAS const char* lds_cptr;
#define MFMA32(a, b, c) __builtin_amdgcn_mfma_f32_32x32x16_bf16((a), (b), (c), 0, 0, 0)
__device__ __forceinline__ int crow(int reg, int hh) { return (reg & 3) + 8 * (reg >> 2) + 4 * hh; }
__device__ __forceinline__ s16x4 vtr(lds_cptr p) { return __builtin_bit_cast(s16x4, __builtin_amdgcn_ds_read_tr16_b64_v4i16((LAS v4i16_t*)p)); }
__device__ __forceinline__ unsigned cvtpk(float lo, float hi) { f32x2_t v = {lo, hi}; bf16x2_t b = __builtin_convertvector(v, bf16x2_t); return __builtin_bit_cast(unsigned, b); }
__device__ __forceinline__ bf16x8 cat8(s16x4 lo, s16x4 hi) { return (bf16x8){lo[0], lo[1], lo[2], lo[3], hi[0], hi[1], hi[2], hi[3]}; }
__device__ __forceinline__ float ulo(unsigned w) { return __builtin_bit_cast(float, w << 16); }
__device__ __forceinline__ float uhi(unsigned w) { return __builtin_bit_cast(float, w & 0xffff0000u); }

constexpr int EQ = 128, NET = EQ / 32;
constexpr int KSTR = 528;
constexpr int KTSTR = 576;
constexpr int VSTR = 320;
constexpr int R3_KB0 = 0, R3_KB1 = 32 * KSTR, R3_VB0 = 2 * 32 * KSTR, R3_VB1 = R3_VB0 + 32 * VSTR;
constexpr int R12_KB0 = 0, R12_KB1 = 32 * KTSTR, R12_VB0 = 2 * 32 * KTSTR, R12_VB1 = R12_VB0 + 32 * VSTR;

__device__ __forceinline__ void r3f_item(Frame& F, int it) {
    bool lat; int b, n, h, eq;
    if (it < NLAT * NCH_LAT * NH * 4) { lat = true; eq = it & 3; h = (it >> 2) & 3; n = (it >> 4) & 7; b = it >> 7; }
    else { const int i2 = it - NLAT * NCH_LAT * NH * 4; lat = false; eq = i2 & 3; h = (i2 >> 2) & 3; n = 0; b = i2 >> 4; }
    const int seq0 = lat ? MCTX + b * LLAT : b * LCTX, row0 = seq0 + n * CH;
    const int tid = F.tid, lane = F.lane, w = F.wave, r32 = lane & 31, hh = lane >> 5;
    const float lgf = log_gamma(F, 0, h), lgb = log_gamma(F, 1, h);
    LAS char* lds = (LAS char*)F.lds;
    bf16x8 qf[16];
    { const bf16* qp = F.Q + (size_t)(row0 + 32 * w + r32) * DQK + h * DK + 8 * hh;
#pragma unroll
      for (int ks = 0; ks < 16; ++ks) qf[ks] = *(const bf16x8*)(qp + 16 * ks); }
    f32x16 acc[NET];
#pragma unroll
    for (int et = 0; et < NET; ++et)
#pragma unroll
        for (int r = 0; r < 16; ++r) acc[et][r] = 0.f;
    const int vrow = tid >> 4, vch = tid & 15;
    const int blk = (lane >> 4) & 1, q4 = (lane & 15) >> 2, p4 = lane & 3;
    const int trn = (8 * hh + q4) * VSTR + 32 * blk + 8 * p4;
    const int trp = (4 * hh + q4) * VSTR + 32 * blk + 8 * p4;
    if (lat) {
#pragma unroll 1
        for (int dir = 0; dir < 2; ++dir) {
            const bf16* sp = F.SP + sp_index(b, h, dir, n) + eq * EQ;
            { const v4u v = *(const v4u*)(sp + (size_t)vrow * DV + vch * 8); *(LAS v4u*)(lds + R3_VB0 + vrow * VSTR + vch * 16) = v; }
            __syncthreads();
#pragma unroll
            for (int db = 0; db < 8; ++db) {
                v4u nv = {0u, 0u, 0u, 0u};
                if (db < 7) nv = *(const v4u*)(sp + (size_t)(32 * (db + 1) + vrow) * DV + vch * 8);
                lds_cptr vb = lds + ((db & 1) ? R3_VB1 : R3_VB0);
#pragma unroll
                for (int ks2 = 0; ks2 < 2; ++ks2)
#pragma unroll
                    for (int et = 0; et < NET; ++et) {
                        const s16x4 lo = vtr(vb + trn + (16 * ks2) * VSTR + 64 * et), hi = vtr(vb + trn + (16 * ks2 + 4) * VSTR + 64 * et);
                        acc[et] = MFMA32(qf[2 * db + ks2], cat8(lo, hi), acc[et]);
                    }
                if (db < 7) *(LAS v4u*)(lds + ((db & 1) ? R3_VB0 : R3_VB1) + vrow * VSTR + vch * 16) = nv;
                __syncthreads();
            }
#pragma unroll
            for (int r = 0; r < 16; ++r) {
                const float i = (float)(32 * w + crow(r, hh));
                const float f = dir == 0 ? __expf(lgf * (i + 1.0f) - lgb * (256.0f - i)) : __expf(lgb * (256.0f - i));
#pragma unroll
                for (int et = 0; et < NET; ++et) acc[et][r] *= f;
            }
        }
    }
    {
        const bf16* kp = F.K + (size_t)row0 * DQK + h * DK; const bf16* vp = F.V + (size_t)row0 * DRV + h * DV + eq * EQ;
        const int krow0 = tid >> 5, kch = tid & 31;
        { const v4u k0 = *(const v4u*)(kp + (size_t)krow0 * DQK + kch * 8), k1 = *(const v4u*)(kp + (size_t)(krow0 + 16) * DQK + kch * 8);
          const v4u v0 = *(const v4u*)(vp + (size_t)vrow * DRV + vch * 8);
          *(LAS v4u*)(lds + R3_KB0 + krow0 * KSTR + kch * 16) = k0; *(LAS v4u*)(lds + R3_KB0 + (krow0 + 16) * KSTR + kch * 16) = k1;
          *(LAS v4u*)(lds + R3_VB0 + vrow * VSTR + vch * 16) = v0; }
        __syncthreads();
#pragma unroll 1
        for (int jb = 0; jb < 8; ++jb) {
            const int cur = jb & 1;
            v4u k0 = {0u, 0u, 0u, 0u}, k1 = k0, v0 = k0;
            if (jb < 7) { const size_t r1 = (size_t)(32 * (jb + 1));
                k0 = *(const v4u*)(kp + (r1 + krow0) * DQK + kch * 8); k1 = *(const v4u*)(kp + (r1 + krow0 + 16) * DQK + kch * 8);
                v0 = *(const v4u*)(vp + (r1 + vrow) * DRV + vch * 8); }
            lds_cptr kb = lds + (cur ? R3_KB1 : R3_KB0) + r32 * KSTR + 16 * hh;
            lds_cptr vb = lds + (cur ? R3_VB1 : R3_VB0);
            f32x16 X;
#pragma unroll
            for (int r = 0; r < 16; ++r) X[r] = 0.f;
#pragma unroll
            for (int ks = 0; ks < 16; ++ks) { const bf16x8 a = *(const LAS bf16x8*)(kb + 32 * ks); X = MFMA32(a, qf[ks], X); }
            const int qi = 32 * w + r32;
#pragma unroll
            for (int r = 0; r < 16; ++r) { const int dj = qi - (32 * jb + crow(r, hh)); X[r] *= dj >= 0 ? __expf(lgf * (float)dj) : __expf(-lgb * (float)dj); }
            bf16x8 pa[2];
#pragma unroll
            for (int s2 = 0; s2 < 2; ++s2) { const unsigned u0 = cvtpk(X[8 * s2], X[8 * s2 + 1]), u1 = cvtpk(X[8 * s2 + 2], X[8 * s2 + 3]), u2 = cvtpk(X[8 * s2 + 4], X[8 * s2 + 5]), u3 = cvtpk(X[8 * s2 + 6], X[8 * s2 + 7]);
                pa[s2] = __builtin_bit_cast(bf16x8, (v4u){u0, u1, u2, u3}); }
#pragma unroll
            for (int s2 = 0; s2 < 2; ++s2)
#pragma unroll
                for (int et = 0; et < NET; ++et) {
                    const s16x4 lo = vtr(vb + trp + (16 * s2) * VSTR + 64 * et), hi = vtr(vb + trp + (16 * s2 + 8) * VSTR + 64 * et);
                    acc[et] = MFMA32(pa[s2], cat8(lo, hi), acc[et]);
                }
            if (jb < 7) { LAS char* kn = lds + (cur ? R3_KB0 : R3_KB1); LAS char* vn = lds + (cur ? R3_VB0 : R3_VB1);
                *(LAS v4u*)(kn + krow0 * KSTR + kch * 16) = k0; *(LAS v4u*)(kn + (krow0 + 16) * KSTR + kch * 16) = k1; *(LAS v4u*)(vn + vrow * VSTR + vch * 16) = v0; }
            __syncthreads();
        }
    }
#pragma unroll
    for (int r = 0; r < 16; ++r) {
        float ss = 0.f;
#pragma unroll
        for (int et = 0; et < NET; ++et) ss += acc[et][r] * acc[et][r];
#pragma unroll
        for (int o = 1; o < 32; o <<= 1) ss += __shfl_xor(ss, o);
        const int row = row0 + 32 * w + crow(r, hh);
        if (r32 == 0) F.SS[((size_t)row * NH + h) * 4 + eq] = ss;
        bf16* op = F.OG + (size_t)row * DRV + h * DV + eq * EQ + r32;
#pragma unroll
        for (int et = 0; et < NET; ++et) op[32 * et] = (bf16)f2bf(acc[et][r]);
    }
}
__device__ __forceinline__ void phase_r3f(Frame& F) {
    for (int it = F.wg; it < (NLAT * NCH_LAT + NCTX) * NH * 4; it += F.G) r3f_item(F, it);
}

__device__ __forceinline__ void r12f_item(Frame& F, int it) {
    bool lat; int b, h, dir, eq;
    if (it < NLAT * NH * 2 * 4) { lat = true; eq = it & 3; dir = (it >> 2) & 1; h = (it >> 3) & 3; b = it >> 5; }
    else { const int i2 = it - NLAT * NH * 2 * 4; lat = false; eq = i2 & 3; dir = (i2 >> 2) & 1; h = (i2 >> 3) & 3; b = i2 >> 5; }
    const int seq0 = lat ? MCTX + b * LLAT : b * LCTX;
    const int tid = F.tid, lane = F.lane, w = F.wave, r32 = lane & 31, hh = lane >> 5;
    const float lg = log_gamma(F, dir, h);
    LAS char* lds = (LAS char*)F.lds;
    f32x16 acc[NET];
    if (lat) {
        const float* s0 = F.state_ret + ((size_t)((b * 2 + dir) * NH + h) * DK) * DV + eq * EQ + r32;
#pragma unroll
        for (int et = 0; et < NET; ++et)
#pragma unroll
            for (int r = 0; r < 16; ++r) acc[et][r] = s0[(size_t)(32 * w + crow(r, hh)) * DV + 32 * et];
    } else {
#pragma unroll
        for (int et = 0; et < NET; ++et)
#pragma unroll
            for (int r = 0; r < 16; ++r) acc[et][r] = 0.f;
    }
    const int nproc = lat ? NCH_LAT - 1 : 1;
    const int nblocks = nproc * 8;
    const int vrow = tid >> 4, vch = tid & 15, krow0 = tid >> 5, kch = tid & 31;
    const int blk = (lane >> 4) & 1, q4 = (lane & 15) >> 2, p4 = lane & 3;
    const int tra = (8 * hh + q4) * KTSTR + 64 * w + 32 * blk + 8 * p4;
    const int trb = (8 * hh + q4) * VSTR + 32 * blk + 8 * p4;
    const bf16* kp = F.K + (size_t)seq0 * DQK + h * DK; const bf16* vp = F.V + (size_t)seq0 * DRV + h * DV + eq * EQ;
    const float g256 = __expf(lg * 256.0f);
    const int nch = lat ? NCH_LAT : 1;
    v4u k0, k1, v0;
#define R12_LOAD(t) do { const int cn_ = (t) >> 3, tb_ = (t) & 7, n_ = dir ? nch - 1 - cn_ : cn_; const size_t r_ = (size_t)(n_ * CH + 32 * tb_); \
        k0 = *(const v4u*)(kp + (r_ + krow0) * DQK + kch * 8); k1 = *(const v4u*)(kp + (r_ + krow0 + 16) * DQK + kch * 8); \
        const v4u vv_ = *(const v4u*)(vp + (r_ + vrow) * DRV + vch * 8); const int pos_ = 32 * tb_ + vrow; \
        const float dec_ = __expf(lg * (float)(dir ? pos_ : 255 - pos_)); \
        v0.x = cvtpk(ulo(vv_.x) * dec_, uhi(vv_.x) * dec_); v0.y = cvtpk(ulo(vv_.y) * dec_, uhi(vv_.y) * dec_); v0.z = cvtpk(ulo(vv_.z) * dec_, uhi(vv_.z) * dec_); v0.w = cvtpk(ulo(vv_.w) * dec_, uhi(vv_.w) * dec_); } while (0)
#define R12_STORE(buf) do { LAS char* kn_ = lds + ((buf) ? R12_KB1 : R12_KB0); LAS char* vn_ = lds + ((buf) ? R12_VB1 : R12_VB0); \
        *(LAS v4u*)(kn_ + krow0 * KTSTR + kch * 16) = k0; *(LAS v4u*)(kn_ + (krow0 + 16) * KTSTR + kch * 16) = k1; *(LAS v4u*)(vn_ + vrow * VSTR + vch * 16) = v0; } while (0)
    R12_LOAD(0); R12_STORE(0);
    __syncthreads();
#pragma unroll 1
    for (int t = 0; t < nblocks; ++t) {
        const int cur = t & 1;
        if ((t & 7) == 0) {
            if (lat) {
                const int cn = t >> 3, n = dir ? nch - 1 - cn : cn;
                bf16* sp = F.SP + sp_index(b, h, dir, n) + eq * EQ + r32;
#pragma unroll
                for (int et = 0; et < NET; ++et)
#pragma unroll
                    for (int r = 0; r < 16; ++r) sp[(size_t)(32 * w + crow(r, hh)) * DV + 32 * et] = (bf16)f2bf(acc[et][r]);
            }
#pragma unroll
            for (int et = 0; et < NET; ++et)
#pragma unroll
                for (int r = 0; r < 16; ++r) acc[et][r] *= g256;
        }
        if (t + 1 < nblocks) R12_LOAD(t + 1);
        lds_cptr kb = lds + (cur ? R12_KB1 : R12_KB0), vb = lds + (cur ? R12_VB1 : R12_VB0);
#pragma unroll
        for (int ks2 = 0; ks2 < 2; ++ks2) {
            const bf16x8 a = cat8(vtr(kb + tra + (16 * ks2) * KTSTR), vtr(kb + tra + (16 * ks2 + 4) * KTSTR));
#pragma unroll
            for (int et = 0; et < NET; ++et) {
                const bf16x8 bb = cat8(vtr(vb + trb + (16 * ks2) * VSTR + 64 * et), vtr(vb + trb + (16 * ks2 + 4) * VSTR + 64 * et));
                acc[et] = MFMA32(a, bb, acc[et]);
            }
        }
        if (t + 1 < nblocks) R12_STORE(cur ^ 1);
        __syncthreads();
    }
#undef R12_LOAD
#undef R12_STORE
    if (lat) {
        const int n = dir ? 0 : nch - 1;
        bf16* sp = F.SP + sp_index(b, h, dir, n) + eq * EQ + r32;
#pragma unroll
        for (int et = 0; et < NET; ++et)
#pragma unroll
            for (int r = 0; r < 16; ++r) sp[(size_t)(32 * w + crow(r, hh)) * DV + 32 * et] = (bf16)f2bf(acc[et][r]);
    } else {
        float* op = F.out + OUT_NSR + ((size_t)((b * 2 + dir) * NH + h) * DK) * DV + eq * EQ + r32;
#pragma unroll
        for (int et = 0; et < NET; ++et)
#pragma unroll
            for (int r = 0; r < 16; ++r) op[(size_t)(32 * w + crow(r, hh)) * DV + 32 * et] = acc[et][r];
    }
}
__device__ __forceinline__ void phase_r12f(Frame& F) {
    constexpr int NLI = NLAT * NH * 2 * 4, NCI = NCTX * NH * 2 * 4;
    if (F.G == 256) {
        if (F.wg < NLI) r12f_item(F, F.wg);
        else { for (int j = 0; j < 4; ++j) r12f_item(F, NLI + (F.wg - NLI) * 4 + j); }
    } else {
        for (int it = F.wg; it < NLI + NCI; it += F.G) r12f_item(F, it);
    }
}


constexpr int XSTR = 272, LRU_XCB = 0, LRU_AS = 64 * XSTR, LRU_BS = LRU_AS + 32768, LRU_HF = LRU_BS + 32768;
__device__ __forceinline__ void lruf_item(Frame& F, int T, int hb, bool fin) {
    const int row0 = 64 * T, tid = F.tid, lane = F.lane, w = F.wave, r32 = lane & 31, hh = lane >> 5;
    int b, seq0, L; bool lat;
    if (row0 < MCTX) { b = row0 / LCTX; seq0 = b * LCTX; L = LCTX; lat = false; } else { b = (row0 - MCTX) / LLAT; seq0 = MCTX + b * LLAT; L = LLAT; lat = true; }
    const int p0 = row0 - seq0, ti = p0 / 64, ntile = L / 64;
    LAS char* lds = (LAS char*)F.lds;
    LAS float* a_s = (LAS float*)(lds + LRU_AS); LAS float* b_s = (LAS float*)(lds + LRU_BS); LAS float* hf_s = (LAS float*)(lds + LRU_HF);
    LAS float* segp = (LAS float*)(lds + LRU_HF + 32768); LAS float* segh = segp + 512; LAS float* carry_s = segh + 512;
    if (fin && tid < 256) {
        const int d2 = tid >> 7, cc = tid & 127, chh = hb * 128 + cc;
        float carry = lat ? F.state_lru[(size_t)(b * 2 + d2) * DL + chh] : 0.f;
        if (d2 == 0) { for (int n = 0; n < ti; ++n) { const float* ag = F.AGG + ((size_t)((T - ti + n) * 2 + 0) * 2) * DL; carry = ag[chh] * carry + ag[DL + chh]; } }
        else { for (int n = ntile - 1; n > ti; --n) { const float* ag = F.AGG + ((size_t)((T - ti + n) * 2 + 1) * 2) * DL; carry = ag[chh] * carry + ag[DL + chh]; } }
        carry_s[tid] = carry;
    }
#pragma unroll
    for (int pp = 0; pp < 2; ++pp) {
        const int piece = tid + 512 * pp, t = piece >> 4, c8 = piece & 15, ch0 = hb * 128 + 8 * c8;
        f32x4 x0 = *(const f32x4*)(F.conv_b + ch0), x1 = *(const f32x4*)(F.conv_b + ch0 + 4);
#pragma unroll
        for (int tap = 0; tap < 4; ++tap) {
            const int tt = t + tap - 2; bool ok;
            if (lat) ok = (tt >= 0 && tt < 64); else { const int p = p0 + tt; ok = (p >= 0 && p < L); }
            if (ok) {
                const v4u raw = *(const v4u*)(F.XL + (size_t)(row0 + tt) * DL + ch0);
                const f32x4 w0 = *(const f32x4*)(F.conv_w + tap * DL + ch0), w1 = *(const f32x4*)(F.conv_w + tap * DL + ch0 + 4);
                x0[0] += w0[0] * ulo(raw.x); x0[1] += w0[1] * uhi(raw.x); x0[2] += w0[2] * ulo(raw.y); x0[3] += w0[3] * uhi(raw.y);
                x1[0] += w1[0] * ulo(raw.z); x1[1] += w1[1] * uhi(raw.z); x1[2] += w1[2] * ulo(raw.w); x1[3] += w1[3] * uhi(raw.w);
            }
        }
        v4u o; o.x = cvtpk(x0[0], x0[1]); o.y = cvtpk(x0[2], x0[3]); o.z = cvtpk(x1[0], x1[1]); o.w = cvtpk(x1[2], x1[3]);
        *(LAS v4u*)(lds + LRU_XCB + t * XSTR + c8 * 16) = o;
    }
    __syncthreads();
    const int rt = w >> 2, cg = w & 3, c = 32 * cg + r32, ch = hb * 128 + c;
#pragma unroll 1
    for (int dir = 0; dir < 2; ++dir) {
        f32x16 acc0, acc1;
#pragma unroll
        for (int r = 0; r < 16; ++r) { acc0[r] = 0.f; acc1[r] = 0.f; }
        const bf16* wb = F.WlruT + (size_t)hb * 512 * LB + (size_t)((2 * dir) * 128 + c) * LB + 8 * hh;
        lds_cptr xa = lds + LRU_XCB + (32 * rt + r32) * XSTR + 16 * hh;
#pragma unroll
        for (int ks = 0; ks < 8; ++ks) {
            const bf16x8 a = *(const LAS bf16x8*)(xa + 32 * ks);
            const bf16x8 b0 = *(const bf16x8*)(wb + 16 * ks), b1 = *(const bf16x8*)(wb + 128 * LB + 16 * ks);
            acc0 = MFMA32(a, b0, acc0); acc1 = MFMA32(a, b1, acc1);
        }
        const float ba = F.lru_ba[dir * DL + ch], bx = F.lru_bx[dir * DL + ch];
        const float sp = log1pf(expf(-F.lru_a[dir * DL + ch]));
#pragma unroll
        for (int r = 0; r < 16; ++r) {
            const int tok = 32 * rt + crow(r, hh);
            const float rr = __builtin_amdgcn_rcpf(1.0f + __expf(-(acc0[r] + ba))), gi = __builtin_amdgcn_rcpf(1.0f + __expf(-(acc1[r] + bx)));
            const float la = -8.0f * rr * sp, x2 = 2.0f * la;
            const float xv = bf2f(*(const LAS bf16*)(lds + LRU_XCB + tok * XSTR + c * 2));
            const float pl = -x2 * (1.0f + x2 * 0.5f * (1.0f + x2 * (1.0f / 3.0f) * (1.0f + x2 * 0.25f * (1.0f + x2 * 0.2f * (1.0f + x2 * (1.0f / 6.0f) * (1.0f + x2 * (1.0f / 7.0f)))))));
            const float em = x2 > -0.25f ? pl : 1.0f - __expf(x2);
            a_s[tok * 128 + c] = __expf(la);
            b_s[tok * 128 + c] = sqrtf(em) * gi * xv;
        }
        __syncthreads();
        {
            const int seg = tid >> 7, cc = tid & 127, chh = hb * 128 + cc;
            const int tb = dir == 0 ? 16 * seg : 16 * seg + 15, ts = dir == 0 ? 1 : -1;
            float av[16], bv[16];
#pragma unroll
            for (int k = 0; k < 16; ++k) { const int t = tb + ts * k; av[k] = a_s[t * 128 + cc]; bv[k] = b_s[t * 128 + cc]; }
            float h = 0.f, pr = 1.f;
#pragma unroll
            for (int k = 0; k < 16; ++k) { h = av[k] * h + bv[k]; pr *= av[k]; bv[k] = h; av[k] = pr; }
            segp[seg * 128 + cc] = pr; segh[seg * 128 + cc] = h;
            __syncthreads();
            float cin = fin ? carry_s[dir * 128 + cc] : 0.f;
            if (dir == 0) { for (int s2 = 0; s2 < seg; ++s2) cin = segp[s2 * 128 + cc] * cin + segh[s2 * 128 + cc]; }
            else { for (int s2 = 3; s2 > seg; --s2) cin = segp[s2 * 128 + cc] * cin + segh[s2 * 128 + cc]; }
            if (fin) {
#pragma unroll
                for (int k = 0; k < 16; ++k) { const int t = tb + ts * k; const float hv = bv[k] + av[k] * cin;
                    if (dir == 0) hf_s[t * 128 + cc] = hv; else hf_s[t * 128 + cc] += hv; }
            }
            const bool lastseg = dir == 0 ? seg == 3 : seg == 0;
            if (lastseg) {
                const float hend = bv[15] + av[15] * cin;
                if (!fin) { float* ag = F.AGG + ((size_t)(T * 2 + dir) * 2) * DL; ag[chh] = (segp[cc] * segp[128 + cc]) * (segp[256 + cc] * segp[384 + cc]); ag[DL + chh] = hend; }
                else if (!lat && (dir == 0 ? ti == ntile - 1 : ti == 0)) F.out[OUT_NSL + (size_t)(b * 2 + dir) * DL + chh] = hend;
            }
        }
        __syncthreads();
    }
    if (fin) {
#pragma unroll
        for (int pp = 0; pp < 2; ++pp) {
            const int piece = tid + 512 * pp, t = piece >> 4, c8 = piece & 15; const size_t o = (size_t)(row0 + t) * DL + hb * 128 + 8 * c8;
            const v4u g = *(const v4u*)(F.GL + o); const LAS float* hp = hf_s + t * 128 + 8 * c8;
            const f32x4 h0 = *(const LAS f32x4*)hp, h1 = *(const LAS f32x4*)(hp + 4);
            v4u r; r.x = cvtpk(h0[0] * ulo(g.x), h0[1] * uhi(g.x)); r.y = cvtpk(h0[2] * ulo(g.y), h0[3] * uhi(g.y)); r.z = cvtpk(h1[0] * ulo(g.z), h1[1] * uhi(g.z)); r.w = cvtpk(h1[2] * ulo(g.w), h1[3] * uhi(g.w));
            *(v4u*)(F.HL + o) = r;
        }
    }
    __syncthreads();
}
__device__ __forceinline__ void phase_lruf(Frame& F, bool fin) {
    for (int it = F.wg; it < (M / 64) * NB; it += F.G) lruf_item(F, it / NB, it % NB, fin);
}

__device__ __forceinline__ void phase_norm(Frame& F) {
    const int gw = F.wg * NWAVES + F.wave, NGW = F.G * NWAVES;
    for (int m = gw; m < M; m += NGW) {
        f32x4* yr = (f32x4*)(F.out + OUT_Y + (size_t)m * D) + F.lane;
        f32x4 v[4]; float s = 0.f;
#pragma unroll
        for (int j = 0; j < 4; ++j) { v[j] = yr[64 * j]; s += (v[j].x * v[j].x + v[j].y * v[j].y) + (v[j].z * v[j].z + v[j].w * v[j].w); }
        const float rstd = 1.0f / sqrtf(wave_sum(s) * (1.f / D) + EPS);
#pragma unroll
        for (int j = 0; j < 4; ++j) { const f32x4 nw = *(const f32x4*)(F.final_norm_w + 4 * F.lane + 256 * j); yr[64 * j] = v[j] * rstd * nw; }
    }
}

__device__ __forceinline__ int opq(int x) { int r; asm volatile("s_mov_b32 %0, %1" : "=s"(r) : "s"(x)); return r; }
constexpr int PH_PREP = 0, PH_H = 1, PH_GEMM1 = 2, PH_LRUA = 3, PH_LRUB = 4, PH_R12 = 5, PH_R3 = 6, PH_G2 = 7, PH_DOWN = 8, PH_OUT = 9, PH_NORM = 10, N_PHASES = 11;

__global__ void __launch_bounds__(NTHR, 2) fwd_kernel(Args args) {
    extern __shared__ __attribute__((aligned(16))) unsigned char lds_raw[];
    Frame F;
    F.lds = (LAS unsigned char*)lds_raw;
    F.tid = threadIdx.x; F.lane = F.tid & 63; F.wave = __builtin_amdgcn_readfirstlane(F.tid >> 6);
    F.G = gridDim.x; F.wg = blockIdx.x;
    F.x_prompt = args.in[0]; F.x_sample = args.in[1]; F.state_ret = args.in[2]; F.state_lru = args.in[3]; F.c = args.in[4]; F.c_ctx = args.in[5];
    F.norm_w = args.in[6]; F.w_ada = args.in[7]; F.b_ada = args.in[8]; F.w_in = args.in[9]; F.decay_logit = args.in[10]; F.gn_w = args.in[11];
    F.w_ret_down = args.in[12]; F.conv_w = args.in[13]; F.conv_b = args.in[14]; F.lru_wa = args.in[15]; F.lru_ba = args.in[16]; F.lru_wx = args.in[17];
    F.lru_bx = args.in[18]; F.lru_a = args.in[19]; F.w_lru_down = args.in[20]; F.w_out = args.in[21]; F.final_norm_w = args.in[22];
    F.out = args.out; F.ws = args.ws;
    unsigned char* ws = args.ws;
    F.WinT = (bf16*)(ws + WS_WINT); F.WrdT = (bf16*)(ws + WS_WRDT); F.WldT = (bf16*)(ws + WS_WLDT); F.WoutT = (bf16*)(ws + WS_WOUTT); F.WlruT = (bf16*)(ws + WS_WLRUT);
    F.MOD = (float*)(ws + WS_MOD); F.MODP = (float*)(ws + WS_MODP); F.H = (bf16*)(ws + WS_H); F.Q = (bf16*)(ws + WS_Q); F.K = (bf16*)(ws + WS_K); F.V = (bf16*)(ws + WS_V);
    F.XL = (bf16*)(ws + WS_XL); F.GL = (bf16*)(ws + WS_GL); F.AGG = (float*)(ws + WS_AGG); F.SS = (float*)(ws + WS_SS); F.HL = (bf16*)(ws + WS_HL); F.SP = (bf16*)(ws + WS_SP);
    F.SIGR = (bf16*)(ws + WS_SIGR); F.SIGL = (bf16*)(ws + WS_SIGL); F.MERGED = (bf16*)(ws + WS_MERGED); F.OG = (bf16*)(args.out + OUT_Y);

    volatile LAS unsigned* MISC = (volatile LAS unsigned*)(F.lds + MISC_OFF);
    for (int u = F.tid; u < (LDS_BYTES - 131072) / 4; u += NTHR) ((LAS unsigned*)(F.lds + 131072))[u] = 0u;
    __syncthreads();
    const int lo = args.ph_lo, hi = args.ph_hi;
    XcdBarrier bar; bar.bar = (unsigned*)(ws + WS_CTL) + CW_BAR; bar.x = 0; bar.st = nullptr;
    if (hi - lo > 1) bar = xcd_barrier_post((unsigned*)(ws + WS_CTL) + CW_BAR, MISC + 8);
#define IN(k) (lo <= (k) && (k) < hi)
#define SEAM(k) do { if (IN(k) && IN((k) + 1)) xcd_barrier(bar); } while (0)

    if (IN(PH_PREP)) { for (int rp = 0; rp < args.rep[PH_PREP]; ++rp) { F.wg = opq(blockIdx.x); phase_prep(F); __syncthreads(); } SEAM(PH_PREP); }
    if (IN(PH_H)) { for (int rp = 0; rp < args.rep[PH_H]; ++rp) { F.wg = opq(blockIdx.x); phase_h(F); } SEAM(PH_H); }
    if (IN(PH_GEMM1)) { pg8::Gemm g{F.H, F.WinT, M, N1, D}; pg8::StaticOrder S; S.init(M, N1, F.G, F.wg); pg8::EpiG1 E{F.Q, F.K, F.V, F.XL, F.GL};
        pg8::gemm_phase<pg8::EpiG1, pg8::StaticOrder, true, true>(F.lds, g, S, E); SEAM(PH_GEMM1); }
    if (IN(PH_LRUA)) { for (int rp = 0; rp < args.rep[PH_LRUA]; ++rp) { F.wg = opq(blockIdx.x); phase_lruf(F, false); } SEAM(PH_LRUA); }
    if (IN(PH_LRUB)) { for (int rp = 0; rp < args.rep[PH_LRUB]; ++rp) { F.wg = opq(blockIdx.x); phase_lruf(F, true); } SEAM(PH_LRUB); }
    if (IN(PH_R12)) { for (int rp = 0; rp < args.rep[PH_R12]; ++rp) { F.wg = opq(blockIdx.x); phase_r12f(F); } SEAM(PH_R12); }
    if (IN(PH_R3)) { for (int rp = 0; rp < args.rep[PH_R3]; ++rp) { F.wg = opq(blockIdx.x); phase_r3f(F); } SEAM(PH_R3); }
    if (IN(PH_G2)) { pg8::Gemm g{F.H, F.WinT + (size_t)N1 * D, M, N2, D}; pg8::StaticOrder S; S.init(M, N2, F.G, F.wg); pg8::EpiG2 E{F.OG, F.SIGR, F.SIGL, F.SS, F.gn_w};
        pg8::gemm_phase<pg8::EpiG2, pg8::StaticOrder, true, true>(F.lds, g, S, E); SEAM(PH_G2); }
    if (IN(PH_DOWN)) {
        { pg8::Gemm g{F.OG, F.WrdT, M, D, DRV}; pg8::StaticOrder S; S.init(M, D, F.G, F.wg); pg8::EpiDown<false> E{F.MERGED, F.SIGR}; pg8::gemm_phase<pg8::EpiDown<false>, pg8::StaticOrder, true, true>(F.lds, g, S, E); }
        { pg8::Gemm g{F.HL, F.WldT, M, D, DL}; pg8::StaticOrder S; S.init(M, D, F.G, F.wg); pg8::EpiDown<true> E{F.MERGED, F.SIGL}; pg8::gemm_phase<pg8::EpiDown<true>, pg8::StaticOrder, true, true>(F.lds, g, S, E); }
        SEAM(PH_DOWN);
    }
    if (IN(PH_OUT)) { pg8::Gemm g{F.MERGED, F.WoutT, M, D, D}; pg8::StaticOrder S; S.init(M, D, F.G, F.wg); pg8::EpiY E{F.out + OUT_Y, F.x_prompt, F.x_sample, F.MOD, MCTX, LLAT};
        pg8::gemm_phase<pg8::EpiY, pg8::StaticOrder, true, true>(F.lds, g, S, E); SEAM(PH_OUT); }
    if (IN(PH_NORM)) { phase_norm(F); }
#undef IN
#undef SEAM
}
}

extern "C" void kernel_launch(void* const* d_in, const int* in_sizes, int n_in, void* d_out, int out_size, void* d_ws, size_t ws_size, hipStream_t stream) {
    static int grid = 0;
    if (grid == 0) {
        if (n_in != 23 || (size_t)out_size != OUT_TOTAL || ws_size < WS_END) { fprintf(stderr, "kernel_launch: unexpected shapes n_in %d out %d ws %zu\n", n_in, out_size, ws_size); grid = -1; return; }
        int dev = 0, cus = 0;
        if (hipGetDevice(&dev) != hipSuccess || hipDeviceGetAttribute(&cus, hipDeviceAttributeMultiprocessorCount, dev) != hipSuccess) { grid = -1; return; }
        if (hipFuncSetAttribute((const void*)fwd_kernel, hipFuncAttributeMaxDynamicSharedMemorySize, LDS_BYTES) != hipSuccess) { fprintf(stderr, "kernel_launch: hipFuncSetAttribute failed\n"); grid = -1; return; }
        int per_cu = 0;
        (void)hipOccupancyMaxActiveBlocksPerMultiprocessor(&per_cu, (const void*)fwd_kernel, NTHR, LDS_BYTES);
        (void)hipGetLastError();
        grid = cus;
    }
    if (grid < 0) return;
    (void)hipMemsetAsync((char*)d_ws + WS_CTL, 0, CTL_ZERO_BYTES, stream);
    Args a{};
    for (int i = 0; i < 23; ++i) a.in[i] = (const float*)d_in[i];
    a.out = (float*)d_out; a.ws = (unsigned char*)d_ws;
    { static const int REP[12] = {PROBE_REP}; for (int i = 0; i < 12; ++i) a.rep[i] = REP[i]; }
#if MK_ONE_LAUNCH
    a.ph_lo = 0; a.ph_hi = N_PHASES;
    hipLaunchKernelGGL(fwd_kernel, dim3(grid), dim3(NTHR), LDS_BYTES, stream, a);
#else
    for (int p = 0; p < N_PHASES; ++p) { a.ph_lo = p; a.ph_hi = p + 1; hipLaunchKernelGGL(fwd_kernel, dim3(grid), dim3(NTHR), LDS_BYTES, stream, a); }
#endif
}
```

```cpp
#include <hip/hip_runtime.h>
#include <cstdint>
#include <cstdio>

#ifndef PROBE_REP
#define PROBE_REP 1,1,1,1,1,1,1,1,1,1,1,1
#endif
#ifndef MK_ONE_LAUNCH
#define MK_ONE_LAUNCH 1
#endif

namespace {
constexpr int D = 1024, NCTX = 16, LCTX = 256, NLAT = 4, LLAT = 2048;
constexpr int MCTX = NCTX * LCTX, MLAT = NLAT * LLAT, M = MCTX + MLAT;
constexpr int NH = 4, DK = 256, DV = 512, DQK = NH * DK, DRV = NH * DV;
constexpr int NB = 10, LB = 128, DL = NB * LB;
constexpr int DIN = 10752;
constexpr int N1 = 6656;
constexpr int N2 = 4096;
constexpr int CH = 256;
constexpr int NCH_LAT = LLAT / CH;
constexpr float EPS = 1e-6f;
constexpr int NWAVES = 8, NTHR = 512;

constexpr size_t MiB = 1u << 20;
constexpr size_t WS_CTL = 0, CTL_ZERO_BYTES = 1 * MiB;
constexpr size_t WS_WINT = 1 * MiB;
constexpr size_t WS_WRDT = 22 * MiB;
constexpr size_t WS_WLDT = 26 * MiB;
constexpr size_t WS_WOUTT = 28 * MiB + 512 * 1024;
constexpr size_t WS_WLRUT = 30 * MiB + 512 * 1024;
constexpr size_t WS_MOD = 31 * MiB + 768 * 1024;
constexpr size_t WS_H = 32 * MiB;
constexpr size_t WS_Q = 56 * MiB, WS_K = 80 * MiB, WS_V = 104 * MiB;
constexpr size_t WS_XL = 152 * MiB, WS_GL = 182 * MiB;
constexpr size_t WS_AGG = 216 * MiB;
constexpr size_t WS_SS = 220 * MiB;
constexpr size_t WS_MODP = 224 * MiB;
constexpr size_t WS_HL = 226 * MiB;
constexpr size_t WS_SP = 152 * MiB;
constexpr size_t WS_SIGR = 56 * MiB, WS_SIGL = 80 * MiB;
constexpr size_t WS_MERGED = 104 * MiB;
constexpr size_t WS_END = 256 * MiB;
constexpr size_t OUT_Y = 0;
constexpr size_t OUT_NSR = (size_t)M * D;
constexpr size_t OUT_NSL = OUT_NSR + (size_t)NCTX * 2 * NH * DK * DV;
constexpr size_t OUT_TOTAL = OUT_NSL + (size_t)NCTX * 2 * DL;

constexpr int CW_TMO = 0, CW_CODE = 1, CW_BAR = 4096;
constexpr int LDS_BYTES = 147456;
constexpr int MISC_OFF = 131072 + 320;

#define GAS __attribute__((address_space(1)))
#define LAS __attribute__((address_space(3)))
typedef unsigned short bf16;
typedef unsigned v4u __attribute__((ext_vector_type(4)));
typedef float f32x4 __attribute__((ext_vector_type(4)));
typedef short bf16x8 __attribute__((ext_vector_type(8)));
typedef GAS unsigned gu32;
#define RLX_AGENT __ATOMIC_RELAXED, __HIP_MEMORY_SCOPE_AGENT
#define LDS_WAIT() asm volatile("s_waitcnt lgkmcnt(0)" ::: "memory")
#define VM_WAIT() asm volatile("s_waitcnt vmcnt(0)" ::: "memory")

__device__ __forceinline__ unsigned f2bf(float f) { unsigned u = __builtin_bit_cast(unsigned, f); return (u + 0x7fffu + ((u >> 16) & 1u)) >> 16; }
__device__ __forceinline__ float bf2f(unsigned short b) { return __builtin_bit_cast(float, ((unsigned)b) << 16); }
__device__ __forceinline__ float bfr(float f) { return bf2f((unsigned short)f2bf(f)); }
__device__ __forceinline__ unsigned pk2(float lo, float hi) { return f2bf(lo) | (f2bf(hi) << 16); }
__device__ __forceinline__ float sigmoidf_(float x) { return 1.0f / (1.0f + __expf(-x)); }
__device__ __forceinline__ float siluf_(float x) { return x / (1.0f + __expf(-x)); }

#define XB_TMO      128
#define XB_XCNT(j)  (256  + 64 * (j))
#define XB_XSUB(j)  (1280 + 64 * (j))
#define XB_XGEN(j)  (2304 + 64 * (j))
#define XB_TOP      3328
#define XB_TOPGEN   3392
#define XCD_BAR_WORDS 3456
#define XB_SPIN_CAP (1u << 22)
__device__ __forceinline__ unsigned xb_ld(unsigned* p)              { return __hip_atomic_load(p, __ATOMIC_RELAXED, __HIP_MEMORY_SCOPE_AGENT); }
__device__ __forceinline__ unsigned xb_add(unsigned* p, unsigned v) { return __hip_atomic_fetch_add(p, v, __ATOMIC_RELAXED, __HIP_MEMORY_SCOPE_AGENT); }
__device__ __forceinline__ unsigned xb_xcc_id() { return (unsigned)__builtin_amdgcn_s_getreg((3 << 11) | 20) & 0xFu; }
#define XB_SPIN(cond, bar) do { unsigned _sp = 0; while (cond) { __builtin_amdgcn_s_sleep(1); \
    if ((++_sp & 255u) == 0u) { if (xb_ld(&(bar)[XB_TMO])) break; if (_sp > XB_SPIN_CAP) { atomicAdd(&(bar)[XB_TMO], 1u); break; } } } } while (0)
struct XcdBarrier { unsigned* bar; unsigned x; volatile LAS unsigned* st; };
__device__ __forceinline__ XcdBarrier xcd_barrier_post(unsigned* bar, volatile LAS unsigned* st) {
    XcdBarrier b; b.bar = bar; b.x = xb_xcc_id(); b.st = st;
    if (threadIdx.x == 0) (void)xb_add(&bar[XB_XCNT(b.x)], 1u);
    return b;
}
__device__ __forceinline__ void xcd_barrier_complete(unsigned* bar, unsigned x, unsigned& nloc, unsigned& nx) {
    const unsigned G = gridDim.x * gridDim.y * gridDim.z;
    unsigned sum, cnt, mine, sp = 0u;
    for (;;) {
        sum = 0u; cnt = 0u; mine = 0u;
#pragma unroll
        for (unsigned j = 0; j < 16; ++j) { const unsigned c = xb_ld(&bar[XB_XCNT(j)]); sum += c; cnt += (c > 0u) ? 1u : 0u; mine = (j == x) ? c : mine; }
        if (sum == G) break;
        __builtin_amdgcn_s_sleep(1);
        if ((++sp & 255u) == 0u) { if (xb_ld(&bar[XB_TMO])) break; if (sp > XB_SPIN_CAP) { atomicAdd(&bar[XB_TMO], 1u); break; } }
    }
    nloc = mine > 0u ? mine : 1u; nx = cnt > 0u ? cnt : 1u;
}
__device__ __forceinline__ void xcd_barrier(const XcdBarrier& b) {
    asm volatile("s_waitcnt vmcnt(0)" ::: "memory");
    __syncthreads();
    if (threadIdx.x == 0) {
        unsigned* bar = b.bar;
        __builtin_amdgcn_s_waitcnt(0);
        unsigned nloc = b.st[0], nx = b.st[1];
        if (nloc == 0u) { xcd_barrier_complete(bar, b.x, nloc, nx); b.st[0] = nloc; b.st[1] = nx; }
        const unsigned old = xb_add(&bar[XB_XSUB(b.x)], 1u);
        const unsigned gen = old / nloc;
        if (old + 1u == (gen + 1u) * nloc) {
            __builtin_amdgcn_fence(__ATOMIC_RELEASE, "agent");
            asm volatile("s_waitcnt vmcnt(0)" ::: "memory");
            const unsigned og = xb_add(&bar[XB_TOP], 1u);
            const unsigned tg = og / nx;
            if (og + 1u == (tg + 1u) * nx) xb_add(&bar[XB_TOPGEN], 1u);
            else XB_SPIN(xb_ld(&bar[XB_TOPGEN]) == tg, bar);
            __builtin_amdgcn_fence(__ATOMIC_ACQUIRE, "agent");
            xb_add(&bar[XB_XGEN(b.x)], 1u);
            asm volatile("s_waitcnt vmcnt(0)" ::: "memory");
        } else {
            XB_SPIN(xb_ld(&bar[XB_XGEN(b.x)]) == gen, bar);
            __builtin_amdgcn_fence(__ATOMIC_ACQUIRE, "agent");
            asm volatile("s_waitcnt vmcnt(0)" ::: "memory");
        }
    }
    __syncthreads();
}

namespace pg8 {
#define PG8_LAS __attribute__((address_space(3)))
typedef unsigned short bf16_t;
typedef short bf16x8 __attribute__((ext_vector_type(8)));
typedef float f32x4 __attribute__((ext_vector_type(4)));
typedef unsigned u32x4 __attribute__((ext_vector_type(4)));
constexpr int BM = 256, BK = 64, HALF = 128, HTB = HALF * BK * 2  , STAGE_BYTES = 8 * HTB, NXCD = 8, WGM = 8;

__host__ __device__ __forceinline__ int lds_byte(int r, int c) { const int st = (r >> 4) * 2 + (c >> 5), rr = r & 15, cc = c & 31, ob = rr * 64 + cc * 2; return st * 1024 + (ob ^ (((ob >> 9) & 1) << 5)); }
__host__ __device__ __forceinline__ void stage_rc(int b, int& R, int& C) { const int st = b / 1024, sb = b % 1024, swz = sb ^ (((sb >> 9) & 1) << 5); R = (st >> 1) * 16 + swz / 64; C = (st & 1) * 32 + (swz % 64) / 2; }
__host__ __device__ __forceinline__ int perm32(int rho) { const int n = rho >> 4, i = rho & 15; return 8 * (i >> 2) + 4 * n + (i & 3); }

struct Unit { int pm, pn; };
struct Gemm { const bf16_t* A; const bf16_t* Bt; int M, N, K; };

struct StaticOrder {
    int nM, nN, nwg, G, c;
    __host__ __device__ void init(int M, int N, int G_, int c_) { nM = M / BM; nN = N / BM; nwg = nM * nN; G = G_; c = c_; }
    __host__ __device__ bool next(int i, Unit& u) const {
        const long L = (long)i * G + c; if (L >= nwg) return false;
        int wgid = (int)L; { const int q = nwg / NXCD, r = nwg % NXCD, xcd = wgid % NXCD, off = wgid / NXCD; wgid = (xcd < r ? xcd * (q + 1) : r * (q + 1) + (xcd - r) * q) + off; }
        const int nig = WGM * nN, gid = wgid / nig, fm = gid * WGM, gsz = (nM - fm) < WGM ? (nM - fm) : WGM;
        u.pm = fm + ((wgid % nig) % gsz); u.pn = (wgid % nig) / gsz; return true;
    }
    __device__ __forceinline__ void a_ready(const Unit&) const {}
    __device__ __forceinline__ void done(const Unit&) const {}
};

__device__ __forceinline__ unsigned cvt_pk_bf16(float lo, float hi) { unsigned r; asm volatile("v_cvt_pk_bf16_f32 %0, %1, %2" : "=v"(r) : "v"(lo), "v"(hi)); return r; }

typedef float f32x2 __attribute__((ext_vector_type(2)));
__device__ __forceinline__ float pg_silu(float x) { return x * __builtin_amdgcn_rcpf(1.0f + __expf(-x)); }
__device__ __forceinline__ float pg_sigm(float x) { return __builtin_amdgcn_rcpf(1.0f + __expf(-x)); }
__device__ __forceinline__ float pg_lo(unsigned w) { return __builtin_bit_cast(float, w << 16); }
__device__ __forceinline__ float pg_hi(unsigned w) { return __builtin_bit_cast(float, w & 0xffff0000u); }
struct EpiG1 {
    static constexpr bool PERM = true, AFTER_DRAIN = false;
    bf16_t *Q, *K, *V, *XL, *GL;
    __device__ __forceinline__ void operator()(const f32x4 (&acc)[2][2][4][2], const Unit& u, int wr, int wc, int fr, int fq) const {
        const int row0 = u.pm * BM + wr * 64 + fr; int colt = u.pn * BM; bf16_t* base; int ldc; float sc = 1.f; bool act = false;
        if (colt < 1024) { base = Q; ldc = 1024; } else if (colt < 2048) { base = K; ldc = 1024; colt -= 1024; sc = 0.0625f; }
        else if (colt < 4096) { base = V; ldc = 2048; colt -= 2048; } else if (colt < 5376) { base = XL; ldc = 1280; colt -= 4096; } else { base = GL; ldc = 1280; colt -= 5376; act = true; }
        const int col0 = colt + wc * 32 + 8 * fq;
#pragma unroll
        for (int ai = 0; ai < 2; ++ai)
#pragma unroll
            for (int m = 0; m < 4; ++m) { bf16_t* rowp = base + (size_t)(row0 + ai * HALF + m * 16) * ldc + col0;
#pragma unroll
                for (int bj = 0; bj < 2; ++bj) { f32x4 v0 = acc[ai][bj][m][0], v1 = acc[ai][bj][m][1];
                    if (act) {
#pragma unroll
                        for (int j = 0; j < 4; ++j) { v0[j] = pg_silu(v0[j]); v1[j] = pg_silu(v1[j]); } }
                    v0 = v0 * sc; v1 = v1 * sc; u32x4 w; w.x = cvt_pk_bf16(v0[0], v0[1]); w.y = cvt_pk_bf16(v0[2], v0[3]); w.z = cvt_pk_bf16(v1[0], v1[1]); w.w = cvt_pk_bf16(v1[2], v1[3]);
                    *(u32x4*)(rowp + bj * HALF) = w; } }
    }
};
struct EpiG2 {
    static constexpr bool PERM = true, AFTER_DRAIN = false;
    bf16_t *OG, *SIGR, *SIGL; const float *SS, *gnw;
    __device__ __forceinline__ void operator()(const f32x4 (&acc)[2][2][4][2], const Unit& u, int wr, int wc, int fr, int fq) const {
        const int row0 = u.pm * BM + wr * 64 + fr; int colt = u.pn * BM; bf16_t* base; int ldc; bool mul = false;
        if (colt < 2048) { base = OG; ldc = 2048; mul = true; } else if (colt < 3072) { base = SIGR; ldc = 1024; colt -= 2048; } else { base = SIGL; ldc = 1024; colt -= 3072; }
        const int col0 = colt + wc * 32 + 8 * fq, head = colt >> 9;
        f32x4 gw[2][2];
#pragma unroll
        for (int bj = 0; bj < 2; ++bj)
#pragma unroll
            for (int n = 0; n < 2; ++n) gw[bj][n] = mul ? *(const f32x4*)(gnw + col0 + bj * HALF + 4 * n) : (f32x4){1.f, 1.f, 1.f, 1.f};
#pragma unroll
        for (int ai = 0; ai < 2; ++ai)
#pragma unroll
            for (int m = 0; m < 4; ++m) { const int r = row0 + ai * HALF + m * 16; bf16_t* rowp = base + (size_t)r * ldc + col0;
                float rs = 1.f;
                if (mul) { const f32x4 sq = *(const f32x4*)(SS + ((size_t)r * 4 + head) * 4); rs = 1.0f / sqrtf(((sq[0] + sq[1]) + (sq[2] + sq[3])) * (1.0f / 512.0f) + 1e-6f); }
#pragma unroll
                for (int bj = 0; bj < 2; ++bj) { f32x4 v0 = acc[ai][bj][m][0], v1 = acc[ai][bj][m][1];
                    if (mul) { const u32x4 o = *(const u32x4*)(rowp + bj * HALF); const f32x4 g0 = gw[bj][0] * rs, g1 = gw[bj][1] * rs;
                        v0[0] = pg_silu(v0[0]) * pg_lo(o.x) * g0[0]; v0[1] = pg_silu(v0[1]) * pg_hi(o.x) * g0[1]; v0[2] = pg_silu(v0[2]) * pg_lo(o.y) * g0[2]; v0[3] = pg_silu(v0[3]) * pg_hi(o.y) * g0[3];
                        v1[0] = pg_silu(v1[0]) * pg_lo(o.z) * g1[0]; v1[1] = pg_silu(v1[1]) * pg_hi(o.z) * g1[1]; v1[2] = pg_silu(v1[2]) * pg_lo(o.w) * g1[2]; v1[3] = pg_silu(v1[3]) * pg_hi(o.w) * g1[3];
                    } else {
#pragma unroll
                        for (int j = 0; j < 4; ++j) { v0[j] = pg_sigm(v0[j]); v1[j] = pg_sigm(v1[j]); } }
                    u32x4 w; w.x = cvt_pk_bf16(v0[0], v0[1]); w.y = cvt_pk_bf16(v0[2], v0[3]); w.z = cvt_pk_bf16(v1[0], v1[1]); w.w = cvt_pk_bf16(v1[2], v1[3]);
                    *(u32x4*)(rowp + bj * HALF) = w; } }
    }
};
template <bool ADD> struct EpiDown {
    static constexpr bool PERM = true, AFTER_DRAIN = false;
    bf16_t* MERGED; const bf16_t* SIG;
    __device__ __forceinline__ void operator()(const f32x4 (&acc)[2][2][4][2], const Unit& u, int wr, int wc, int fr, int fq) const {
        const int row0 = u.pm * BM + wr * 64 + fr, col0 = u.pn * BM + wc * 32 + 8 * fq;
#pragma unroll
        for (int ai = 0; ai < 2; ++ai)
#pragma unroll
            for (int m = 0; m < 4; ++m) { const size_t off = (size_t)(row0 + ai * HALF + m * 16) * 1024 + col0;
#pragma unroll
                for (int bj = 0; bj < 2; ++bj) { f32x4 v0 = acc[ai][bj][m][0], v1 = acc[ai][bj][m][1];
                    const u32x4 g = *(const u32x4*)(SIG + off + bj * HALF);
                    v0[0] *= pg_lo(g.x); v0[1] *= pg_hi(g.x); v0[2] *= pg_lo(g.y); v0[3] *= pg_hi(g.y); v1[0] *= pg_lo(g.z); v1[1] *= pg_hi(g.z); v1[2] *= pg_lo(g.w); v1[3] *= pg_hi(g.w);
                    if (ADD) { const u32x4 o = *(const u32x4*)(MERGED + off + bj * HALF);
                        v0[0] += pg_lo(o.x); v0[1] += pg_hi(o.x); v0[2] += pg_lo(o.y); v0[3] += pg_hi(o.y); v1[0] += pg_lo(o.z); v1[1] += pg_hi(o.z); v1[2] += pg_lo(o.w); v1[3] += pg_hi(o.w); }
                    u32x4 w; w.x = cvt_pk_bf16(v0[0], v0[1]); w.y = cvt_pk_bf16(v0[2], v0[3]); w.z = cvt_pk_bf16(v1[0], v1[1]); w.w = cvt_pk_bf16(v1[2], v1[3]);
                    *(u32x4*)(MERGED + off + bj * HALF) = w; } }
    }
};
struct EpiY {
    static constexpr bool PERM = false, AFTER_DRAIN = false;
    float* Y; const float *xp, *xs, *MOD; int mctx, llat;
    __device__ __forceinline__ void operator()(const f32x4 (&acc)[2][2][4][2], const Unit& u, int wr, int wc, int fr, int fq) const {
        const int row0 = u.pm * BM + wr * 64 + fr, col0 = u.pn * BM + wc * 32 + 4 * fq;
        const int rbase = u.pm * BM;
        const float* gate = MOD + (rbase < mctx ? 0 : 1 + (rbase - mctx) / llat) * 3072 + 2048;
        f32x4 gv[2][2];
#pragma unroll
        for (int bj = 0; bj < 2; ++bj)
#pragma unroll
            for (int n = 0; n < 2; ++n) gv[bj][n] = *(const f32x4*)(gate + col0 + bj * HALF + n * 16);
#pragma unroll
        for (int ai = 0; ai < 2; ++ai)
#pragma unroll
            for (int m = 0; m < 4; ++m) { const int r = row0 + ai * HALF + m * 16; const float* xr = (r < mctx ? xp + (size_t)r * 1024 : xs + (size_t)(r - mctx) * 1024) + col0; float* yr = Y + (size_t)r * 1024 + col0;
#pragma unroll
                for (int bj = 0; bj < 2; ++bj)
#pragma unroll
                    for (int n = 0; n < 2; ++n) { const f32x4 xv = *(const f32x4*)(xr + bj * HALF + n * 16); *(f32x4*)(yr + bj * HALF + n * 16) = xv + gv[bj][n] * acc[ai][bj][m][n]; } }
    }
};

template <class Epi, class Sched, bool ALIGN_EPI = false, bool SP2 = false>
__device__ __forceinline__ void gemm_phase(PG8_LAS unsigned char* lds, const Gemm g, const Sched& S, const Epi& E) {
    const int tid = threadIdx.x, wid = __builtin_amdgcn_readfirstlane(tid >> 6), lane = tid & 63, wr = wid >> 2, wc = wid & 3, fr = lane & 15, fq = lane >> 4;
    const int K = g.K, nt = K / BK;
    unsigned voffA[2], voffB[2];
#pragma unroll
    for (int i = 0; i < 2; ++i) { int R, C; stage_rc(tid * 16 + i * 8192, R, C); const int Rb = Epi::PERM ? ((R & ~31) + perm32(R & 31)) : R;
        voffA[i] = (unsigned)(R * K + C) * 2u; voffB[i] = (unsigned)(Rb * K + C) * 2u; }
    const size_t kstep = (size_t)(BK * 2);
    const size_t hstep = (size_t)HALF * K * 2;
    const size_t tstep = 2 * hstep;
    const unsigned ldsw = (unsigned)wid * 1024u;
    const int aoff = lds_byte(wr * 64 + fr, fq * 8), boff = lds_byte(wc * 32 + fr, fq * 8);
#define PG8_SA(b, h) (((b) * 2 + (h)) * HTB)
#define PG8_SB(b, h) ((4 + (b) * 2 + (h)) * HTB)
#define PG8_STAGE(bufoff, gbase, voff) do { _Pragma("unroll") for (int _i = 0; _i < 2; ++_i) \
        __builtin_amdgcn_global_load_lds((const unsigned*)((const char*)(gbase) + (voff)[_i]), (PG8_LAS unsigned*)(lds + (bufoff) + ldsw + _i * 8192), 16, 0, 0); } while (0)
#define PG8_LDA(dst, b, h) do { _Pragma("unroll") for (int m = 0; m < 4; ++m) _Pragma("unroll") for (int k = 0; k < 2; ++k) dst[m][k] = *(const PG8_LAS bf16x8*)(lds + PG8_SA(b, h) + aoff + m * 2048 + k * 1024); } while (0)
#define PG8_LDB(dst, b, h) do { _Pragma("unroll") for (int n = 0; n < 2; ++n) _Pragma("unroll") for (int k = 0; k < 2; ++k) dst[n][k] = *(const PG8_LAS bf16x8*)(lds + PG8_SB(b, h) + boff + n * 2048 + k * 1024); } while (0)
#define PG8_MMA(ai, bj, At, Bt) do { __builtin_amdgcn_s_setprio(1); _Pragma("unroll") for (int m = 0; m < 4; ++m) _Pragma("unroll") for (int n = 0; n < 2; ++n) _Pragma("unroll") for (int k = 0; k < 2; ++k) \
        acc[ai][bj][m][n] = __builtin_amdgcn_mfma_f32_16x16x32_bf16(Bt[n][k], At[m][k], acc[ai][bj][m][n], 0, 0, 0); __builtin_amdgcn_s_setprio(0); } while (0)
#define PG8_WAIT_V(n) asm volatile("s_waitcnt vmcnt(" #n ")" ::: "memory")
#define PG8_WAIT_L(n) asm volatile("s_waitcnt lgkmcnt(" #n ")" ::: "memory")
#define PG8_BAR __builtin_amdgcn_s_barrier()
#define PG8_SCHED __builtin_amdgcn_sched_barrier(0)
    Unit cur, nxt; int ui = 0;
    if (!S.next(0, cur)) return;
    f32x4 acc[2][2][4][2];
#pragma unroll
    for (int a = 0; a < 2; ++a)
#pragma unroll
        for (int b = 0; b < 2; ++b)
#pragma unroll
            for (int m = 0; m < 4; ++m)
#pragma unroll
                for (int n = 0; n < 2; ++n) acc[a][b][m][n] = (f32x4){0.f, 0.f, 0.f, 0.f};
    bf16x8 At[4][2], B0[2][2], B1[2][2];
    const char* cA = (const char*)g.A + (size_t)cur.pm * tstep; const char* cB = (const char*)g.Bt + (size_t)cur.pn * tstep;
    S.a_ready(cur);
    if constexpr (SP2) {
        PG8_STAGE(PG8_SB(0, 0), cB, voffB); PG8_STAGE(PG8_SB(0, 1), cB + hstep, voffB); PG8_STAGE(PG8_SA(0, 0), cA, voffA); PG8_STAGE(PG8_SA(0, 1), cA + hstep, voffA);
        if (wr == 1) PG8_BAR;
        PG8_WAIT_V(2); PG8_BAR;
        PG8_STAGE(PG8_SB(1, 0), cB + kstep, voffB); PG8_STAGE(PG8_SA(1, 0), cA + kstep, voffA); PG8_STAGE(PG8_SB(1, 1), cB + hstep + kstep, voffB);
        PG8_WAIT_V(6); PG8_BAR;
    } else {
        PG8_STAGE(PG8_SB(0, 0), cB, voffB); PG8_STAGE(PG8_SA(0, 0), cA, voffA); PG8_STAGE(PG8_SB(0, 1), cB + hstep, voffB); PG8_STAGE(PG8_SA(0, 1), cA + hstep, voffA);
        if (wr == 1) PG8_BAR;
        PG8_WAIT_V(4); PG8_BAR;
        PG8_STAGE(PG8_SB(1, 0), cB + kstep, voffB); PG8_STAGE(PG8_SA(1, 0), cA + kstep, voffA); PG8_STAGE(PG8_SB(1, 1), cB + hstep + kstep, voffB);
        PG8_WAIT_V(6); PG8_BAR;
    }
    for (;;) {
        const bool has_next = S.next(ui + 1, nxt);
        const char* nA = has_next ? (const char*)g.A + (size_t)nxt.pm * tstep : cA; const char* nB = has_next ? (const char*)g.Bt + (size_t)nxt.pn * tstep : cB;
        for (int t = 0; t < nt; t += 2) {
            const bool last = (t == nt - 2);
            const char* a1 = cA + (size_t)(t + 1) * kstep;
            const char* a2 = last ? nA : cA + (size_t)(t + 2) * kstep; const char* b2 = last ? nB : cB + (size_t)(t + 2) * kstep;
            const char* a3 = a2 + kstep; const char* b3 = b2 + kstep;
            if (last && has_next) S.a_ready(nxt);
            if constexpr (SP2) {
            PG8_LDB(B0, 0, 0); PG8_LDB(B1, 0, 1); PG8_SCHED; PG8_LDA(At, 0, 0); PG8_STAGE(PG8_SA(1, 1), a1 + hstep, voffA);
            PG8_WAIT_V(8); PG8_WAIT_L(0); PG8_BAR; PG8_MMA(0, 0, At, B0); PG8_MMA(0, 1, At, B1); PG8_BAR; PG8_SCHED;
            PG8_LDA(At, 0, 1); PG8_STAGE(PG8_SB(0, 0), b2, voffB); PG8_STAGE(PG8_SB(0, 1), b2 + hstep, voffB); PG8_STAGE(PG8_SA(0, 0), a2, voffA);
            PG8_WAIT_V(8); PG8_WAIT_L(0); PG8_BAR; PG8_MMA(1, 0, At, B0); PG8_MMA(1, 1, At, B1); PG8_BAR; PG8_SCHED;
            PG8_LDB(B0, 1, 0); PG8_LDB(B1, 1, 1); PG8_SCHED; PG8_LDA(At, 1, 0); PG8_STAGE(PG8_SA(0, 1), a2 + hstep, voffA);
            PG8_WAIT_V(8); PG8_WAIT_L(0); PG8_BAR; PG8_MMA(0, 0, At, B0); PG8_MMA(0, 1, At, B1); PG8_BAR; PG8_SCHED;
            PG8_LDA(At, 1, 1); PG8_STAGE(PG8_SB(1, 0), b3, voffB); PG8_STAGE(PG8_SB(1, 1), b3 + hstep, voffB); PG8_STAGE(PG8_SA(1, 0), a3, voffA);
            PG8_WAIT_V(8); PG8_WAIT_L(0); PG8_BAR; PG8_MMA(1, 0, At, B0); PG8_MMA(1, 1, At, B1); PG8_BAR; PG8_SCHED;
            } else {
            PG8_LDB(B0, 0, 0); PG8_SCHED; PG8_LDA(At, 0, 0); PG8_STAGE(PG8_SA(1, 1), a1 + hstep, voffA);
            PG8_WAIT_L(8); PG8_BAR; PG8_WAIT_L(0); PG8_MMA(0, 0, At, B0); PG8_BAR; PG8_SCHED;
            PG8_LDB(B1, 0, 1); PG8_STAGE(PG8_SB(0, 0), b2, voffB);
            PG8_BAR; PG8_WAIT_L(0); PG8_MMA(0, 1, At, B1); PG8_BAR;
            PG8_LDA(At, 0, 1); PG8_STAGE(PG8_SA(0, 0), a2, voffA);
            PG8_BAR; PG8_WAIT_L(0); PG8_MMA(1, 0, At, B0); PG8_BAR; PG8_SCHED;
            PG8_STAGE(PG8_SB(0, 1), b2 + hstep, voffB);
            PG8_WAIT_V(6); PG8_BAR; PG8_MMA(1, 1, At, B1); PG8_BAR;
            PG8_LDB(B0, 1, 0); PG8_SCHED; PG8_LDA(At, 1, 0); PG8_STAGE(PG8_SA(0, 1), a2 + hstep, voffA);
            PG8_WAIT_L(8); PG8_BAR; PG8_WAIT_L(0); PG8_MMA(0, 0, At, B0); PG8_BAR; PG8_SCHED;
            PG8_LDB(B1, 1, 1); PG8_STAGE(PG8_SB(1, 0), b3, voffB);
            PG8_BAR; PG8_WAIT_L(0); PG8_MMA(0, 1, At, B1); PG8_BAR;
            PG8_LDA(At, 1, 1); PG8_STAGE(PG8_SA(1, 0), a3, voffA);
            PG8_BAR; PG8_WAIT_L(0); PG8_MMA(1, 0, At, B0); PG8_BAR; PG8_SCHED;
            PG8_STAGE(PG8_SB(1, 1), b3 + hstep, voffB);
            PG8_WAIT_V(6); PG8_BAR; PG8_MMA(1, 1, At, B1); PG8_BAR;
            }
        }
        if constexpr (ALIGN_EPI) { if (wr == 0) PG8_BAR; }
        if constexpr (!Epi::AFTER_DRAIN) { E(acc, cur, wr, wc, fr, fq); S.done(cur); }
        if (!has_next) break;
#pragma unroll
        for (int a = 0; a < 2; ++a)
#pragma unroll
            for (int b = 0; b < 2; ++b)
#pragma unroll
                for (int m = 0; m < 4; ++m)
#pragma unroll
                    for (int n = 0; n < 2; ++n) acc[a][b][m][n] = (f32x4){0.f, 0.f, 0.f, 0.f};
        cur = nxt; cA = nA; cB = nB; ++ui;
        if constexpr (ALIGN_EPI) { if (wr == 1) PG8_BAR; }
    }
    PG8_WAIT_V(0);
    if constexpr (!ALIGN_EPI) { if (wr == 0) PG8_BAR; }
    PG8_BAR;
    if constexpr (Epi::AFTER_DRAIN) { E.fused(acc, cur, wr, wc, fr, fq, lds, wid, lane); S.done(cur); }
#undef PG8_SA
#undef PG8_SB
#undef PG8_STAGE
#undef PG8_LDA
#undef PG8_LDB
#undef PG8_MMA
#undef PG8_WAIT_V
#undef PG8_WAIT_L
#undef PG8_BAR
#undef PG8_SCHED
}
}

struct Args {
    const float* in[23]; float* out; unsigned char* ws; int ph_lo, ph_hi; int rep[12];
};
struct Frame {
    LAS unsigned char* lds;
    int tid, lane, wave, G, wg;
    const float *x_prompt, *x_sample, *state_ret, *state_lru, *c, *c_ctx, *norm_w, *w_ada, *b_ada, *w_in, *decay_logit, *gn_w, *w_ret_down,
                *conv_w, *conv_b, *lru_wa, *lru_ba, *lru_wx, *lru_bx, *lru_a, *w_lru_down, *w_out, *final_norm_w;
    float* out; unsigned char* ws;
    bf16 *WinT, *WrdT, *WldT, *WoutT, *WlruT, *H, *Q, *K, *V, *XL, *GL, *HL, *SP, *SIGR, *SIGL, *MERGED, *OG;
    float *MOD, *MODP, *AGG, *SS;
};

__device__ __forceinline__ float wave_sum(float v) {
#pragma unroll
    for (int o = 1; o < 64; o <<= 1) v += __shfl_xor(v, o);
    return v;
}
__device__ __forceinline__ const float* xrow_ptr(const Frame& F, int row) {
    return row < MCTX ? F.x_prompt + (size_t)row * D : F.x_sample + (size_t)(row - MCTX) * D;
}
__device__ __forceinline__ int mod_index(int row) { return row < MCTX ? 0 : 1 + (row - MCTX) / LLAT; }

__device__ __forceinline__ void p0_transpose_item(const float* W, int K, int N, bf16* WT, int drow0, int k0, int n0, LAS float* scr, int lane) {
#pragma unroll 8
    for (int i = 0; i < 32; ++i) { const int kk = 2 * i + (lane >> 5); scr[kk * 33 + (lane & 31)] = W[(size_t)(k0 + kk) * N + n0 + (lane & 31)]; }
    LDS_WAIT(); asm volatile("" ::: "memory");
    const int c = lane & 7;
#pragma unroll
    for (int j = 0; j < 4; ++j) { const int n = (lane >> 3) + 8 * j; const LAS float* s = scr + (8 * c) * 33 + n;
        v4u o; o.x = pk2(s[0 * 33], s[1 * 33]); o.y = pk2(s[2 * 33], s[3 * 33]); o.z = pk2(s[4 * 33], s[5 * 33]); o.w = pk2(s[6 * 33], s[7 * 33]);
        *(v4u*)(WT + (size_t)(drow0 + n) * K + k0 + 8 * c) = o; }
    LDS_WAIT(); asm volatile("" ::: "memory");
}
__device__ __forceinline__ int win_dst_row(int n) { return n < 4096 ? n : (n < 6144 ? n + 2560 : (n < 8704 ? n - 2048 : n)); }

constexpr int MOD_KQ = 4;
__device__ __forceinline__ void phase_prep(Frame& F) {
    LAS float* scr = (LAS float*)(F.lds + F.wave * 8448);
    LAS float* tab = (LAS float*)(F.lds + 8 * 8448);
    for (int i = F.tid; i < 5 * D; i += NTHR) { const float cv = i < D ? F.c_ctx[i] : F.c[i - D]; tab[i] = siluf_(cv); }
    __syncthreads();
    const int gw = F.wg * NWAVES + F.wave, NGW = F.G * NWAVES;
    constexpr int I_IN = (D / 64) * (DIN / 32), I_RD = (DRV / 64) * (D / 32), I_LD = (DL / 64) * (D / 32), I_OUT = (D / 64) * (D / 32), I_LRU = 40 * 8, I_MOD = MOD_KQ * (3072 / 64);
    constexpr int NITEMS = I_MOD + I_IN + I_RD + I_LD + I_OUT + I_LRU;
    for (int it = gw; it < NITEMS; it += NGW) {
        int r = it;
        if (r < I_MOD) {
            const int kq = r / 48, n = (r % 48) * 64 + F.lane;
            float acc[5] = {0.f, 0.f, 0.f, 0.f, 0.f};
            const float* wp = F.w_ada + (size_t)(kq * (D / MOD_KQ)) * 3072 + n; const LAS float* tp = tab + kq * (D / MOD_KQ);
#pragma unroll 16
            for (int k = 0; k < D / MOD_KQ; ++k) {
                const float w = wp[(size_t)k * 3072];
#pragma unroll
                for (int v = 0; v < 5; ++v) acc[v] += tp[v * D + k] * w;
            }
#pragma unroll
            for (int v = 0; v < 5; ++v) F.MODP[(kq * 5 + v) * 3072 + n] = acc[v];
            continue;
        }
        r -= I_MOD;
        if (r < I_IN) { const int nblk = DIN / 32, kb = r / nblk, nb = r % nblk; p0_transpose_item(F.w_in, D, DIN, F.WinT, win_dst_row(nb * 32), kb * 64, nb * 32, scr, F.lane); continue; }
        r -= I_IN;
        if (r < I_RD) { const int nblk = D / 32, kb = r / nblk, nb = r % nblk; p0_transpose_item(F.w_ret_down, DRV, D, F.WrdT, nb * 32, kb * 64, nb * 32, scr, F.lane); continue; }
        r -= I_RD;
        if (r < I_LD) { const int nblk = D / 32, kb = r / nblk, nb = r % nblk; p0_transpose_item(F.w_lru_down, DL, D, F.WldT, nb * 32, kb * 64, nb * 32, scr, F.lane); continue; }
        r -= I_LD;
        if (r < I_OUT) { const int nblk = D / 32, kb = r / nblk, nb = r % nblk; p0_transpose_item(F.w_out, D, D, F.WoutT, nb * 32, kb * 64, nb * 32, scr, F.lane); continue; }
        r -= I_OUT;
        {
            const int mi = r / 8, sub = r % 8, slot = mi / NB, hb = mi % NB, kb = sub / 4, nb = sub % 4;
            const float* W = ((slot & 1) ? F.lru_wx : F.lru_wa) + (size_t)((slot >> 1) * NB + hb) * LB * LB;
            p0_transpose_item(W, LB, LB, F.WlruT + (size_t)hb * 512 * LB, slot * 128 + nb * 32, kb * 64, nb * 32, scr, F.lane);
        }
    }
}

__device__ __forceinline__ void phase_h(Frame& F) {
    LAS float* tab = (LAS float*)F.lds;
    for (int i = F.tid; i < 5 * 2048; i += NTHR) { const int v = i >> 11, n = i & 2047; float a = F.b_ada[n];
#pragma unroll
        for (int kq = 0; kq < MOD_KQ; ++kq) a += F.MODP[(kq * 5 + v) * 3072 + n];
        tab[i] = a; }
    if (F.wg == 0) for (int i = F.tid; i < 5 * 1024; i += NTHR) { const int v = i >> 10, n = 2048 + (i & 1023); float a = F.b_ada[n];
#pragma unroll
        for (int kq = 0; kq < MOD_KQ; ++kq) a += F.MODP[(kq * 5 + v) * 3072 + n];
        F.MOD[v * 3072 + n] = a; }
    __syncthreads();
    const int gw = F.wg * NWAVES + F.wave, NGW = F.G * NWAVES;
    for (int m = gw; m < M; m += NGW) {
        const f32x4* xr = (const f32x4*)xrow_ptr(F, m) + F.lane;
        const LAS float* mod = tab + mod_index(m) * 2048;
        f32x4 v[4]; float s = 0.f;
#pragma unroll
        for (int j = 0; j < 4; ++j) { v[j] = xr[64 * j]; s += (v[j].x * v[j].x + v[j].y * v[j].y) + (v[j].z * v[j].z + v[j].w * v[j].w); }
        const float rstd = 1.0f / sqrtf(wave_sum(s) * (1.f / D) + EPS);
        unsigned long long* o8 = (unsigned long long*)(F.H + (size_t)m * D) + F.lane;
#pragma unroll
        for (int j = 0; j < 4; ++j) {
            const int c0 = 4 * F.lane + 256 * j;
            const f32x4 nw = *(const f32x4*)(F.norm_w + c0), sh = *(const LAS f32x4*)(mod + c0), sc = *(const LAS f32x4*)(mod + 1024 + c0);
            const f32x4 h = v[j] * rstd * nw * (sc + 1.0f) + sh;
            o8[64 * j] = (unsigned long long)pk2(h.x, h.y) | ((unsigned long long)pk2(h.z, h.w) << 32);
        }
    }
    __syncthreads();
}

template <class Epi>
__device__ __forceinline__ void gemm_simple(const Frame& F, const bf16* A, int lda, const bf16* Bt, int ldb, int Mr, int Nc, int K, const Epi& epi) {
    const int wr = F.wave >> 2, wc = F.wave & 3, fr = F.lane & 15, fq = F.lane >> 4;
    const int tilesN = Nc / 256, tiles = (Mr / 128) * tilesN;
    for (int t = F.wg; t < tiles; t += F.G) {
        const int tm = t / tilesN, tn = t % tilesN;
        const int row0 = tm * 128 + wr * 64, col0 = tn * 256 + wc * 64;
        f32x4 acc[4][4];
#pragma unroll
        for (int i = 0; i < 4; ++i)
#pragma unroll
            for (int j = 0; j < 4; ++j) acc[i][j] = (f32x4){0.f, 0.f, 0.f, 0.f};
        const bf16* ap = A + (size_t)(row0 + fr) * lda + 8 * fq;
        const bf16* bp = Bt + (size_t)(col0 + fr) * ldb + 8 * fq;
        for (int k0 = 0; k0 < K; k0 += 32) {
            bf16x8 a[4], b[4];
#pragma unroll
            for (int i = 0; i < 4; ++i) a[i] = *(const bf16x8*)(ap + (size_t)(16 * i) * lda + k0);
#pragma unroll
            for (int j = 0; j < 4; ++j) b[j] = *(const bf16x8*)(bp + (size_t)(16 * j) * ldb + k0);
#pragma unroll
            for (int i = 0; i < 4; ++i)
#pragma unroll
                for (int j = 0; j < 4; ++j) acc[i][j] = __builtin_amdgcn_mfma_f32_16x16x32_bf16(a[i], b[j], acc[i][j], 0, 0, 0);
        }
#pragma unroll
        for (int i = 0; i < 4; ++i)
#pragma unroll
            for (int j = 0; j < 4; ++j)
#pragma unroll
                for (int r = 0; r < 4; ++r) epi(row0 + 16 * i + 4 * fq + r, col0 + 16 * j + fr, acc[i][j][r]);
    }
}

struct EpiGemm1 {
    bf16 *Q, *K, *V, *XL, *GL;
    __device__ __forceinline__ void operator()(int row, int col, float v) const {
        if (col < 1024) Q[(size_t)row * 1024 + col] = (bf16)f2bf(v);
        else if (col < 2048) K[(size_t)row * 1024 + col - 1024] = (bf16)f2bf(v * 0.0625f);
        else if (col < 4096) V[(size_t)row * 2048 + col - 2048] = (bf16)f2bf(v);
        else if (col < 5376) XL[(size_t)row * 1280 + col - 4096] = (bf16)f2bf(v);
        else GL[(size_t)row * 1280 + col - 5376] = (bf16)f2bf(siluf_(v));
    }
};
struct EpiGemm2 {
    bf16 *OG, *SIGR, *SIGL;
    __device__ __forceinline__ void operator()(int row, int col, float v) const {
        if (col < 2048) { bf16* p = OG + (size_t)row * 2048 + col; *p = (bf16)f2bf(bf2f(*p) * siluf_(v)); }
        else if (col < 3072) SIGR[(size_t)row * 1024 + col - 2048] = (bf16)f2bf(sigmoidf_(v));
        else SIGL[(size_t)row * 1024 + col - 3072] = (bf16)f2bf(sigmoidf_(v));
    }
};
struct EpiDownR { bf16 *MERGED; const bf16* SIG;
    __device__ __forceinline__ void operator()(int row, int col, float v) const { const size_t o = (size_t)row * 1024 + col; MERGED[o] = (bf16)f2bf(bf2f(SIG[o]) * v); } };
struct EpiDownL { bf16 *MERGED; const bf16* SIG;
    __device__ __forceinline__ void operator()(int row, int col, float v) const { const size_t o = (size_t)row * 1024 + col; MERGED[o] = (bf16)f2bf(bf2f(MERGED[o]) + bf2f(SIG[o]) * v); } };
struct EpiOut { float* Y; const float *xp, *xs, *MOD;
    __device__ __forceinline__ void operator()(int row, int col, float v) const {
        const float xv = row < MCTX ? xp[(size_t)row * D + col] : xs[(size_t)(row - MCTX) * D + col];
        Y[(size_t)row * D + col] = xv + MOD[mod_index(row) * 3072 + 2048 + col] * v;
    } };

__device__ __forceinline__ void lru_item(Frame& F, int T, int hb, bool fin) {
    const int row0 = 64 * T, tid = F.tid;
    int b, seq0, L; bool lat;
    if (row0 < MCTX) { b = row0 / LCTX; seq0 = b * LCTX; L = LCTX; lat = false; } else { b = (row0 - MCTX) / LLAT; seq0 = MCTX + b * LLAT; L = LLAT; lat = true; }
    const int p0 = row0 - seq0, ti = p0 / 64, ntile = L / 64;
    LAS float* xc = (LAS float*)F.lds; LAS float* a_s = xc + 8192; LAS float* b_s = xc + 16384; LAS float* hf_s = xc + 24576;
    for (int idx = tid; idx < 64 * 128; idx += NTHR) {
        const int t = idx >> 7, c = idx & 127, ch = hb * 128 + c;
        float acc = F.conv_b[ch];
#pragma unroll
        for (int tap = 0; tap < 4; ++tap) {
            const int tt = t + tap - 2; bool ok;
            if (lat) ok = (tt >= 0 && tt < 64); else { const int p = p0 + tt; ok = (p >= 0 && p < L); }
            if (ok) acc += F.conv_w[tap * DL + ch] * bf2f(F.XL[(size_t)(row0 + tt) * DL + ch]);
        }
        xc[idx] = acc;
    }
    __syncthreads();
    const int c = tid & 127, tg = tid >> 7, ch = hb * 128 + c;
    const bf16* W = F.WlruT + (size_t)hb * 512 * LB;
#pragma unroll 1
    for (int dir = 0; dir < 2; ++dir) {
        float acc[2][16];
#pragma unroll
        for (int s = 0; s < 2; ++s)
#pragma unroll
            for (int t = 0; t < 16; ++t) acc[s][t] = 0.f;
        const bf16* W0 = W + (size_t)((2 * dir) * 128 + c) * LB; const bf16* W1 = W + (size_t)((2 * dir + 1) * 128 + c) * LB;
#pragma unroll 2
        for (int i = 0; i < 128; ++i) {
            const float w0 = bf2f(W0[i]), w1 = bf2f(W1[i]);
#pragma unroll
            for (int t = 0; t < 16; ++t) { const float xv = bfr(xc[(tg * 16 + t) * 128 + i]); acc[0][t] += xv * w0; acc[1][t] += xv * w1; }
        }
        const float ba = F.lru_ba[dir * DL + ch], bx = F.lru_bx[dir * DL + ch];
        const float sp = log1pf(expf(-F.lru_a[dir * DL + ch]));
#pragma unroll
        for (int t = 0; t < 16; ++t) {
            const int tok = tg * 16 + t;
            const float r = sigmoidf_(acc[0][t] + ba), gi = sigmoidf_(acc[1][t] + bx);
            const float la = -8.0f * r * sp;
            a_s[tok * 128 + c] = expf(la);
            b_s[tok * 128 + c] = sqrtf(-expm1f(2.0f * la)) * gi * xc[tok * 128 + c];
        }
        __syncthreads();
        if (tid < 128) {
            const int cc = tid, chh = hb * 128 + cc;
            float carry = 0.f;
            if (fin) {
                carry = lat ? F.state_lru[(size_t)(b * 2 + dir) * DL + chh] : 0.f;
                if (dir == 0) { for (int n = 0; n < ti; ++n) { const float* ag = F.AGG + ((size_t)((T - ti + n) * 2 + 0) * 2) * DL; carry = ag[chh] * carry + ag[DL + chh]; } }
                else { for (int n = ntile - 1; n > ti; --n) { const float* ag = F.AGG + ((size_t)((T - ti + n) * 2 + 1) * 2) * DL; carry = ag[chh] * carry + ag[DL + chh]; } }
            }
            float h = carry, P = 1.f;
            if (dir == 0) {
                for (int t = 0; t < 64; ++t) { const float a = a_s[t * 128 + cc]; h = a * h + b_s[t * 128 + cc]; P *= a; if (fin) hf_s[t * 128 + cc] = h; }
                if (fin && !lat && ti == ntile - 1) F.out[OUT_NSL + (size_t)(b * 2 + 0) * DL + chh] = h;
            } else {
                for (int t = 63; t >= 0; --t) { const float a = a_s[t * 128 + cc]; h = a * h + b_s[t * 128 + cc]; P *= a; if (fin) hf_s[t * 128 + cc] += h; }
                if (fin && !lat && ti == 0) F.out[OUT_NSL + (size_t)(b * 2 + 1) * DL + chh] = h;
            }
            if (!fin) { float* ag = F.AGG + ((size_t)(T * 2 + dir) * 2) * DL; ag[chh] = P; ag[DL + chh] = h; }
        }
        __syncthreads();
    }
    if (fin) {
        for (int idx = tid; idx < 64 * 128; idx += NTHR) {
            const int t = idx >> 7, cc = idx & 127; const size_t o = (size_t)(row0 + t) * DL + hb * 128 + cc;
            F.HL[o] = (bf16)f2bf(hf_s[idx] * bf2f(F.GL[o]));
        }
    }
    __syncthreads();
}
__device__ __forceinline__ void phase_lru(Frame& F, bool fin) {
    for (int it = F.wg; it < (M / 64) * NB; it += F.G) lru_item(F, it / NB, it % NB, fin);
}

__device__ __forceinline__ float log_gamma(const Frame& F, int dir, int h) { const float x = F.decay_logit[dir * NH + h]; return -log1pf(expf(-x)); }
__device__ __forceinline__ size_t sp_index(int b, int h, int dir, int n) { return ((size_t)(((b * NH + h) * 2 + dir) * NCH_LAT + n)) * (DK * DV); }
__device__ __forceinline__ void phase_r12(Frame& F) {
    const int e = F.tid;
    constexpr int ITEMS = (NCTX + NLAT) * NH * 2 * (DK / 4);
    for (int it = F.wg; it < ITEMS; it += F.G) {
        int r = it; const int dg = r % (DK / 4); r /= (DK / 4); const int dir = r & 1; r >>= 1; const int h = r % NH; const int s = r / NH;
        const bool lat = s >= NCTX; const int b = lat ? s - NCTX : s; const int L = lat ? LLAT : LCTX; const int seq0 = lat ? MCTX + b * LLAT : b * LCTX;
        const float g = expf(log_gamma(F, dir, h));
        float S[4];
#pragma unroll
        for (int u = 0; u < 4; ++u) S[u] = lat ? F.state_ret[((size_t)((b * 2 + dir) * NH + h) * DK + dg * 4 + u) * DV + e] : 0.f;
        const int nch = L / CH;
        for (int nn = 0; nn < nch; ++nn) {
            const int n = dir == 0 ? nn : nch - 1 - nn;
            if (lat) {
#pragma unroll
                for (int u = 0; u < 4; ++u) F.SP[sp_index(b, h, dir, n) + (size_t)(dg * 4 + u) * DV + e] = (bf16)f2bf(S[u]);
            }
            for (int ii = 0; ii < CH; ++ii) {
                const int i = dir == 0 ? ii : CH - 1 - ii; const size_t row = (size_t)seq0 + n * CH + i;
                const float vv = bf2f(F.V[row * DRV + h * DV + e]);
                const unsigned long long kk = *(const unsigned long long*)(F.K + row * DQK + h * DK + dg * 4);
#pragma unroll
                for (int u = 0; u < 4; ++u) S[u] = g * S[u] + bf2f((unsigned short)(kk >> (16 * u))) * vv;
            }
        }
        if (!lat) {
#pragma unroll
            for (int u = 0; u < 4; ++u) F.out[OUT_NSR + ((size_t)((b * 2 + dir) * NH + h) * DK + dg * 4 + u) * DV + e] = S[u];
        }
    }
}

__device__ __forceinline__ void phase_r3(Frame& F) {
    LAS float* qs = (LAS float*)F.lds; LAS float* Ps = qs + 256; LAS float* red = qs + 512;
    const int tid = F.tid;
    for (int it = F.wg; it < M * NH; it += F.G) {
        const int row = it / NH, h = it % NH;
        const bool lat = row >= MCTX; const int b = lat ? (row - MCTX) / LLAT : row / LCTX; const int seq0 = lat ? MCTX + b * LLAT : b * LCTX;
        const int p = row - seq0, n = p / CH, i = p % CH, crow0 = row - i;
        const float lgf = log_gamma(F, 0, h), lgb = log_gamma(F, 1, h);
        if (tid < 256) qs[tid] = bf2f(F.Q[(size_t)row * DQK + h * DK + tid]);
        __syncthreads();
        if (tid < 256) {
            const int j = tid; const bf16* kr = F.K + (size_t)(crow0 + j) * DQK + h * DK; float s = 0.f;
            for (int d = 0; d < DK; d += 8) { const v4u kv = *(const v4u*)(kr + d);
                s += qs[d] * bf2f((unsigned short)kv.x) + qs[d + 1] * bf2f((unsigned short)(kv.x >> 16)) + qs[d + 2] * bf2f((unsigned short)kv.y) + qs[d + 3] * bf2f((unsigned short)(kv.y >> 16))
                   + qs[d + 4] * bf2f((unsigned short)kv.z) + qs[d + 5] * bf2f((unsigned short)(kv.z >> 16)) + qs[d + 6] * bf2f((unsigned short)kv.w) + qs[d + 7] * bf2f((unsigned short)(kv.w >> 16)); }
            const int dj = i - j; const float dec = dj >= 0 ? expf(lgf * (float)dj) : expf(lgb * (float)(-dj));
            Ps[j] = bfr(s * dec);
        }
        __syncthreads();
        const int e = tid; float acc = 0.f;
        for (int j = 0; j < CH; ++j) acc += Ps[j] * bf2f(F.V[(size_t)(crow0 + j) * DRV + h * DV + e]);
        if (lat) {
            const bf16* sf = F.SP + sp_index(b, h, 0, n); const bf16* sb = F.SP + sp_index(b, h, 1, n);
            float af = 0.f, ab = 0.f;
            for (int d = 0; d < DK; ++d) { af += qs[d] * bf2f(sf[(size_t)d * DV + e]); ab += qs[d] * bf2f(sb[(size_t)d * DV + e]); }
            acc += expf(lgf * (float)(i + 1)) * af + expf(lgb * (float)(CH - i)) * ab;
        }
        float ss = wave_sum(acc * acc);
        if (F.lane == 0) red[F.wave] = ss;
        __syncthreads();
        ss = 0.f;
#pragma unroll
        for (int w = 0; w < NWAVES; ++w) ss += red[w];
        const float sc = 1.0f / sqrtf(ss * (1.0f / DV) + EPS);
        F.OG[(size_t)row * DRV + h * DV + e] = (bf16)f2bf(acc * sc * F.gn_w[h * DV + e]);
        __syncthreads();
    }
}


typedef float f32x16 __attribute__((ext_vector_type(16)));
typedef short s16x4 __attribute__((ext_vector_type(4)));
typedef short v4i16_t __attribute__((ext_vector_type(4)));
typedef float f32x2_t __attribute__((ext_vector_type(2))); typedef __bf16 bf16x2_t __attribute__((ext_vector_type(2)));
typedef LAS const char* lds_cptr;
#define MFMA32(a, b, c) __builtin_amdgcn_mfma_f32_32x32x16_bf16((a), (b), (c), 0, 0, 0)
__device__ __forceinline__ int crow(int reg, int hh) { return (reg & 3) + 8 * (reg >> 2) + 4 * hh; }
__device__ __forceinline__ s16x4 vtr(lds_cptr p) { return __builtin_bit_cast(s16x4, __builtin_amdgcn_ds_read_tr16_b64_v4i16((LAS v4i16_t*)p)); }
__device__ __forceinline__ unsigned cvtpk(float lo, float hi) { f32x2_t v = {lo, hi}; bf16x2_t b = __builtin_convertvector(v, bf16x2_t); return __builtin_bit_cast(unsigned, b); }
__device__ __forceinline__ bf16x8 cat8(s16x4 lo, s16x4 hi) { return (bf16x8){lo[0], lo[1], lo[2], lo[3], hi[0], hi[1], hi[2], hi[3]}; }
__device__ __forceinline__ float ulo(unsigned w) { return __builtin_bit_cast(float, w << 16); }
__device__ __forceinline__ float uhi(unsigned w) { return __builtin_bit_cast(float, w & 0xffff0000u); }

constexpr int EQ = 128, NET = EQ / 32;
constexpr int KSTR = 528;
constexpr int KTSTR = 576;
constexpr int VSTR = 320;
constexpr int R3_KB0 = 0, R3_KB1 = 32 * KSTR, R3_VB0 = 2 * 32 * KSTR, R3_VB1 = R3_VB0 + 32 * VSTR;
constexpr int R12_KB0 = 0, R12_KB1 = 32 * KTSTR, R12_VB0 = 2 * 32 * KTSTR, R12_VB1 = R12_VB0 + 32 * VSTR;

__device__ __forceinline__ void r3f_item(Frame& F, int it) {
    bool lat; int b, n, h, eq;
    if (it < NLAT * NCH_LAT * NH * 4) { lat = true; eq = it & 3; h = (it >> 2) & 3; n = (it >> 4) & 7; b = it >> 7; }
    else { const int i2 = it - NLAT * NCH_LAT * NH * 4; lat = false; eq = i2 & 3; h = (i2 >> 2) & 3; n = 0; b = i2 >> 4; }
    const int seq0 = lat ? MCTX + b * LLAT : b * LCTX, row0 = seq0 + n * CH;
    const int tid = F.tid, lane = F.lane, w = F.wave, r32 = lane & 31, hh = lane >> 5;
    const float lgf = log_gamma(F, 0, h), lgb = log_gamma(F, 1, h);
    LAS char* lds = (LAS char*)F.lds;
    bf16x8 qf[16];
    { const bf16* qp = F.Q + (size_t)(row0 + 32 * w + r32) * DQK + h * DK + 8 * hh;
#pragma unroll
      for (int ks = 0; ks < 16; ++ks) qf[ks] = *(const bf16x8*)(qp + 16 * ks); }
    f32x16 acc[NET];
#pragma unroll
    for (int et = 0; et < NET; ++et)
#pragma unroll
        for (int r = 0; r < 16; ++r) acc[et][r] = 0.f;
    const int vrow = tid >> 4, vch = tid & 15;
    const int blk = (lane >> 4) & 1, q4 = (lane & 15) >> 2, p4 = lane & 3;
    const int trn = (8 * hh + q4) * VSTR + 32 * blk + 8 * p4;
    const int trp = (4 * hh + q4) * VSTR + 32 * blk + 8 * p4;
    if (lat) {
#pragma unroll 1
        for (int dir = 0; dir < 2; ++dir) {
            const bf16* sp = F.SP + sp_index(b, h, dir, n) + eq * EQ;
            { const v4u v = *(const v4u*)(sp + (size_t)vrow * DV + vch * 8); *(LAS v4u*)(lds + R3_VB0 + vrow * VSTR + vch * 16) = v; }
            __syncthreads();
#pragma unroll
            for (int db = 0; db < 8; ++db) {
                v4u nv = {0u, 0u, 0u, 0u};
                if (db < 7) nv = *(const v4u*)(sp + (size_t)(32 * (db + 1) + vrow) * DV + vch * 8);
                lds_cptr vb = lds + ((db & 1) ? R3_VB1 : R3_VB0);
#pragma unroll
                for (int ks2 = 0; ks2 < 2; ++ks2)
#pragma unroll
                    for (int et = 0; et < NET; ++et) {
                        const s16x4 lo = vtr(vb + trn + (16 * ks2) * VSTR + 64 * et), hi = vtr(vb + trn + (16 * ks2 + 4) * VSTR + 64 * et);
                        acc[et] = MFMA32(qf[2 * db + ks2], cat8(lo, hi), acc[et]);
                    }
                if (db < 7) *(LAS v4u*)(lds + ((db & 1) ? R3_VB0 : R3_VB1) + vrow * VSTR + vch * 16) = nv;
                __syncthreads();
            }
#pragma unroll
            for (int r = 0; r < 16; ++r) {
                const float i = (float)(32 * w + crow(r, hh));
                const float f = dir == 0 ? __expf(lgf * (i + 1.0f) - lgb * (256.0f - i)) : __expf(lgb * (256.0f - i));
#pragma unroll
                for (int et = 0; et < NET; ++et) acc[et][r] *= f;
            }
        }
    }
    {
        const bf16* kp = F.K + (size_t)row0 * DQK + h * DK; const bf16* vp = F.V + (size_t)row0 * DRV + h * DV + eq * EQ;
        const int krow0 = tid >> 5, kch = tid & 31;
        { const v4u k0 = *(const v4u*)(kp + (size_t)krow0 * DQK + kch * 8), k1 = *(const v4u*)(kp + (size_t)(krow0 + 16) * DQK + kch * 8);
          const v4u v0 = *(const v4u*)(vp + (size_t)vrow * DRV + vch * 8);
          *(LAS v4u*)(lds + R3_KB0 + krow0 * KSTR + kch * 16) = k0; *(LAS v4u*)(lds + R3_KB0 + (krow0 + 16) * KSTR + kch * 16) = k1;
          *(LAS v4u*)(lds + R3_VB0 + vrow * VSTR + vch * 16) = v0; }
        __syncthreads();
#pragma unroll 1
        for (int jb = 0; jb < 8; ++jb) {
            const int cur = jb & 1;
            v4u k0 = {0u, 0u, 0u, 0u}, k1 = k0, v0 = k0;
            if (jb < 7) { const size_t r1 = (size_t)(32 * (jb + 1));
                k0 = *(const v4u*)(kp + (r1 + krow0) * DQK + kch * 8); k1 = *(const v4u*)(kp + (r1 + krow0 + 16) * DQK + kch * 8);
                v0 = *(const v4u*)(vp + (r1 + vrow) * DRV + vch * 8); }
            lds_cptr kb = lds + (cur ? R3_KB1 : R3_KB0) + r32 * KSTR + 16 * hh;
            lds_cptr vb = lds + (cur ? R3_VB1 : R3_VB0);
            f32x16 X;
#pragma unroll
            for (int r = 0; r < 16; ++r) X[r] = 0.f;
#pragma unroll
            for (int ks = 0; ks < 16; ++ks) { const bf16x8 a = *(const LAS bf16x8*)(kb + 32 * ks); X = MFMA32(a, qf[ks], X); }
            const int qi = 32 * w + r32;
#pragma unroll
            for (int r = 0; r < 16; ++r) { const int dj = qi - (32 * jb + crow(r, hh)); X[r] *= dj >= 0 ? __expf(lgf * (float)dj) : __expf(-lgb * (float)dj); }
            bf16x8 pa[2];
#pragma unroll
            for (int s2 = 0; s2 < 2; ++s2) { const unsigned u0 = cvtpk(X[8 * s2], X[8 * s2 + 1]), u1 = cvtpk(X[8 * s2 + 2], X[8 * s2 + 3]), u2 = cvtpk(X[8 * s2 + 4], X[8 * s2 + 5]), u3 = cvtpk(X[8 * s2 + 6], X[8 * s2 + 7]);
                pa[s2] = __builtin_bit_cast(bf16x8, (v4u){u0, u1, u2, u3}); }
#pragma unroll
            for (int s2 = 0; s2 < 2; ++s2)
#pragma unroll
                for (int et = 0; et < NET; ++et) {
                    const s16x4 lo = vtr(vb + trp + (16 * s2) * VSTR + 64 * et), hi = vtr(vb + trp + (16 * s2 + 8) * VSTR + 64 * et);
                    acc[et] = MFMA32(pa[s2], cat8(lo, hi), acc[et]);
                }
            if (jb < 7) { LAS char* kn = lds + (cur ? R3_KB0 : R3_KB1); LAS char* vn = lds + (cur ? R3_VB0 : R3_VB1);
                *(LAS v4u*)(kn + krow0 * KSTR + kch * 16) = k0; *(LAS v4u*)(kn + (krow0 + 16) * KSTR + kch * 16) = k1; *(LAS v4u*)(vn + vrow * VSTR + vch * 16) = v0; }
            __syncthreads();
        }
    }
#pragma unroll
    for (int r = 0; r < 16; ++r) {
        float ss = 0.f;
#pragma unroll
        for (int et = 0; et < NET; ++et) ss += acc[et][r] * acc[et][r];
#pragma unroll
        for (int o = 1; o < 32; o <<= 1) ss += __shfl_xor(ss, o);
        const int row = row0 + 32 * w + crow(r, hh);
        if (r32 == 0) F.SS[((size_t)row * NH + h) * 4 + eq] = ss;
        bf16* op = F.OG + (size_t)row * DRV + h * DV + eq * EQ + r32;
#pragma unroll
        for (int et = 0; et < NET; ++et) op[32 * et] = (bf16)f2bf(acc[et][r]);
    }
}
__device__ __forceinline__ void phase_r3f(Frame& F) {
    for (int it = F.wg; it < (NLAT * NCH_LAT + NCTX) * NH * 4; it += F.G) r3f_item(F, it);
}

__device__ __forceinline__ void r12f_item(Frame& F, int it) {
    bool lat; int b, h, dir, eq;
    if (it < NLAT * NH * 2 * 4) { lat = true; eq = it & 3; dir = (it >> 2) & 1; h = (it >> 3) & 3; b = it >> 5; }
    else { const int i2 = it - NLAT * NH * 2 * 4; lat = false; eq = i2 & 3; dir = (i2 >> 2) & 1; h = (i2 >> 3) & 3; b = i2 >> 5; }
    const int seq0 = lat ? MCTX + b * LLAT : b * LCTX;
    const int tid = F.tid, lane = F.lane, w = F.wave, r32 = lane & 31, hh = lane >> 5;
    const float lg = log_gamma(F, dir, h);
    LAS char* lds = (LAS char*)F.lds;
    f32x16 acc[NET];
    if (lat) {
        const float* s0 = F.state_ret + ((size_t)((b * 2 + dir) * NH + h) * DK) * DV + eq * EQ + r32;
#pragma unroll
        for (int et = 0; et < NET; ++et)
#pragma unroll
            for (int r = 0; r < 16; ++r) acc[et][r] = s0[(size_t)(32 * w + crow(r, hh)) * DV + 32 * et];
    } else {
#pragma unroll
        for (int et = 0; et < NET; ++et)
#pragma unroll
            for (int r = 0; r < 16; ++r) acc[et][r] = 0.f;
    }
    const int nproc = lat ? NCH_LAT - 1 : 1;
    const int nblocks = nproc * 8;
    const int vrow = tid >> 4, vch = tid & 15, krow0 = tid >> 5, kch = tid & 31;
    const int blk = (lane >> 4) & 1, q4 = (lane & 15) >> 2, p4 = lane & 3;
    const int tra = (8 * hh + q4) * KTSTR + 64 * w + 32 * blk + 8 * p4;
    const int trb = (8 * hh + q4) * VSTR + 32 * blk + 8 * p4;
    const bf16* kp = F.K + (size_t)seq0 * DQK + h * DK; const bf16* vp = F.V + (size_t)seq0 * DRV + h * DV + eq * EQ;
    const float g256 = __expf(lg * 256.0f);
    const int nch = lat ? NCH_LAT : 1;
    v4u k0, k1, v0;
#define R12_LOAD(t) do { const int cn_ = (t) >> 3, tb_ = (t) & 7, n_ = dir ? nch - 1 - cn_ : cn_; const size_t r_ = (size_t)(n_ * CH + 32 * tb_); \
        k0 = *(const v4u*)(kp + (r_ + krow0) * DQK + kch * 8); k1 = *(const v4u*)(kp + (r_ + krow0 + 16) * DQK + kch * 8); \
        const v4u vv_ = *(const v4u*)(vp + (r_ + vrow) * DRV + vch * 8); const int pos_ = 32 * tb_ + vrow; \
        const float dec_ = __expf(lg * (float)(dir ? pos_ : 255 - pos_)); \
        v0.x = cvtpk(ulo(vv_.x) * dec_, uhi(vv_.x) * dec_); v0.y = cvtpk(ulo(vv_.y) * dec_, uhi(vv_.y) * dec_); v0.z = cvtpk(ulo(vv_.z) * dec_, uhi(vv_.z) * dec_); v0.w = cvtpk(ulo(vv_.w) * dec_, uhi(vv_.w) * dec_); } while (0)
#define R12_STORE(buf) do { LAS char* kn_ = lds + ((buf) ? R12_KB1 : R12_KB0); LAS char* vn_ = lds + ((buf) ? R12_VB1 : R12_VB0); \
        *(LAS v4u*)(kn_ + krow0 * KTSTR + kch * 16) = k0; *(LAS v4u*)(kn_ + (krow0 + 16) * KTSTR + kch * 16) = k1; *(LAS v4u*)(vn_ + vrow * VSTR + vch * 16) = v0; } while (0)
    R12_LOAD(0); R12_STORE(0);
    __syncthreads();
#pragma unroll 1
    for (int t = 0; t < nblocks; ++t) {
        const int cur = t & 1;
        if ((t & 7) == 0) {
            if (lat) {
                const int cn = t >> 3, n = dir ? nch - 1 - cn : cn;
                bf16* sp = F.SP + sp_index(b, h, dir, n) + eq * EQ + r32;
#pragma unroll
                for (int et = 0; et < NET; ++et)
#pragma unroll
                    for (int r = 0; r < 16; ++r) sp[(size_t)(32 * w + crow(r, hh)) * DV + 32 * et] = (bf16)f2bf(acc[et][r]);
            }
#pragma unroll
            for (int et = 0; et < NET; ++et)
#pragma unroll
                for (int r = 0; r < 16; ++r) acc[et][r] *= g256;
        }
        if (t + 1 < nblocks) R12_LOAD(t + 1);
        lds_cptr kb = lds + (cur ? R12_KB1 : R12_KB0), vb = lds + (cur ? R12_VB1 : R12_VB0);
#pragma unroll
        for (int ks2 = 0; ks2 < 2; ++ks2) {
            const bf16x8 a = cat8(vtr(kb + tra + (16 * ks2) * KTSTR), vtr(kb + tra + (16 * ks2 + 4) * KTSTR));
#pragma unroll
            for (int et = 0; et < NET; ++et) {
                const bf16x8 bb = cat8(vtr(vb + trb + (16 * ks2) * VSTR + 64 * et), vtr(vb + trb + (16 * ks2 + 4) * VSTR + 64 * et));
                acc[et] = MFMA32(a, bb, acc[et]);
            }
        }
        if (t + 1 < nblocks) R12_STORE(cur ^ 1);
        __syncthreads();
    }
#undef R12_LOAD
#undef R12_STORE
    if (lat) {
        const int n = dir ? 0 : nch - 1;
        bf16* sp = F.SP + sp_index(b, h, dir, n) + eq * EQ + r32;
#pragma unroll
        for (int et = 0; et < NET; ++et)
#pragma unroll
            for (int r = 0; r < 16; ++r) sp[(size_t)(32 * w + crow(r, hh)) * DV + 32 * et] = (bf16)f2bf(acc[et][r]);
    } else {
        float* op = F.out + OUT_NSR + ((size_t)((b * 2 + dir) * NH + h) * DK) * DV + eq * EQ + r32;
#pragma unroll
        for (int et = 0; et < NET; ++et)
#pragma unroll
            for (int r = 0; r < 16; ++r) op[(size_t)(32 * w + crow(r, hh)) * DV + 32 * et] = acc[et][r];
    }
}
__device__ __forceinline__ void phase_r12f(Frame& F) {
    constexpr int NLI = NLAT * NH * 2 * 4, NCI = NCTX * NH * 2 * 4;
    if (F.G == 256) {
        if (F.wg < NLI) r12f_item(F, F.wg);
        else { for (int j = 0; j < 4; ++j) r12f_item(F, NLI + (F.wg - NLI) * 4 + j); }
    } else {
        for (int it = F.wg; it < NLI + NCI; it += F.G) r12f_item(F, it);
    }
}


constexpr int XSTR = 272, LRU_XCB = 0, LRU_AS = 64 * XSTR, LRU_BS = LRU_AS + 32768, LRU_HF = LRU_BS + 32768;
__device__ __forceinline__ void lruf_item(Frame& F, int T, int hb, bool fin) {
    const int row0 = 64 * T, tid = F.tid, lane = F.lane, w = F.wave, r32 = lane & 31, hh = lane >> 5;
    int b, seq0, L; bool lat;
    if (row0 < MCTX) { b = row0 / LCTX; seq0 = b * LCTX; L = LCTX; lat = false; } else { b = (row0 - MCTX) / LLAT; seq0 = MCTX + b * LLAT; L = LLAT; lat = true; }
    const int p0 = row0 - seq0, ti = p0 / 64, ntile = L / 64;
    LAS char* lds = (LAS char*)F.lds;
    LAS float* a_s = (LAS float*)(lds + LRU_AS); LAS float* b_s = (LAS float*)(lds + LRU_BS); LAS float* hf_s = (LAS float*)(lds + LRU_HF);
    LAS float* segp = (LAS float*)(lds + LRU_HF + 32768); LAS float* segh = segp + 512; LAS float* carry_s = segh + 512;
    if (fin && tid < 256) {
        const int d2 = tid >> 7, cc = tid & 127, chh = hb * 128 + cc;
        float carry = lat ? F.state_lru[(size_t)(b * 2 + d2) * DL + chh] : 0.f;
        if (d2 == 0) { for (int n = 0; n < ti; ++n) { const float* ag = F.AGG + ((size_t)((T - ti + n) * 2 + 0) * 2) * DL; carry = ag[chh] * carry + ag[DL + chh]; } }
        else { for (int n = ntile - 1; n > ti; --n) { const float* ag = F.AGG + ((size_t)((T - ti + n) * 2 + 1) * 2) * DL; carry = ag[chh] * carry + ag[DL + chh]; } }
        carry_s[tid] = carry;
    }
#pragma unroll
    for (int pp = 0; pp < 2; ++pp) {
        const int piece = tid + 512 * pp, t = piece >> 4, c8 = piece & 15, ch0 = hb * 128 + 8 * c8;
        f32x4 x0 = *(const f32x4*)(F.conv_b + ch0), x1 = *(const f32x4*)(F.conv_b + ch0 + 4);
#pragma unroll
        for (int tap = 0; tap < 4; ++tap) {
            const int tt = t + tap - 2; bool ok;
            if (lat) ok = (tt >= 0 && tt < 64); else { const int p = p0 + tt; ok = (p >= 0 && p < L); }
            if (ok) {
                const v4u raw = *(const v4u*)(F.XL + (size_t)(row0 + tt) * DL + ch0);
                const f32x4 w0 = *(const f32x4*)(F.conv_w + tap * DL + ch0), w1 = *(const f32x4*)(F.conv_w + tap * DL + ch0 + 4);
                x0[0] += w0[0] * ulo(raw.x); x0[1] += w0[1] * uhi(raw.x); x0[2] += w0[2] * ulo(raw.y); x0[3] += w0[3] * uhi(raw.y);
                x1[0] += w1[0] * ulo(raw.z); x1[1] += w1[1] * uhi(raw.z); x1[2] += w1[2] * ulo(raw.w); x1[3] += w1[3] * uhi(raw.w);
            }
        }
        v4u o; o.x = cvtpk(x0[0], x0[1]); o.y = cvtpk(x0[2], x0[3]); o.z = cvtpk(x1[0], x1[1]); o.w = cvtpk(x1[2], x1[3]);
        *(LAS v4u*)(lds + LRU_XCB + t * XSTR + c8 * 16) = o;
    }
    __syncthreads();
    const int rt = w >> 2, cg = w & 3, c = 32 * cg + r32, ch = hb * 128 + c;
#pragma unroll 1
    for (int dir = 0; dir < 2; ++dir) {
        f32x16 acc0, acc1;
#pragma unroll
        for (int r = 0; r < 16; ++r) { acc0[r] = 0.f; acc1[r] = 0.f; }
        const bf16* wb = F.WlruT + (size_t)hb * 512 * LB + (size_t)((2 * dir) * 128 + c) * LB + 8 * hh;
        lds_cptr xa = lds + LRU_XCB + (32 * rt + r32) * XSTR + 16 * hh;
#pragma unroll
        for (int ks = 0; ks < 8; ++ks) {
            const bf16x8 a = *(const LAS bf16x8*)(xa + 32 * ks);
            const bf16x8 b0 = *(const bf16x8*)(wb + 16 * ks), b1 = *(const bf16x8*)(wb + 128 * LB + 16 * ks);
            acc0 = MFMA32(a, b0, acc0); acc1 = MFMA32(a, b1, acc1);
        }
        const float ba = F.lru_ba[dir * DL + ch], bx = F.lru_bx[dir * DL + ch];
        const float sp = log1pf(expf(-F.lru_a[dir * DL + ch]));
#pragma unroll
        for (int r = 0; r < 16; ++r) {
            const int tok = 32 * rt + crow(r, hh);
            const float rr = __builtin_amdgcn_rcpf(1.0f + __expf(-(acc0[r] + ba))), gi = __builtin_amdgcn_rcpf(1.0f + __expf(-(acc1[r] + bx)));
            const float la = -8.0f * rr * sp, x2 = 2.0f * la;
            const float xv = bf2f(*(const LAS bf16*)(lds + LRU_XCB + tok * XSTR + c * 2));
            const float pl = -x2 * (1.0f + x2 * 0.5f * (1.0f + x2 * (1.0f / 3.0f) * (1.0f + x2 * 0.25f * (1.0f + x2 * 0.2f * (1.0f + x2 * (1.0f / 6.0f) * (1.0f + x2 * (1.0f / 7.0f)))))));
            const float em = x2 > -0.25f ? pl : 1.0f - __expf(x2);
            a_s[tok * 128 + c] = __expf(la);
            b_s[tok * 128 + c] = sqrtf(em) * gi * xv;
        }
        __syncthreads();
        {
            const int seg = tid >> 7, cc = tid & 127, chh = hb * 128 + cc;
            const int tb = dir == 0 ? 16 * seg : 16 * seg + 15, ts = dir == 0 ? 1 : -1;
            float av[16], bv[16];
#pragma unroll
            for (int k = 0; k < 16; ++k) { const int t = tb + ts * k; av[k] = a_s[t * 128 + cc]; bv[k] = b_s[t * 128 + cc]; }
            float h = 0.f, pr = 1.f;
#pragma unroll
            for (int k = 0; k < 16; ++k) { h = av[k] * h + bv[k]; pr *= av[k]; bv[k] = h; av[k] = pr; }
            segp[seg * 128 + cc] = pr; segh[seg * 128 + cc] = h;
            __syncthreads();
            float cin = fin ? carry_s[dir * 128 + cc] : 0.f;
            if (dir == 0) { for (int s2 = 0; s2 < seg; ++s2) cin = segp[s2 * 128 + cc] * cin + segh[s2 * 128 + cc]; }
            else { for (int s2 = 3; s2 > seg; --s2) cin = segp[s2 * 128 + cc] * cin + segh[s2 * 128 + cc]; }
            if (fin) {
#pragma unroll
                for (int k = 0; k < 16; ++k) { const int t = tb + ts * k; const float hv = bv[k] + av[k] * cin;
                    if (dir == 0) hf_s[t * 128 + cc] = hv; else hf_s[t * 128 + cc] += hv; }
            }
            const bool lastseg = dir == 0 ? seg == 3 : seg == 0;
            if (lastseg) {
                const float hend = bv[15] + av[15] * cin;
                if (!fin) { float* ag = F.AGG + ((size_t)(T * 2 + dir) * 2) * DL; ag[chh] = (segp[cc] * segp[128 + cc]) * (segp[256 + cc] * segp[384 + cc]); ag[DL + chh] = hend; }
                else if (!lat && (dir == 0 ? ti == ntile - 1 : ti == 0)) F.out[OUT_NSL + (size_t)(b * 2 + dir) * DL + chh] = hend;
            }
        }
        __syncthreads();
    }
    if (fin) {
#pragma unroll
        for (int pp = 0; pp < 2; ++pp) {
            const int piece = tid + 512 * pp, t = piece >> 4, c8 = piece & 15; const size_t o = (size_t)(row0 + t) * DL + hb * 128 + 8 * c8;
            const v4u g = *(const v4u*)(F.GL + o); const LAS float* hp = hf_s + t * 128 + 8 * c8;
            const f32x4 h0 = *(const LAS f32x4*)hp, h1 = *(const LAS f32x4*)(hp + 4);
            v4u r; r.x = cvtpk(h0[0] * ulo(g.x), h0[1] * uhi(g.x)); r.y = cvtpk(h0[2] * ulo(g.y), h0[3] * uhi(g.y)); r.z = cvtpk(h1[0] * ulo(g.z), h1[1] * uhi(g.z)); r.w = cvtpk(h1[2] * ulo(g.w), h1[3] * uhi(g.w));
            *(v4u*)(F.HL + o) = r;
        }
    }
    __syncthreads();
}
__device__ __forceinline__ void phase_lruf(Frame& F, bool fin) {
    for (int it = F.wg; it < (M / 64) * NB; it += F.G) lruf_item(F, it / NB, it % NB, fin);
}


constexpr int LW_XCB = 0, LW_HF0 = 64 * XSTR, LW_HF1 = LW_HF0 + 32768;
__device__ __forceinline__ void lruw_item(Frame& F, int T, int hb, bool fin) {
    const int row0 = 64 * T, tid = F.tid, lane = F.lane, w = F.wave, r32 = lane & 31, hh = lane >> 5;
    int b, seq0, L; bool lat;
    if (row0 < MCTX) { b = row0 / LCTX; seq0 = b * LCTX; L = LCTX; lat = false; } else { b = (row0 - MCTX) / LLAT; seq0 = MCTX + b * LLAT; L = LLAT; lat = true; }
    const int p0 = row0 - seq0, ti = p0 / 64, ntile = L / 64;
    LAS char* lds = (LAS char*)F.lds;
    const int dir = w >> 2, cg = w & 3, c = 32 * cg + r32, ch = hb * 128 + c;
    const float ba = F.lru_ba[dir * DL + ch], bx = F.lru_bx[dir * DL + ch], ap = F.lru_a[dir * DL + ch];
    bf16x8 bfr[2][8];
    { const bf16* wb = F.WlruT + (size_t)hb * 512 * LB + (size_t)((2 * dir) * 128 + c) * LB + 8 * hh;
#pragma unroll
      for (int ks = 0; ks < 8; ++ks) { bfr[0][ks] = *(const bf16x8*)(wb + 16 * ks); bfr[1][ks] = *(const bf16x8*)(wb + 128 * LB + 16 * ks); } }
    float carry = 0.f;
    if (fin) {
        carry = lat ? F.state_lru[(size_t)(b * 2 + dir) * DL + ch] : 0.f;
        const int cnt = dir == 0 ? ti : ntile - 1 - ti;
        const int tstart = dir == 0 ? T - ti : T - ti + ntile - 1, tstep = dir == 0 ? 1 : -1;
        for (int n0 = 0; n0 < cnt; n0 += 8) {
            float pa[8], ha[8];
#pragma unroll
            for (int u = 0; u < 8; ++u) { const int nn = n0 + u < cnt ? n0 + u : cnt - 1; const float* ag = F.AGG + ((size_t)((tstart + tstep * nn) * 2 + dir) * 2) * DL; pa[u] = ag[ch]; ha[u] = ag[DL + ch]; }
#pragma unroll
            for (int u = 0; u < 8; ++u) if (n0 + u < cnt) carry = pa[u] * carry + ha[u];
        }
    }
#pragma unroll
    for (int pp = 0; pp < 2; ++pp) {
        const int piece = tid + 512 * pp, t = piece >> 4, c8 = piece & 15, ch0 = hb * 128 + 8 * c8;
        f32x4 x0 = *(const f32x4*)(F.conv_b + ch0), x1 = *(const f32x4*)(F.conv_b + ch0 + 4);
#pragma unroll
        for (int tap = 0; tap < 4; ++tap) {
            const int tt = t + tap - 2; bool ok;
            if (lat) ok = (tt >= 0 && tt < 64); else { const int p = p0 + tt; ok = (p >= 0 && p < L); }
            if (ok) {
                const v4u raw = *(const v4u*)(F.XL + (size_t)(row0 + tt) * DL + ch0);
                const f32x4 w0 = *(const f32x4*)(F.conv_w + tap * DL + ch0), w1 = *(const f32x4*)(F.conv_w + tap * DL + ch0 + 4);
                x0[0] += w0[0] * ulo(raw.x); x0[1] += w0[1] * uhi(raw.x); x0[2] += w0[2] * ulo(raw.y); x0[3] += w0[3] * uhi(raw.y);
                x1[0] += w1[0] * ulo(raw.z); x1[1] += w1[1] * uhi(raw.z); x1[2] += w1[2] * ulo(raw.w); x1[3] += w1[3] * uhi(raw.w);
            }
        }
        v4u o; o.x = cvtpk(x0[0], x0[1]); o.y = cvtpk(x0[2], x0[3]); o.z = cvtpk(x1[0], x1[1]); o.w = cvtpk(x1[2], x1[3]);
        *(LAS v4u*)(lds + LW_XCB + t * XSTR + c8 * 16) = o;
    }
    __syncthreads();
    float a[8][4], bq[8][4];
    {
        const float sp = log1pf(__expf(-ap));
#pragma unroll
        for (int rt = 0; rt < 2; ++rt) {
            f32x16 acc0, acc1;
#pragma unroll
            for (int r = 0; r < 16; ++r) { acc0[r] = 0.f; acc1[r] = 0.f; }
            lds_cptr xa = lds + LW_XCB + (32 * rt + r32) * XSTR + 16 * hh;
#pragma unroll
            for (int ks = 0; ks < 8; ++ks) { const bf16x8 av = *(const LAS bf16x8*)(xa + 32 * ks); acc0 = MFMA32(av, bfr[0][ks], acc0); acc1 = MFMA32(av, bfr[1][ks], acc1); }
#pragma unroll
            for (int r = 0; r < 16; ++r) {
                const int tok = 32 * rt + crow(r, hh);
                const float rr = __builtin_amdgcn_rcpf(1.0f + __expf(-(acc0[r] + ba))), gi = __builtin_amdgcn_rcpf(1.0f + __expf(-(acc1[r] + bx)));
                const float la = -8.0f * rr * sp, x2 = 2.0f * la;
                const float xv = bf2f(*(const LAS bf16*)(lds + LW_XCB + tok * XSTR + c * 2));
                const float pl = -x2 * (1.0f + x2 * 0.5f * (1.0f + x2 * (1.0f / 3.0f) * (1.0f + x2 * 0.25f * (1.0f + x2 * 0.2f * (1.0f + x2 * (1.0f / 6.0f) * (1.0f + x2 * (1.0f / 7.0f)))))));
                const float em = x2 > -0.25f ? pl : 1.0f - __expf(x2);
                a[rt * 4 + (r >> 2)][r & 3] = __expf(la);
                bq[rt * 4 + (r >> 2)][r & 3] = sqrtf(em) * gi * xv;
            }
        }
    }
    float PR[8], HR[8], PQ[8], HQ[8], ci[8];
    float cin = carry, ptile = 1.f;
    if (dir == 0) {
#pragma unroll
        for (int u = 0; u < 8; ++u) { float h = 0.f, pr = 1.f;
#pragma unroll
            for (int j = 0; j < 4; ++j) { h = a[u][j] * h + bq[u][j]; pr *= a[u][j]; bq[u][j] = h; a[u][j] = pr; }
            PR[u] = pr; HR[u] = h; }
#pragma unroll
        for (int u = 0; u < 8; ++u) { PQ[u] = __shfl_xor(PR[u], 32); HQ[u] = __shfl_xor(HR[u], 32); }
#pragma unroll
        for (int R = 0; R < 16; ++R) { const int u = R >> 1; const bool mine = (R & 1) == hh; const float pp = mine ? PR[u] : PQ[u], hq = mine ? HR[u] : HQ[u];
            ci[u] = mine ? cin : ci[u]; cin = pp * cin + hq; ptile *= pp; }
    } else {
#pragma unroll
        for (int u = 0; u < 8; ++u) { float h = 0.f, pr = 1.f;
#pragma unroll
            for (int j = 3; j >= 0; --j) { h = a[u][j] * h + bq[u][j]; pr *= a[u][j]; bq[u][j] = h; a[u][j] = pr; }
            PR[u] = pr; HR[u] = h; }
#pragma unroll
        for (int u = 0; u < 8; ++u) { PQ[u] = __shfl_xor(PR[u], 32); HQ[u] = __shfl_xor(HR[u], 32); }
#pragma unroll
        for (int R = 15; R >= 0; --R) { const int u = R >> 1; const bool mine = (R & 1) == hh; const float pp = mine ? PR[u] : PQ[u], hq = mine ? HR[u] : HQ[u];
            ci[u] = mine ? cin : ci[u]; cin = pp * cin + hq; ptile *= pp; }
    }
    if (!fin) {
        if (hh == 0) { float* ag = F.AGG + ((size_t)(T * 2 + dir) * 2) * DL; ag[ch] = ptile; ag[DL + ch] = cin; }
    } else {
        LAS float* hf = (LAS float*)(lds + (dir ? LW_HF1 : LW_HF0));
#pragma unroll
        for (int u = 0; u < 8; ++u)
#pragma unroll
            for (int j = 0; j < 4; ++j) hf[(4 * (2 * u + hh) + j) * 128 + c] = bq[u][j] + a[u][j] * ci[u];
        if (hh == 0 && !lat && (dir == 0 ? ti == ntile - 1 : ti == 0)) F.out[OUT_NSL + (size_t)(b * 2 + dir) * DL + ch] = cin;
        __syncthreads();
#pragma unroll
        for (int pp = 0; pp < 2; ++pp) {
            const int piece = tid + 512 * pp, t = piece >> 4, c8 = piece & 15; const size_t o = (size_t)(row0 + t) * DL + hb * 128 + 8 * c8;
            const v4u g = *(const v4u*)(F.GL + o); const LAS float* h0p = (const LAS float*)(lds + LW_HF0) + t * 128 + 8 * c8; const LAS float* h1p = (const LAS float*)(lds + LW_HF1) + t * 128 + 8 * c8;
            const f32x4 h0 = *(const LAS f32x4*)h0p + *(const LAS f32x4*)h1p, h1 = *(const LAS f32x4*)(h0p + 4) + *(const LAS f32x4*)(h1p + 4);
            v4u r; r.x = cvtpk(h0[0] * ulo(g.x), h0[1] * uhi(g.x)); r.y = cvtpk(h0[2] * ulo(g.y), h0[3] * uhi(g.y)); r.z = cvtpk(h1[0] * ulo(g.z), h1[1] * uhi(g.z)); r.w = cvtpk(h1[2] * ulo(g.w), h1[3] * uhi(g.w));
            *(v4u*)(F.HL + o) = r;
        }
    }
    if (!fin) __syncthreads();
}
__device__ __forceinline__ void phase_lruw(Frame& F, bool fin) {
    for (int it = F.wg; it < (M / 64) * NB; it += F.G) lruw_item(F, it / NB, it % NB, fin);
}

__device__ __forceinline__ void phase_norm(Frame& F) {
    const int gw = F.wg * NWAVES + F.wave, NGW = F.G * NWAVES;
    for (int m = gw; m < M; m += NGW) {
        f32x4* yr = (f32x4*)(F.out + OUT_Y + (size_t)m * D) + F.lane;
        f32x4 v[4]; float s = 0.f;
#pragma unroll
        for (int j = 0; j < 4; ++j) { v[j] = yr[64 * j]; s += (v[j].x * v[j].x + v[j].y * v[j].y) + (v[j].z * v[j].z + v[j].w * v[j].w); }
        const float rstd = 1.0f / sqrtf(wave_sum(s) * (1.f / D) + EPS);
#pragma unroll
        for (int j = 0; j < 4; ++j) { const f32x4 nw = *(const f32x4*)(F.final_norm_w + 4 * F.lane + 256 * j); yr[64 * j] = v[j] * rstd * nw; }
    }
}

__device__ __forceinline__ int opq(int x) { int r; asm volatile("s_mov_b32 %0, %1" : "=s"(r) : "s"(x)); return r; }
constexpr int PH_PREP = 0, PH_H = 1, PH_GEMM1 = 2, PH_LRUA = 3, PH_LRUB = 4, PH_R12 = 5, PH_R3 = 6, PH_G2 = 7, PH_DOWN = 8, PH_OUT = 9, PH_NORM = 10, N_PHASES = 11;

__global__ void __launch_bounds__(NTHR, 2) fwd_kernel(Args args) {
    extern __shared__ __attribute__((aligned(16))) unsigned char lds_raw[];
    Frame F;
    F.lds = (LAS unsigned char*)lds_raw;
    F.tid = threadIdx.x; F.lane = F.tid & 63; F.wave = __builtin_amdgcn_readfirstlane(F.tid >> 6);
    F.G = gridDim.x; F.wg = blockIdx.x;
    F.x_prompt = args.in[0]; F.x_sample = args.in[1]; F.state_ret = args.in[2]; F.state_lru = args.in[3]; F.c = args.in[4]; F.c_ctx = args.in[5];
    F.norm_w = args.in[6]; F.w_ada = args.in[7]; F.b_ada = args.in[8]; F.w_in = args.in[9]; F.decay_logit = args.in[10]; F.gn_w = args.in[11];
    F.w_ret_down = args.in[12]; F.conv_w = args.in[13]; F.conv_b = args.in[14]; F.lru_wa = args.in[15]; F.lru_ba = args.in[16]; F.lru_wx = args.in[17];
    F.lru_bx = args.in[18]; F.lru_a = args.in[19]; F.w_lru_down = args.in[20]; F.w_out = args.in[21]; F.final_norm_w = args.in[22];
    F.out = args.out; F.ws = args.ws;
    unsigned char* ws = args.ws;
    F.WinT = (bf16*)(ws + WS_WINT); F.WrdT = (bf16*)(ws + WS_WRDT); F.WldT = (bf16*)(ws + WS_WLDT); F.WoutT = (bf16*)(ws + WS_WOUTT); F.WlruT = (bf16*)(ws + WS_WLRUT);
    F.MOD = (float*)(ws + WS_MOD); F.MODP = (float*)(ws + WS_MODP); F.H = (bf16*)(ws + WS_H); F.Q = (bf16*)(ws + WS_Q); F.K = (bf16*)(ws + WS_K); F.V = (bf16*)(ws + WS_V);
    F.XL = (bf16*)(ws + WS_XL); F.GL = (bf16*)(ws + WS_GL); F.AGG = (float*)(ws + WS_AGG); F.SS = (float*)(ws + WS_SS); F.HL = (bf16*)(ws + WS_HL); F.SP = (bf16*)(ws + WS_SP);
    F.SIGR = (bf16*)(ws + WS_SIGR); F.SIGL = (bf16*)(ws + WS_SIGL); F.MERGED = (bf16*)(ws + WS_MERGED); F.OG = (bf16*)(args.out + OUT_Y);

    volatile LAS unsigned* MISC = (volatile LAS unsigned*)(F.lds + MISC_OFF);
    for (int u = F.tid; u < (LDS_BYTES - 131072) / 4; u += NTHR) ((LAS unsigned*)(F.lds + 131072))[u] = 0u;
    __syncthreads();
    const int lo = args.ph_lo, hi = args.ph_hi;
    XcdBarrier bar; bar.bar = (unsigned*)(ws + WS_CTL) + CW_BAR; bar.x = 0; bar.st = nullptr;
    if (hi - lo > 1) bar = xcd_barrier_post((unsigned*)(ws + WS_CTL) + CW_BAR, MISC + 8);
#define IN(k) (lo <= (k) && (k) < hi)
#define SEAM(k) do { if (IN(k) && IN((k) + 1)) xcd_barrier(bar); } while (0)

    if (IN(PH_PREP)) { for (int rp = 0; rp < args.rep[PH_PREP]; ++rp) { F.wg = opq(blockIdx.x); phase_prep(F); __syncthreads(); } SEAM(PH_PREP); }
    if (IN(PH_H)) { for (int rp = 0; rp < args.rep[PH_H]; ++rp) { F.wg = opq(blockIdx.x); phase_h(F); } SEAM(PH_H); }
    if (IN(PH_GEMM1)) for (int rp = 0; rp < args.rep[PH_GEMM1]; ++rp) { F.wg = opq(blockIdx.x); pg8::Gemm g{F.H, F.WinT, M, N1, D}; pg8::StaticOrder S; S.init(M, N1, F.G, F.wg); pg8::EpiG1 E{F.Q, F.K, F.V, F.XL, F.GL};
        pg8::gemm_phase<pg8::EpiG1, pg8::StaticOrder, true, true>(F.lds, g, S, E); } SEAM(PH_GEMM1);
    if (IN(PH_LRUA)) { for (int rp = 0; rp < args.rep[PH_LRUA]; ++rp) { F.wg = opq(blockIdx.x); phase_lruw(F, false); } SEAM(PH_LRUA); }
    if (IN(PH_LRUB)) { for (int rp = 0; rp < args.rep[PH_LRUB]; ++rp) { F.wg = opq(blockIdx.x); phase_lruw(F, true); } SEAM(PH_LRUB); }
    if (IN(PH_R12)) { for (int rp = 0; rp < args.rep[PH_R12]; ++rp) { F.wg = opq(blockIdx.x); phase_r12f(F); } SEAM(PH_R12); }
    if (IN(PH_R3)) { for (int rp = 0; rp < args.rep[PH_R3]; ++rp) { F.wg = opq(blockIdx.x); phase_r3f(F); } SEAM(PH_R3); }
    if (IN(PH_G2)) { pg8::Gemm g{F.H, F.WinT + (size_t)N1 * D, M, N2, D}; pg8::StaticOrder S; S.init(M, N2, F.G, F.wg); pg8::EpiG2 E{F.OG, F.SIGR, F.SIGL, F.SS, F.gn_w};
        pg8::gemm_phase<pg8::EpiG2, pg8::StaticOrder, true, true>(F.lds, g, S, E); SEAM(PH_G2); }
    if (IN(PH_DOWN)) { for (int rp = 0; rp < args.rep[PH_DOWN]; ++rp) { F.wg = opq(blockIdx.x);
        { pg8::Gemm g{F.OG, F.WrdT, M, D, DRV}; pg8::StaticOrder S; S.init(M, D, F.G, F.wg); pg8::EpiDown<false> E{F.MERGED, F.SIGR}; pg8::gemm_phase<pg8::EpiDown<false>, pg8::StaticOrder, true, true>(F.lds, g, S, E); }
        { pg8::Gemm g{F.HL, F.WldT, M, D, DL}; pg8::StaticOrder S; S.init(M, D, F.G, F.wg); pg8::EpiDown<true> E{F.MERGED, F.SIGL}; pg8::gemm_phase<pg8::EpiDown<true>, pg8::StaticOrder, true, true>(F.lds, g, S, E); } }
        SEAM(PH_DOWN);
    }
    if (IN(PH_OUT)) for (int rp = 0; rp < args.rep[PH_OUT]; ++rp) { F.wg = opq(blockIdx.x); pg8::Gemm g{F.MERGED, F.WoutT, M, D, D}; pg8::StaticOrder S; S.init(M, D, F.G, F.wg); pg8::EpiY E{F.out + OUT_Y, F.x_prompt, F.x_sample, F.MOD, MCTX, LLAT};
        pg8::gemm_phase<pg8::EpiY, pg8::StaticOrder, true, true>(F.lds, g, S, E); } SEAM(PH_OUT);
    if (IN(PH_NORM)) { phase_norm(F); }
#undef IN
#undef SEAM
}
}

extern "C" void kernel_launch(void* const* d_in, const int* in_sizes, int n_in, void* d_out, int out_size, void* d_ws, size_t ws_size, hipStream_t stream) {
    static int grid = 0;
    if (grid == 0) {
        if (n_in != 23 || (size_t)out_size != OUT_TOTAL || ws_size < WS_END) { fprintf(stderr, "kernel_launch: unexpected shapes n_in %d out %d ws %zu\n", n_in, out_size, ws_size); grid = -1; return; }
        int dev = 0, cus = 0;
        if (hipGetDevice(&dev) != hipSuccess || hipDeviceGetAttribute(&cus, hipDeviceAttributeMultiprocessorCount, dev) != hipSuccess) { grid = -1; return; }
        if (hipFuncSetAttribute((const void*)fwd_kernel, hipFuncAttributeMaxDynamicSharedMemorySize, LDS_BYTES) != hipSuccess) { fprintf(stderr, "kernel_launch: hipFuncSetAttribute failed\n"); grid = -1; return; }
        int per_cu = 0;
        (void)hipOccupancyMaxActiveBlocksPerMultiprocessor(&per_cu, (const void*)fwd_kernel, NTHR, LDS_BYTES);
        (void)hipGetLastError();
        grid = cus;
    }
    if (grid < 0) return;
    (void)hipMemsetAsync((char*)d_ws + WS_CTL, 0, CTL_ZERO_BYTES, stream);
    Args a{};
    for (int i = 0; i < 23; ++i) a.in[i] = (const float*)d_in[i];
    a.out = (float*)d_out; a.ws = (unsigned char*)d_ws;
    { static const int REP[12] = {PROBE_REP}; for (int i = 0; i < 12; ++i) a.rep[i] = REP[i]; }
#if MK_ONE_LAUNCH
    a.ph_lo = 0; a.ph_hi = N_PHASES;
    hipLaunchKernelGGL(fwd_kernel, dim3(grid), dim3(NTHR), LDS_BYTES, stream, a);
#else
    for (int p = 0; p < N_PHASES; ++p) { a.ph_lo = p; a.ph_hi = p + 1; hipLaunchKernelGGL(fwd_kernel, dim3(grid), dim3(NTHR), LDS_BYTES, stream, a); }
#endif
}
```

```cpp
#include <hip/hip_runtime.h>
#include <cstdint>
#include <cstdio>

#ifndef PROBE_REP
#define PROBE_REP 1,1,1,1,1,1,1,1,1,1,1,1
#endif
#ifndef MK_ONE_LAUNCH
#define MK_ONE_LAUNCH 1
#endif

namespace {
constexpr int D = 1024, NCTX = 16, LCTX = 256, NLAT = 4, LLAT = 2048;
constexpr int MCTX = NCTX * LCTX, MLAT = NLAT * LLAT, M = MCTX + MLAT;
constexpr int NH = 4, DK = 256, DV = 512, DQK = NH * DK, DRV = NH * DV;
constexpr int NB = 10, LB = 128, DL = NB * LB;
constexpr int DIN = 10752;
constexpr int N1 = 6656;
constexpr int N2 = 4096;
constexpr int CH = 256;
constexpr int NCH_LAT = LLAT / CH;
constexpr float EPS = 1e-6f;
constexpr int NWAVES = 8, NTHR = 512;

constexpr size_t MiB = 1u << 20;
constexpr size_t WS_CTL = 0, CTL_ZERO_BYTES = 1 * MiB;
constexpr size_t WS_WINT = 1 * MiB;
constexpr size_t WS_WRDT = 22 * MiB;
constexpr size_t WS_WLDT = 26 * MiB;
constexpr size_t WS_WOUTT = 28 * MiB + 512 * 1024;
constexpr size_t WS_WLRUT = 30 * MiB + 512 * 1024;
constexpr size_t WS_MOD = 31 * MiB + 768 * 1024;
constexpr size_t WS_H = 32 * MiB;
constexpr size_t WS_Q = 56 * MiB, WS_K = 80 * MiB, WS_V = 104 * MiB;
constexpr size_t WS_XL = 152 * MiB, WS_GL = 182 * MiB;
constexpr size_t WS_AGG = 216 * MiB;
constexpr size_t WS_SS = 220 * MiB;
constexpr size_t WS_MODP = 224 * MiB;
constexpr size_t WS_HL = 226 * MiB;
constexpr size_t WS_SP = 152 * MiB;
constexpr size_t WS_SIGR = 56 * MiB, WS_SIGL = 80 * MiB;
constexpr size_t WS_MERGED = 104 * MiB;
constexpr size_t WS_END = 256 * MiB;
constexpr size_t OUT_Y = 0;
constexpr size_t OUT_NSR = (size_t)M * D;
constexpr size_t OUT_NSL = OUT_NSR + (size_t)NCTX * 2 * NH * DK * DV;
constexpr size_t OUT_TOTAL = OUT_NSL + (size_t)NCTX * 2 * DL;

constexpr int CW_TMO = 0, CW_CODE = 1, CW_BAR = 4096;
constexpr int LDS_BYTES = 147456;
constexpr int MISC_OFF = 131072 + 320;

#define GAS __attribute__((address_space(1)))
#define LAS __attribute__((address_space(3)))
typedef unsigned short bf16;
typedef unsigned v4u __attribute__((ext_vector_type(4)));
typedef float f32x4 __attribute__((ext_vector_type(4)));
typedef short bf16x8 __attribute__((ext_vector_type(8)));
typedef GAS unsigned gu32;
#define RLX_AGENT __ATOMIC_RELAXED, __HIP_MEMORY_SCOPE_AGENT
#define LDS_WAIT() asm volatile("s_waitcnt lgkmcnt(0)" ::: "memory")
#define VM_WAIT() asm volatile("s_waitcnt vmcnt(0)" ::: "memory")

__device__ __forceinline__ unsigned f2bf(float f) { unsigned u = __builtin_bit_cast(unsigned, f); return (u + 0x7fffu + ((u >> 16) & 1u)) >> 16; }
__device__ __forceinline__ float bf2f(unsigned short b) { return __builtin_bit_cast(float, ((unsigned)b) << 16); }
__device__ __forceinline__ float bfr(float f) { return bf2f((unsigned short)f2bf(f)); }
__device__ __forceinline__ unsigned pk2(float lo, float hi) { return f2bf(lo) | (f2bf(hi) << 16); }
__device__ __forceinline__ float sigmoidf_(float x) { return 1.0f / (1.0f + __expf(-x)); }
__device__ __forceinline__ float siluf_(float x) { return x / (1.0f + __expf(-x)); }

#define XB_TMO      128
#define XB_XCNT(j)  (256  + 64 * (j))
#define XB_XSUB(j)  (1280 + 64 * (j))
#define XB_XGEN(j)  (2304 + 64 * (j))
#define XB_TOP      3328
#define XB_TOPGEN   3392
#define XCD_BAR_WORDS 3456
#define XB_SPIN_CAP (1u << 22)
__device__ __forceinline__ unsigned xb_ld(unsigned* p)              { return __hip_atomic_load(p, __ATOMIC_RELAXED, __HIP_MEMORY_SCOPE_AGENT); }
__device__ __forceinline__ unsigned xb_add(unsigned* p, unsigned v) { return __hip_atomic_fetch_add(p, v, __ATOMIC_RELAXED, __HIP_MEMORY_SCOPE_AGENT); }
__device__ __forceinline__ unsigned xb_xcc_id() { return (unsigned)__builtin_amdgcn_s_getreg((3 << 11) | 20) & 0xFu; }
#define XB_SPIN(cond, bar) do { unsigned _sp = 0; while (cond) { __builtin_amdgcn_s_sleep(1); \
    if ((++_sp & 255u) == 0u) { if (xb_ld(&(bar)[XB_TMO])) break; if (_sp > XB_SPIN_CAP) { atomicAdd(&(bar)[XB_TMO], 1u); break; } } } } while (0)
struct XcdBarrier { unsigned* bar; unsigned x; volatile LAS unsigned* st; };
__device__ __forceinline__ XcdBarrier xcd_barrier_post(unsigned* bar, volatile LAS unsigned* st) {
    XcdBarrier b; b.bar = bar; b.x = xb_xcc_id(); b.st = st;
    if (threadIdx.x == 0) (void)xb_add(&bar[XB_XCNT(b.x)], 1u);
    return b;
}
__device__ __forceinline__ void xcd_barrier_complete(unsigned* bar, unsigned x, unsigned& nloc, unsigned& nx) {
    const unsigned G = gridDim.x * gridDim.y * gridDim.z;
    unsigned sum, cnt, mine, sp = 0u;
    for (;;) {
        sum = 0u; cnt = 0u; mine = 0u;
#pragma unroll
        for (unsigned j = 0; j < 16; ++j) { const unsigned c = xb_ld(&bar[XB_XCNT(j)]); sum += c; cnt += (c > 0u) ? 1u : 0u; mine = (j == x) ? c : mine; }
        if (sum == G) break;
        __builtin_amdgcn_s_sleep(1);
        if ((++sp & 255u) == 0u) { if (xb_ld(&bar[XB_TMO])) break; if (sp > XB_SPIN_CAP) { atomicAdd(&bar[XB_TMO], 1u); break; } }
    }
    nloc = mine > 0u ? mine : 1u; nx = cnt > 0u ? cnt : 1u;
}
__device__ __forceinline__ void xcd_barrier(const XcdBarrier& b) {
    asm volatile("s_waitcnt vmcnt(0)" ::: "memory");
    __syncthreads();
    if (threadIdx.x == 0) {
        unsigned* bar = b.bar;
        __builtin_amdgcn_s_waitcnt(0);
        unsigned nloc = b.st[0], nx = b.st[1];
        if (nloc == 0u) { xcd_barrier_complete(bar, b.x, nloc, nx); b.st[0] = nloc; b.st[1] = nx; }
        const unsigned old = xb_add(&bar[XB_XSUB(b.x)], 1u);
        const unsigned gen = old / nloc;
        if (old + 1u == (gen + 1u) * nloc) {
            __builtin_amdgcn_fence(__ATOMIC_RELEASE, "agent");
            asm volatile("s_waitcnt vmcnt(0)" ::: "memory");
            const unsigned og = xb_add(&bar[XB_TOP], 1u);
            const unsigned tg = og / nx;
            if (og + 1u == (tg + 1u) * nx) xb_add(&bar[XB_TOPGEN], 1u);
            else XB_SPIN(xb_ld(&bar[XB_TOPGEN]) == tg, bar);
            __builtin_amdgcn_fence(__ATOMIC_ACQUIRE, "agent");
            xb_add(&bar[XB_XGEN(b.x)], 1u);
            asm volatile("s_waitcnt vmcnt(0)" ::: "memory");
        } else {
            XB_SPIN(xb_ld(&bar[XB_XGEN(b.x)]) == gen, bar);
            __builtin_amdgcn_fence(__ATOMIC_ACQUIRE, "agent");
            asm volatile("s_waitcnt vmcnt(0)" ::: "memory");
        }
    }
    __syncthreads();
}

namespace pg8 {
#define PG8_LAS __attribute__((address_space(3)))
typedef unsigned short bf16_t;
typedef short bf16x8 __attribute__((ext_vector_type(8)));
typedef float f32x4 __attribute__((ext_vector_type(4)));
typedef unsigned u32x4 __attribute__((ext_vector_type(4)));
constexpr int BM = 256, BK = 64, HALF = 128, HTB = HALF * BK * 2  , STAGE_BYTES = 8 * HTB, NXCD = 8, WGM = 8;

__host__ __device__ __forceinline__ int lds_byte(int r, int c) { const int st = (r >> 4) * 2 + (c >> 5), rr = r & 15, cc = c & 31, ob = rr * 64 + cc * 2; return st * 1024 + (ob ^ (((ob >> 9) & 1) << 5)); }
__host__ __device__ __forceinline__ void stage_rc(int b, int& R, int& C) { const int st = b / 1024, sb = b % 1024, swz = sb ^ (((sb >> 9) & 1) << 5); R = (st >> 1) * 16 + swz / 64; C = (st & 1) * 32 + (swz % 64) / 2; }
__host__ __device__ __forceinline__ int perm32(int rho) { const int n = rho >> 4, i = rho & 15; return 8 * (i >> 2) + 4 * n + (i & 3); }

struct Unit { int pm, pn; };
struct Gemm { const bf16_t* A; const bf16_t* Bt; int M, N, K; };

struct StaticOrder {
    int nM, nN, nwg, G, c;
    __host__ __device__ void init(int M, int N, int G_, int c_) { nM = M / BM; nN = N / BM; nwg = nM * nN; G = G_; c = c_; }
    __host__ __device__ bool next(int i, Unit& u) const {
        const long L = (long)i * G + c; if (L >= nwg) return false;
        int wgid = (int)L; { const int q = nwg / NXCD, r = nwg % NXCD, xcd = wgid % NXCD, off = wgid / NXCD; wgid = (xcd < r ? xcd * (q + 1) : r * (q + 1) + (xcd - r) * q) + off; }
        const int nig = WGM * nN, gid = wgid / nig, fm = gid * WGM, gsz = (nM - fm) < WGM ? (nM - fm) : WGM;
        u.pm = fm + ((wgid % nig) % gsz); u.pn = (wgid % nig) / gsz; return true;
    }
    __device__ __forceinline__ void a_ready(const Unit&) const {}
    __device__ __forceinline__ void done(const Unit&) const {}
};

__device__ __forceinline__ unsigned cvt_pk_bf16(float lo, float hi) { unsigned r; asm volatile("v_cvt_pk_bf16_f32 %0, %1, %2" : "=v"(r) : "v"(lo), "v"(hi)); return r; }

typedef float f32x2 __attribute__((ext_vector_type(2)));
__device__ __forceinline__ float pg_silu(float x) { return x * __builtin_amdgcn_rcpf(1.0f + __expf(-x)); }
__device__ __forceinline__ float pg_sigm(float x) { return __builtin_amdgcn_rcpf(1.0f + __expf(-x)); }
__device__ __forceinline__ float pg_lo(unsigned w) { return __builtin_bit_cast(float, w << 16); }
__device__ __forceinline__ float pg_hi(unsigned w) { return __builtin_bit_cast(float, w & 0xffff0000u); }
struct EpiG1 {
    static constexpr bool PERM = true, AFTER_DRAIN = false;
    bf16_t *Q, *K, *V, *XL, *GL;
    __device__ __forceinline__ void operator()(const f32x4 (&acc)[2][2][4][2], const Unit& u, int wr, int wc, int fr, int fq) const {
        const int row0 = u.pm * BM + wr * 64 + fr; int colt = u.pn * BM; bf16_t* base; int ldc; float sc = 1.f; bool act = false;
        if (colt < 1024) { base = Q; ldc = 1024; } else if (colt < 2048) { base = K; ldc = 1024; colt -= 1024; sc = 0.0625f; }
        else if (colt < 4096) { base = V; ldc = 2048; colt -= 2048; } else if (colt < 5376) { base = XL; ldc = 1280; colt -= 4096; } else { base = GL; ldc = 1280; colt -= 5376; act = true; }
        const int col0 = colt + wc * 32 + 8 * fq;
#pragma unroll
        for (int ai = 0; ai < 2; ++ai)
#pragma unroll
            for (int m = 0; m < 4; ++m) { bf16_t* rowp = base + (size_t)(row0 + ai * HALF + m * 16) * ldc + col0;
#pragma unroll
                for (int bj = 0; bj < 2; ++bj) { f32x4 v0 = acc[ai][bj][m][0], v1 = acc[ai][bj][m][1];
                    if (act) {
#pragma unroll
                        for (int j = 0; j < 4; ++j) { v0[j] = pg_silu(v0[j]); v1[j] = pg_silu(v1[j]); } }
                    v0 = v0 * sc; v1 = v1 * sc; u32x4 w; w.x = cvt_pk_bf16(v0[0], v0[1]); w.y = cvt_pk_bf16(v0[2], v0[3]); w.z = cvt_pk_bf16(v1[0], v1[1]); w.w = cvt_pk_bf16(v1[2], v1[3]);
                    *(u32x4*)(rowp + bj * HALF) = w; } }
    }
};
struct EpiG2 {
    static constexpr bool PERM = true, AFTER_DRAIN = false;
    bf16_t *OG, *SIGR, *SIGL; const float *SS, *gnw;
    __device__ __forceinline__ void operator()(const f32x4 (&acc)[2][2][4][2], const Unit& u, int wr, int wc, int fr, int fq) const {
        const int row0 = u.pm * BM + wr * 64 + fr; int colt = u.pn * BM; bf16_t* base; int ldc; bool mul = false;
        if (colt < 2048) { base = OG; ldc = 2048; mul = true; } else if (colt < 3072) { base = SIGR; ldc = 1024; colt -= 2048; } else { base = SIGL; ldc = 1024; colt -= 3072; }
        const int col0 = colt + wc * 32 + 8 * fq, head = colt >> 9;
        f32x4 gw[2][2];
#pragma unroll
        for (int bj = 0; bj < 2; ++bj)
#pragma unroll
            for (int n = 0; n < 2; ++n) gw[bj][n] = mul ? *(const f32x4*)(gnw + col0 + bj * HALF + 4 * n) : (f32x4){1.f, 1.f, 1.f, 1.f};
#pragma unroll
        for (int ai = 0; ai < 2; ++ai)
#pragma unroll
            for (int m = 0; m < 4; ++m) { const int r = row0 + ai * HALF + m * 16; bf16_t* rowp = base + (size_t)r * ldc + col0;
                float rs = 1.f;
                if (mul) { const f32x4 sq = *(const f32x4*)(SS + ((size_t)r * 4 + head) * 4); rs = 1.0f / sqrtf(((sq[0] + sq[1]) + (sq[2] + sq[3])) * (1.0f / 512.0f) + 1e-6f); }
#pragma unroll
                for (int bj = 0; bj < 2; ++bj) { f32x4 v0 = acc[ai][bj][m][0], v1 = acc[ai][bj][m][1];
                    if (mul) { const u32x4 o = *(const u32x4*)(rowp + bj * HALF); const f32x4 g0 = gw[bj][0] * rs, g1 = gw[bj][1] * rs;
                        v0[0] = pg_silu(v0[0]) * pg_lo(o.x) * g0[0]; v0[1] = pg_silu(v0[1]) * pg_hi(o.x) * g0[1]; v0[2] = pg_silu(v0[2]) * pg_lo(o.y) * g0[2]; v0[3] = pg_silu(v0[3]) * pg_hi(o.y) * g0[3];
                        v1[0] = pg_silu(v1[0]) * pg_lo(o.z) * g1[0]; v1[1] = pg_silu(v1[1]) * pg_hi(o.z) * g1[1]; v1[2] = pg_silu(v1[2]) * pg_lo(o.w) * g1[2]; v1[3] = pg_silu(v1[3]) * pg_hi(o.w) * g1[3];
                    } else {
#pragma unroll
                        for (int j = 0; j < 4; ++j) { v0[j] = pg_sigm(v0[j]); v1[j] = pg_sigm(v1[j]); } }
                    u32x4 w; w.x = cvt_pk_bf16(v0[0], v0[1]); w.y = cvt_pk_bf16(v0[2], v0[3]); w.z = cvt_pk_bf16(v1[0], v1[1]); w.w = cvt_pk_bf16(v1[2], v1[3]);
                    *(u32x4*)(rowp + bj * HALF) = w; } }
    }
};
template <bool ADD> struct EpiDown {
    static constexpr bool PERM = true, AFTER_DRAIN = false;
    bf16_t* MERGED; const bf16_t* SIG;
    __device__ __forceinline__ void operator()(const f32x4 (&acc)[2][2][4][2], const Unit& u, int wr, int wc, int fr, int fq) const {
        const int row0 = u.pm * BM + wr * 64 + fr, col0 = u.pn * BM + wc * 32 + 8 * fq;
#pragma unroll
        for (int ai = 0; ai < 2; ++ai)
#pragma unroll
            for (int m = 0; m < 4; ++m) { const size_t off = (size_t)(row0 + ai * HALF + m * 16) * 1024 + col0;
#pragma unroll
                for (int bj = 0; bj < 2; ++bj) { f32x4 v0 = acc[ai][bj][m][0], v1 = acc[ai][bj][m][1];
                    const u32x4 g = *(const u32x4*)(SIG + off + bj * HALF);
                    v0[0] *= pg_lo(g.x); v0[1] *= pg_hi(g.x); v0[2] *= pg_lo(g.y); v0[3] *= pg_hi(g.y); v1[0] *= pg_lo(g.z); v1[1] *= pg_hi(g.z); v1[2] *= pg_lo(g.w); v1[3] *= pg_hi(g.w);
                    if (ADD) { const u32x4 o = *(const u32x4*)(MERGED + off + bj * HALF);
                        v0[0] += pg_lo(o.x); v0[1] += pg_hi(o.x); v0[2] += pg_lo(o.y); v0[3] += pg_hi(o.y); v1[0] += pg_lo(o.z); v1[1] += pg_hi(o.z); v1[2] += pg_lo(o.w); v1[3] += pg_hi(o.w); }
                    u32x4 w; w.x = cvt_pk_bf16(v0[0], v0[1]); w.y = cvt_pk_bf16(v0[2], v0[3]); w.z = cvt_pk_bf16(v1[0], v1[1]); w.w = cvt_pk_bf16(v1[2], v1[3]);
                    *(u32x4*)(MERGED + off + bj * HALF) = w; } }
    }
};
struct EpiY {
    static constexpr bool PERM = false, AFTER_DRAIN = false;
    float* Y; const float *xp, *xs, *MOD; int mctx, llat;
    __device__ __forceinline__ void operator()(const f32x4 (&acc)[2][2][4][2], const Unit& u, int wr, int wc, int fr, int fq) const {
        const int row0 = u.pm * BM + wr * 64 + fr, col0 = u.pn * BM + wc * 32 + 4 * fq;
        const int rbase = u.pm * BM;
        const float* gate = MOD + (rbase < mctx ? 0 : 1 + (rbase - mctx) / llat) * 3072 + 2048;
        f32x4 gv[2][2];
#pragma unroll
        for (int bj = 0; bj < 2; ++bj)
#pragma unroll
            for (int n = 0; n < 2; ++n) gv[bj][n] = *(const f32x4*)(gate + col0 + bj * HALF + n * 16);
#pragma unroll
        for (int ai = 0; ai < 2; ++ai)
#pragma unroll
            for (int m = 0; m < 4; ++m) { const int r = row0 + ai * HALF + m * 16; const float* xr = (r < mctx ? xp + (size_t)r * 1024 : xs + (size_t)(r - mctx) * 1024) + col0; float* yr = Y + (size_t)r * 1024 + col0;
#pragma unroll
                for (int bj = 0; bj < 2; ++bj)
#pragma unroll
                    for (int n = 0; n < 2; ++n) { const f32x4 xv = *(const f32x4*)(xr + bj * HALF + n * 16); *(f32x4*)(yr + bj * HALF + n * 16) = xv + gv[bj][n] * acc[ai][bj][m][n]; } }
    }
};

template <class Epi, class Sched, bool ALIGN_EPI = false, bool SP2 = false>
__device__ __forceinline__ void gemm_phase(PG8_LAS unsigned char* lds, const Gemm g, const Sched& S, const Epi& E) {
    const int tid = threadIdx.x, wid = __builtin_amdgcn_readfirstlane(tid >> 6), lane = tid & 63, wr = wid >> 2, wc = wid & 3, fr = lane & 15, fq = lane >> 4;
    const int K = g.K, nt = K / BK;
    unsigned voffA[2], voffB[2];
#pragma unroll
    for (int i = 0; i < 2; ++i) { int R, C; stage_rc(tid * 16 + i * 8192, R, C); const int Rb = Epi::PERM ? ((R & ~31) + perm32(R & 31)) : R;
        voffA[i] = (unsigned)(R * K + C) * 2u; voffB[i] = (unsigned)(Rb * K + C) * 2u; }
    const size_t kstep = (size_t)(BK * 2);
    const size_t hstep = (size_t)HALF * K * 2;
    const size_t tstep = 2 * hstep;
    const unsigned ldsw = (unsigned)wid * 1024u;
    const int aoff = lds_byte(wr * 64 + fr, fq * 8), boff = lds_byte(wc * 32 + fr, fq * 8);
#define PG8_SA(b, h) (((b) * 2 + (h)) * HTB)
#define PG8_SB(b, h) ((4 + (b) * 2 + (h)) * HTB)
#define PG8_STAGE(bufoff, gbase, voff) do { _Pragma("unroll") for (int _i = 0; _i < 2; ++_i) \
        __builtin_amdgcn_global_load_lds((const unsigned*)((const char*)(gbase) + (voff)[_i]), (PG8_LAS unsigned*)(lds + (bufoff) + ldsw + _i * 8192), 16, 0, 0); } while (0)
#define PG8_LDA(dst, b, h) do { _Pragma("unroll") for (int m = 0; m < 4; ++m) _Pragma("unroll") for (int k = 0; k < 2; ++k) dst[m][k] = *(const PG8_LAS bf16x8*)(lds + PG8_SA(b, h) + aoff + m * 2048 + k * 1024); } while (0)
#define PG8_LDB(dst, b, h) do { _Pragma("unroll") for (int n = 0; n < 2; ++n) _Pragma("unroll") for (int k = 0; k < 2; ++k) dst[n][k] = *(const PG8_LAS bf16x8*)(lds + PG8_SB(b, h) + boff + n * 2048 + k * 1024); } while (0)
#define PG8_MMA(ai, bj, At, Bt) do { __builtin_amdgcn_s_setprio(1); _Pragma("unroll") for (int m = 0; m < 4; ++m) _Pragma("unroll") for (int n = 0; n < 2; ++n) _Pragma("unroll") for (int k = 0; k < 2; ++k) \
        acc[ai][bj][m][n] = __builtin_amdgcn_mfma_f32_16x16x32_bf16(Bt[n][k], At[m][k], acc[ai][bj][m][n], 0, 0, 0); __builtin_amdgcn_s_setprio(0); } while (0)
#define PG8_WAIT_V(n) asm volatile("s_waitcnt vmcnt(" #n ")" ::: "memory")
#define PG8_WAIT_L(n) asm volatile("s_waitcnt lgkmcnt(" #n ")" ::: "memory")
#define PG8_BAR __builtin_amdgcn_s_barrier()
#define PG8_SCHED __builtin_amdgcn_sched_barrier(0)
    Unit cur, nxt; int ui = 0;
    if (!S.next(0, cur)) return;
    f32x4 acc[2][2][4][2];
#pragma unroll
    for (int a = 0; a < 2; ++a)
#pragma unroll
        for (int b = 0; b < 2; ++b)
#pragma unroll
            for (int m = 0; m < 4; ++m)
#pragma unroll
                for (int n = 0; n < 2; ++n) acc[a][b][m][n] = (f32x4){0.f, 0.f, 0.f, 0.f};
    bf16x8 At[4][2], B0[2][2], B1[2][2];
    const char* cA = (const char*)g.A + (size_t)cur.pm * tstep; const char* cB = (const char*)g.Bt + (size_t)cur.pn * tstep;
    S.a_ready(cur);
    if constexpr (SP2) {
        PG8_STAGE(PG8_SB(0, 0), cB, voffB); PG8_STAGE(PG8_SB(0, 1), cB + hstep, voffB); PG8_STAGE(PG8_SA(0, 0), cA, voffA); PG8_STAGE(PG8_SA(0, 1), cA + hstep, voffA);
        if (wr == 1) PG8_BAR;
        PG8_WAIT_V(2); PG8_BAR;
        PG8_STAGE(PG8_SB(1, 0), cB + kstep, voffB); PG8_STAGE(PG8_SA(1, 0), cA + kstep, voffA); PG8_STAGE(PG8_SB(1, 1), cB + hstep + kstep, voffB);
        PG8_WAIT_V(6); PG8_BAR;
    } else {
        PG8_STAGE(PG8_SB(0, 0), cB, voffB); PG8_STAGE(PG8_SA(0, 0), cA, voffA); PG8_STAGE(PG8_SB(0, 1), cB + hstep, voffB); PG8_STAGE(PG8_SA(0, 1), cA + hstep, voffA);
        if (wr == 1) PG8_BAR;
        PG8_WAIT_V(4); PG8_BAR;
        PG8_STAGE(PG8_SB(1, 0), cB + kstep, voffB); PG8_STAGE(PG8_SA(1, 0), cA + kstep, voffA); PG8_STAGE(PG8_SB(1, 1), cB + hstep + kstep, voffB);
        PG8_WAIT_V(6); PG8_BAR;
    }
    for (;;) {
        const bool has_next = S.next(ui + 1, nxt);
        const char* nA = has_next ? (const char*)g.A + (size_t)nxt.pm * tstep : cA; const char* nB = has_next ? (const char*)g.Bt + (size_t)nxt.pn * tstep : cB;
        for (int t = 0; t < nt; t += 2) {
            const bool last = (t == nt - 2);
            const char* a1 = cA + (size_t)(t + 1) * kstep;
            const char* a2 = last ? nA : cA + (size_t)(t + 2) * kstep; const char* b2 = last ? nB : cB + (size_t)(t + 2) * kstep;
            const char* a3 = a2 + kstep; const char* b3 = b2 + kstep;
            if (last && has_next) S.a_ready(nxt);
            if constexpr (SP2) {
            PG8_LDB(B0, 0, 0); PG8_LDB(B1, 0, 1); PG8_SCHED; PG8_LDA(At, 0, 0); PG8_STAGE(PG8_SA(1, 1), a1 + hstep, voffA);
            PG8_WAIT_V(8); PG8_WAIT_L(0); PG8_BAR; PG8_MMA(0, 0, At, B0); PG8_MMA(0, 1, At, B1); PG8_BAR; PG8_SCHED;
            PG8_LDA(At, 0, 1); PG8_STAGE(PG8_SB(0, 0), b2, voffB); PG8_STAGE(PG8_SB(0, 1), b2 + hstep, voffB); PG8_STAGE(PG8_SA(0, 0), a2, voffA);
            PG8_WAIT_V(8); PG8_WAIT_L(0); PG8_BAR; PG8_MMA(1, 0, At, B0); PG8_MMA(1, 1, At, B1); PG8_BAR; PG8_SCHED;
            PG8_LDB(B0, 1, 0); PG8_LDB(B1, 1, 1); PG8_SCHED; PG8_LDA(At, 1, 0); PG8_STAGE(PG8_SA(0, 1), a2 + hstep, voffA);
            PG8_WAIT_V(8); PG8_WAIT_L(0); PG8_BAR; PG8_MMA(0, 0, At, B0); PG8_MMA(0, 1, At, B1); PG8_BAR; PG8_SCHED;
            PG8_LDA(At, 1, 1); PG8_STAGE(PG8_SB(1, 0), b3, voffB); PG8_STAGE(PG8_SB(1, 1), b3 + hstep, voffB); PG8_STAGE(PG8_SA(1, 0), a3, voffA);
            PG8_WAIT_V(8); PG8_WAIT_L(0); PG8_BAR; PG8_MMA(1, 0, At, B0); PG8_MMA(1, 1, At, B1); PG8_BAR; PG8_SCHED;
            } else {
            PG8_LDB(B0, 0, 0); PG8_SCHED; PG8_LDA(At, 0, 0); PG8_STAGE(PG8_SA(1, 1), a1 + hstep, voffA);
            PG8_WAIT_L(8); PG8_BAR; PG8_WAIT_L(0); PG8_MMA(0, 0, At, B0); PG8_BAR; PG8_SCHED;
            PG8_LDB(B1, 0, 1); PG8_STAGE(PG8_SB(0, 0), b2, voffB);
            PG8_BAR; PG8_WAIT_L(0); PG8_MMA(0, 1, At, B1); PG8_BAR;
            PG8_LDA(At, 0, 1); PG8_STAGE(PG8_SA(0, 0), a2, voffA);
            PG8_BAR; PG8_WAIT_L(0); PG8_MMA(1, 0, At, B0); PG8_BAR; PG8_SCHED;
            PG8_STAGE(PG8_SB(0, 1), b2 + hstep, voffB);
            PG8_WAIT_V(6); PG8_BAR; PG8_MMA(1, 1, At, B1); PG8_BAR;
            PG8_LDB(B0, 1, 0); PG8_SCHED; PG8_LDA(At, 1, 0); PG8_STAGE(PG8_SA(0, 1), a2 + hstep, voffA);
            PG8_WAIT_L(8); PG8_BAR; PG8_WAIT_L(0); PG8_MMA(0, 0, At, B0); PG8_BAR; PG8_SCHED;
            PG8_LDB(B1, 1, 1); PG8_STAGE(PG8_SB(1, 0), b3, voffB);
            PG8_BAR; PG8_WAIT_L(0); PG8_MMA(0, 1, At, B1); PG8_BAR;
            PG8_LDA(At, 1, 1); PG8_STAGE(PG8_SA(1, 0), a3, voffA);
            PG8_BAR; PG8_WAIT_L(0); PG8_MMA(1, 0, At, B0); PG8_BAR; PG8_SCHED;
            PG8_STAGE(PG8_SB(1, 1), b3 + hstep, voffB);
            PG8_WAIT_V(6); PG8_BAR; PG8_MMA(1, 1, At, B1); PG8_BAR;
            }
        }
        if constexpr (ALIGN_EPI) { if (wr == 0) PG8_BAR; }
        if constexpr (!Epi::AFTER_DRAIN) { E(acc, cur, wr, wc, fr, fq); S.done(cur); }
        if (!has_next) break;
#pragma unroll
        for (int a = 0; a < 2; ++a)
#pragma unroll
            for (int b = 0; b < 2; ++b)
#pragma unroll
                for (int m = 0; m < 4; ++m)
#pragma unroll
                    for (int n = 0; n < 2; ++n) acc[a][b][m][n] = (f32x4){0.f, 0.f, 0.f, 0.f};
        cur = nxt; cA = nA; cB = nB; ++ui;
        if constexpr (ALIGN_EPI) { if (wr == 1) PG8_BAR; }
    }
    PG8_WAIT_V(0);
    if constexpr (!ALIGN_EPI) { if (wr == 0) PG8_BAR; }
    PG8_BAR;
    if constexpr (Epi::AFTER_DRAIN) { E.fused(acc, cur, wr, wc, fr, fq, lds, wid, lane); S.done(cur); }
#undef PG8_SA
#undef PG8_SB
#undef PG8_STAGE
#undef PG8_LDA
#undef PG8_LDB
#undef PG8_MMA
#undef PG8_WAIT_V
#undef PG8_WAIT_L
#undef PG8_BAR
#undef PG8_SCHED
}
}

struct Args {
    const float* in[23]; float* out; unsigned char* ws; int ph_lo, ph_hi; int rep[12];
};
struct Frame {
    LAS unsigned char* lds;
    int tid, lane, wave, G, wg;
    const float *x_prompt, *x_sample, *state_ret, *state_lru, *c, *c_ctx, *norm_w, *w_ada, *b_ada, *w_in, *decay_logit, *gn_w, *w_ret_down,
                *conv_w, *conv_b, *lru_wa, *lru_ba, *lru_wx, *lru_bx, *lru_a, *w_lru_down, *w_out, *final_norm_w;
    float* out; unsigned char* ws;
    bf16 *WinT, *WrdT, *WldT, *WoutT, *WlruT, *H, *Q, *K, *V, *XL, *GL, *HL, *SP, *SIGR, *SIGL, *MERGED, *OG;
    float *MOD, *MODP, *AGG, *SS;
};

__device__ __forceinline__ float wave_sum(float v) {
#pragma unroll
    for (int o = 1; o < 64; o <<= 1) v += __shfl_xor(v, o);
    return v;
}
__device__ __forceinline__ const float* xrow_ptr(const Frame& F, int row) {
    return row < MCTX ? F.x_prompt + (size_t)row * D : F.x_sample + (size_t)(row - MCTX) * D;
}
__device__ __forceinline__ int mod_index(int row) { return row < MCTX ? 0 : 1 + (row - MCTX) / LLAT; }

__device__ __forceinline__ void p0_transpose_item(const float* W, int K, int N, bf16* WT, int drow0, int k0, int n0, LAS float* scr, int lane) {
#pragma unroll 8
    for (int i = 0; i < 32; ++i) { const int kk = 2 * i + (lane >> 5); scr[kk * 33 + (lane & 31)] = W[(size_t)(k0 + kk) * N + n0 + (lane & 31)]; }
    LDS_WAIT(); asm volatile("" ::: "memory");
    const int c = lane & 7;
#pragma unroll
    for (int j = 0; j < 4; ++j) { const int n = (lane >> 3) + 8 * j; const LAS float* s = scr + (8 * c) * 33 + n;
        v4u o; o.x = pk2(s[0 * 33], s[1 * 33]); o.y = pk2(s[2 * 33], s[3 * 33]); o.z = pk2(s[4 * 33], s[5 * 33]); o.w = pk2(s[6 * 33], s[7 * 33]);
        *(v4u*)(WT + (size_t)(drow0 + n) * K + k0 + 8 * c) = o; }
    LDS_WAIT(); asm volatile("" ::: "memory");
}
__device__ __forceinline__ int win_dst_row(int n) { return n < 4096 ? n : (n < 6144 ? n + 2560 : (n < 8704 ? n - 2048 : n)); }

constexpr int MOD_KQ = 4;
__device__ __forceinline__ void phase_prep(Frame& F) {
    LAS float* scr = (LAS float*)(F.lds + F.wave * 8448);
    LAS float* tab = (LAS float*)(F.lds + 8 * 8448);
    for (int i = F.tid; i < 5 * D; i += NTHR) { const float cv = i < D ? F.c_ctx[i] : F.c[i - D]; tab[i] = siluf_(cv); }
    __syncthreads();
    const int gw = F.wg * NWAVES + F.wave, NGW = F.G * NWAVES;
    constexpr int I_IN = (D / 64) * (DIN / 32), I_RD = (DRV / 64) * (D / 32), I_LD = (DL / 64) * (D / 32), I_OUT = (D / 64) * (D / 32), I_LRU = 40 * 8, I_MOD = MOD_KQ * (3072 / 64);
    constexpr int NITEMS = I_MOD + I_IN + I_RD + I_LD + I_OUT + I_LRU;
    for (int it = gw; it < NITEMS; it += NGW) {
        int r = it;
        if (r < I_MOD) {
            const int kq = r / 48, n = (r % 48) * 64 + F.lane;
            float acc[5] = {0.f, 0.f, 0.f, 0.f, 0.f};
            const float* wp = F.w_ada + (size_t)(kq * (D / MOD_KQ)) * 3072 + n; const LAS float* tp = tab + kq * (D / MOD_KQ);
#pragma unroll 16
            for (int k = 0; k < D / MOD_KQ; ++k) {
                const float w = wp[(size_t)k * 3072];
#pragma unroll
                for (int v = 0; v < 5; ++v) acc[v] += tp[v * D + k] * w;
            }
#pragma unroll
            for (int v = 0; v < 5; ++v) F.MODP[(kq * 5 + v) * 3072 + n] = acc[v];
            continue;
        }
        r -= I_MOD;
        if (r < I_IN) { const int nblk = DIN / 32, kb = r / nblk, nb = r % nblk; p0_transpose_item(F.w_in, D, DIN, F.WinT, win_dst_row(nb * 32), kb * 64, nb * 32, scr, F.lane); continue; }
        r -= I_IN;
        if (r < I_RD) { const int nblk = D / 32, kb = r / nblk, nb = r % nblk; p0_transpose_item(F.w_ret_down, DRV, D, F.WrdT, nb * 32, kb * 64, nb * 32, scr, F.lane); continue; }
        r -= I_RD;
        if (r < I_LD) { const int nblk = D / 32, kb = r / nblk, nb = r % nblk; p0_transpose_item(F.w_lru_down, DL, D, F.WldT, nb * 32, kb * 64, nb * 32, scr, F.lane); continue; }
        r -= I_LD;
        if (r < I_OUT) { const int nblk = D / 32, kb = r / nblk, nb = r % nblk; p0_transpose_item(F.w_out, D, D, F.WoutT, nb * 32, kb * 64, nb * 32, scr, F.lane); continue; }
        r -= I_OUT;
        {
            const int mi = r / 8, sub = r % 8, slot = mi / NB, hb = mi % NB, kb = sub / 4, nb = sub % 4;
            const float* W = ((slot & 1) ? F.lru_wx : F.lru_wa) + (size_t)((slot >> 1) * NB + hb) * LB * LB;
            p0_transpose_item(W, LB, LB, F.WlruT + (size_t)hb * 512 * LB, slot * 128 + nb * 32, kb * 64, nb * 32, scr, F.lane);
        }
    }
}

__device__ __forceinline__ void phase_h(Frame& F) {
    LAS float* tab = (LAS float*)F.lds;
    for (int i = F.tid; i < 5 * 2048; i += NTHR) { const int v = i >> 11, n = i & 2047; float a = F.b_ada[n];
#pragma unroll
        for (int kq = 0; kq < MOD_KQ; ++kq) a += F.MODP[(kq * 5 + v) * 3072 + n];
        tab[i] = a; }
    if (F.wg == 0) for (int i = F.tid; i < 5 * 1024; i += NTHR) { const int v = i >> 10, n = 2048 + (i & 1023); float a = F.b_ada[n];
#pragma unroll
        for (int kq = 0; kq < MOD_KQ; ++kq) a += F.MODP[(kq * 5 + v) * 3072 + n];
        F.MOD[v * 3072 + n] = a; }
    __syncthreads();
    const int gw = F.wg * NWAVES + F.wave, NGW = F.G * NWAVES;
    for (int m = gw; m < M; m += NGW) {
        const f32x4* xr = (const f32x4*)xrow_ptr(F, m) + F.lane;
        const LAS float* mod = tab + mod_index(m) * 2048;
        f32x4 v[4]; float s = 0.f;
#pragma unroll
        for (int j = 0; j < 4; ++j) { v[j] = xr[64 * j]; s += (v[j].x * v[j].x + v[j].y * v[j].y) + (v[j].z * v[j].z + v[j].w * v[j].w); }
        const float rstd = 1.0f / sqrtf(wave_sum(s) * (1.f / D) + EPS);
        unsigned long long* o8 = (unsigned long long*)(F.H + (size_t)m * D) + F.lane;
#pragma unroll
        for (int j = 0; j < 4; ++j) {
            const int c0 = 4 * F.lane + 256 * j;
            const f32x4 nw = *(const f32x4*)(F.norm_w + c0), sh = *(const LAS f32x4*)(mod + c0), sc = *(const LAS f32x4*)(mod + 1024 + c0);
            const f32x4 h = v[j] * rstd * nw * (sc + 1.0f) + sh;
            o8[64 * j] = (unsigned long long)pk2(h.x, h.y) | ((unsigned long long)pk2(h.z, h.w) << 32);
        }
    }
    __syncthreads();
}

template <class Epi>
__device__ __forceinline__ void gemm_simple(const Frame& F, const bf16* A, int lda, const bf16* Bt, int ldb, int Mr, int Nc, int K, const Epi& epi) {
    const int wr = F.wave >> 2, wc = F.wave & 3, fr = F.lane & 15, fq = F.lane >> 4;
    const int tilesN = Nc / 256, tiles = (Mr / 128) * tilesN;
    for (int t = F.wg; t < tiles; t += F.G) {
        const int tm = t / tilesN, tn = t % tilesN;
        const int row0 = tm * 128 + wr * 64, col0 = tn * 256 + wc * 64;
        f32x4 acc[4][4];
#pragma unroll
        for (int i = 0; i < 4; ++i)
#pragma unroll
            for (int j = 0; j < 4; ++j) acc[i][j] = (f32x4){0.f, 0.f, 0.f, 0.f};
        const bf16* ap = A + (size_t)(row0 + fr) * lda + 8 * fq;
        const bf16* bp = Bt + (size_t)(col0 + fr) * ldb + 8 * fq;
        for (int k0 = 0; k0 < K; k0 += 32) {
            bf16x8 a[4], b[4];
#pragma unroll
            for (int i = 0; i < 4; ++i) a[i] = *(const bf16x8*)(ap + (size_t)(16 * i) * lda + k0);
#pragma unroll
            for (int j = 0; j < 4; ++j) b[j] = *(const bf16x8*)(bp + (size_t)(16 * j) * ldb + k0);
#pragma unroll
            for (int i = 0; i < 4; ++i)
#pragma unroll
                for (int j = 0; j < 4; ++j) acc[i][j] = __builtin_amdgcn_mfma_f32_16x16x32_bf16(a[i], b[j], acc[i][j], 0, 0, 0);
        }
#pragma unroll
        for (int i = 0; i < 4; ++i)
#pragma unroll
            for (int j = 0; j < 4; ++j)
#pragma unroll
                for (int r = 0; r < 4; ++r) epi(row0 + 16 * i + 4 * fq + r, col0 + 16 * j + fr, acc[i][j][r]);
    }
}

struct EpiGemm1 {
    bf16 *Q, *K, *V, *XL, *GL;
    __device__ __forceinline__ void operator()(int row, int col, float v) const {
        if (col < 1024) Q[(size_t)row * 1024 + col] = (bf16)f2bf(v);
        else if (col < 2048) K[(size_t)row * 1024 + col - 1024] = (bf16)f2bf(v * 0.0625f);
        else if (col < 4096) V[(size_t)row * 2048 + col - 2048] = (bf16)f2bf(v);
        else if (col < 5376) XL[(size_t)row * 1280 + col - 4096] = (bf16)f2bf(v);
        else GL[(size_t)row * 1280 + col - 5376] = (bf16)f2bf(siluf_(v));
    }
};
struct EpiGemm2 {
    bf16 *OG, *SIGR, *SIGL;
    __device__ __forceinline__ void operator()(int row, int col, float v) const {
        if (col < 2048) { bf16* p = OG + (size_t)row * 2048 + col; *p = (bf16)f2bf(bf2f(*p) * siluf_(v)); }
        else if (col < 3072) SIGR[(size_t)row * 1024 + col - 2048] = (bf16)f2bf(sigmoidf_(v));
        else SIGL[(size_t)row * 1024 + col - 3072] = (bf16)f2bf(sigmoidf_(v));
    }
};
struct EpiDownR { bf16 *MERGED; const bf16* SIG;
    __device__ __forceinline__ void operator()(int row, int col, float v) const { const size_t o = (size_t)row * 1024 + col; MERGED[o] = (bf16)f2bf(bf2f(SIG[o]) * v); } };
struct EpiDownL { bf16 *MERGED; const bf16* SIG;
    __device__ __forceinline__ void operator()(int row, int col, float v) const { const size_t o = (size_t)row * 1024 + col; MERGED[o] = (bf16)f2bf(bf2f(MERGED[o]) + bf2f(SIG[o]) * v); } };
struct EpiOut { float* Y; const float *xp, *xs, *MOD;
    __device__ __forceinline__ void operator()(int row, int col, float v) const {
        const float xv = row < MCTX ? xp[(size_t)row * D + col] : xs[(size_t)(row - MCTX) * D + col];
        Y[(size_t)row * D + col] = xv + MOD[mod_index(row) * 3072 + 2048 + col] * v;
    } };

__device__ __forceinline__ void lru_item(Frame& F, int T, int hb, bool fin) {
    const int row0 = 64 * T, tid = F.tid;
    int b, seq0, L; bool lat;
    if (row0 < MCTX) { b = row0 / LCTX; seq0 = b * LCTX; L = LCTX; lat = false; } else { b = (row0 - MCTX) / LLAT; seq0 = MCTX + b * LLAT; L = LLAT; lat = true; }
    const int p0 = row0 - seq0, ti = p0 / 64, ntile = L / 64;
    LAS float* xc = (LAS float*)F.lds; LAS float* a_s = xc + 8192; LAS float* b_s = xc + 16384; LAS float* hf_s = xc + 24576;
    for (int idx = tid; idx < 64 * 128; idx += NTHR) {
        const int t = idx >> 7, c = idx & 127, ch = hb * 128 + c;
        float acc = F.conv_b[ch];
#pragma unroll
        for (int tap = 0; tap < 4; ++tap) {
            const int tt = t + tap - 2; bool ok;
            if (lat) ok = (tt >= 0 && tt < 64); else { const int p = p0 + tt; ok = (p >= 0 && p < L); }
            if (ok) acc += F.conv_w[tap * DL + ch] * bf2f(F.XL[(size_t)(row0 + tt) * DL + ch]);
        }
        xc[idx] = acc;
    }
    __syncthreads();
    const int c = tid & 127, tg = tid >> 7, ch = hb * 128 + c;
    const bf16* W = F.WlruT + (size_t)hb * 512 * LB;
#pragma unroll 1
    for (int dir = 0; dir < 2; ++dir) {
        float acc[2][16];
#pragma unroll
        for (int s = 0; s < 2; ++s)
#pragma unroll
            for (int t = 0; t < 16; ++t) acc[s][t] = 0.f;
        const bf16* W0 = W + (size_t)((2 * dir) * 128 + c) * LB; const bf16* W1 = W + (size_t)((2 * dir + 1) * 128 + c) * LB;
#pragma unroll 2
        for (int i = 0; i < 128; ++i) {
            const float w0 = bf2f(W0[i]), w1 = bf2f(W1[i]);
#pragma unroll
            for (int t = 0; t < 16; ++t) { const float xv = bfr(xc[(tg * 16 + t) * 128 + i]); acc[0][t] += xv * w0; acc[1][t] += xv * w1; }
        }
        const float ba = F.lru_ba[dir * DL + ch], bx = F.lru_bx[dir * DL + ch];
        const float sp = log1pf(expf(-F.lru_a[dir * DL + ch]));
#pragma unroll
        for (int t = 0; t < 16; ++t) {
            const int tok = tg * 16 + t;
            const float r = sigmoidf_(acc[0][t] + ba), gi = sigmoidf_(acc[1][t] + bx);
            const float la = -8.0f * r * sp;
            a_s[tok * 128 + c] = expf(la);
            b_s[tok * 128 + c] = sqrtf(-expm1f(2.0f * la)) * gi * xc[tok * 128 + c];
        }
        __syncthreads();
        if (tid < 128) {
            const int cc = tid, chh = hb * 128 + cc;
            float carry = 0.f;
            if (fin) {
                carry = lat ? F.state_lru[(size_t)(b * 2 + dir) * DL + chh] : 0.f;
                if (dir == 0) { for (int n = 0; n < ti; ++n) { const float* ag = F.AGG + ((size_t)((T - ti + n) * 2 + 0) * 2) * DL; carry = ag[chh] * carry + ag[DL + chh]; } }
                else { for (int n = ntile - 1; n > ti; --n) { const float* ag = F.AGG + ((size_t)((T - ti + n) * 2 + 1) * 2) * DL; carry = ag[chh] * carry + ag[DL + chh]; } }
            }
            float h = carry, P = 1.f;
            if (dir == 0) {
                for (int t = 0; t < 64; ++t) { const float a = a_s[t * 128 + cc]; h = a * h + b_s[t * 128 + cc]; P *= a; if (fin) hf_s[t * 128 + cc] = h; }
                if (fin && !lat && ti == ntile - 1) F.out[OUT_NSL + (size_t)(b * 2 + 0) * DL + chh] = h;
            } else {
                for (int t = 63; t >= 0; --t) { const float a = a_s[t * 128 + cc]; h = a * h + b_s[t * 128 + cc]; P *= a; if (fin) hf_s[t * 128 + cc] += h; }
                if (fin && !lat && ti == 0) F.out[OUT_NSL + (size_t)(b * 2 + 1) * DL + chh] = h;
            }
            if (!fin) { float* ag = F.AGG + ((size_t)(T * 2 + dir) * 2) * DL; ag[chh] = P; ag[DL + chh] = h; }
        }
        __syncthreads();
    }
    if (fin) {
        for (int idx = tid; idx < 64 * 128; idx += NTHR) {
            const int t = idx >> 7, cc = idx & 127; const size_t o = (size_t)(row0 + t) * DL + hb * 128 + cc;
            F.HL[o] = (bf16)f2bf(hf_s[idx] * bf2f(F.GL[o]));
        }
    }
    __syncthreads();
}
__device__ __forceinline__ void phase_lru(Frame& F, bool fin) {
    for (int it = F.wg; it < (M / 64) * NB; it += F.G) lru_item(F, it / NB, it % NB, fin);
}

__device__ __forceinline__ float log_gamma(const Frame& F, int dir, int h) { const float x = F.decay_logit[dir * NH + h]; return -log1pf(expf(-x)); }
__device__ __forceinline__ size_t sp_index(int b, int h, int dir, int n) { return ((size_t)(((b * NH + h) * 2 + dir) * NCH_LAT + n)) * (DK * DV); }
__device__ __forceinline__ void phase_r12(Frame& F) {
    const int e = F.tid;
    constexpr int ITEMS = (NCTX + NLAT) * NH * 2 * (DK / 4);
    for (int it = F.wg; it < ITEMS; it += F.G) {
        int r = it; const int dg = r % (DK / 4); r /= (DK / 4); const int dir = r & 1; r >>= 1; const int h = r % NH; const int s = r / NH;
        const bool lat = s >= NCTX; const int b = lat ? s - NCTX : s; const int L = lat ? LLAT : LCTX; const int seq0 = lat ? MCTX + b * LLAT : b * LCTX;
        const float g = expf(log_gamma(F, dir, h));
        float S[4];
#pragma unroll
        for (int u = 0; u < 4; ++u) S[u] = lat ? F.state_ret[((size_t)((b * 2 + dir) * NH + h) * DK + dg * 4 + u) * DV + e] : 0.f;
        const int nch = L / CH;
        for (int nn = 0; nn < nch; ++nn) {
            const int n = dir == 0 ? nn : nch - 1 - nn;
            if (lat) {
#pragma unroll
                for (int u = 0; u < 4; ++u) F.SP[sp_index(b, h, dir, n) + (size_t)(dg * 4 + u) * DV + e] = (bf16)f2bf(S[u]);
            }
            for (int ii = 0; ii < CH; ++ii) {
                const int i = dir == 0 ? ii : CH - 1 - ii; const size_t row = (size_t)seq0 + n * CH + i;
                const float vv = bf2f(F.V[row * DRV + h * DV + e]);
                const unsigned long long kk = *(const unsigned long long*)(F.K + row * DQK + h * DK + dg * 4);
#pragma unroll
                for (int u = 0; u < 4; ++u) S[u] = g * S[u] + bf2f((unsigned short)(kk >> (16 * u))) * vv;
            }
        }
        if (!lat) {
#pragma unroll
            for (int u = 0; u < 4; ++u) F.out[OUT_NSR + ((size_t)((b * 2 + dir) * NH + h) * DK + dg * 4 + u) * DV + e] = S[u];
        }
    }
}

__device__ __forceinline__ void phase_r3(Frame& F) {
    LAS float* qs = (LAS float*)F.lds; LAS float* Ps = qs + 256; LAS float* red = qs + 512;
    const int tid = F.tid;
    for (int it = F.wg; it < M * NH; it += F.G) {
        const int row = it / NH, h = it % NH;
        const bool lat = row >= MCTX; const int b = lat ? (row - MCTX) / LLAT : row / LCTX; const int seq0 = lat ? MCTX + b * LLAT : b * LCTX;
        const int p = row - seq0, n = p / CH, i = p % CH, crow0 = row - i;
        const float lgf = log_gamma(F, 0, h), lgb = log_gamma(F, 1, h);
        if (tid < 256) qs[tid] = bf2f(F.Q[(size_t)row * DQK + h * DK + tid]);
        __syncthreads();
        if (tid < 256) {
            const int j = tid; const bf16* kr = F.K + (size_t)(crow0 + j) * DQK + h * DK; float s = 0.f;
            for (int d = 0; d < DK; d += 8) { const v4u kv = *(const v4u*)(kr + d);
                s += qs[d] * bf2f((unsigned short)kv.x) + qs[d + 1] * bf2f((unsigned short)(kv.x >> 16)) + qs[d + 2] * bf2f((unsigned short)kv.y) + qs[d + 3] * bf2f((unsigned short)(kv.y >> 16))
                   + qs[d + 4] * bf2f((unsigned short)kv.z) + qs[d + 5] * bf2f((unsigned short)(kv.z >> 16)) + qs[d + 6] * bf2f((unsigned short)kv.w) + qs[d + 7] * bf2f((unsigned short)(kv.w >> 16)); }
            const int dj = i - j; const float dec = dj >= 0 ? expf(lgf * (float)dj) : expf(lgb * (float)(-dj));
            Ps[j] = bfr(s * dec);
        }
        __syncthreads();
        const int e = tid; float acc = 0.f;
        for (int j = 0; j < CH; ++j) acc += Ps[j] * bf2f(F.V[(size_t)(crow0 + j) * DRV + h * DV + e]);
        if (lat) {
            const bf16* sf = F.SP + sp_index(b, h, 0, n); const bf16* sb = F.SP + sp_index(b, h, 1, n);
            float af = 0.f, ab = 0.f;
            for (int d = 0; d < DK; ++d) { af += qs[d] * bf2f(sf[(size_t)d * DV + e]); ab += qs[d] * bf2f(sb[(size_t)d * DV + e]); }
            acc += expf(lgf * (float)(i + 1)) * af + expf(lgb * (float)(CH - i)) * ab;
        }
        float ss = wave_sum(acc * acc);
        if (F.lane == 0) red[F.wave] = ss;
        __syncthreads();
        ss = 0.f;
#pragma unroll
        for (int w = 0; w < NWAVES; ++w) ss += red[w];
        const float sc = 1.0f / sqrtf(ss * (1.0f / DV) + EPS);
        F.OG[(size_t)row * DRV + h * DV + e] = (bf16)f2bf(acc * sc * F.gn_w[h * DV + e]);
        __syncthreads();
    }
}


typedef float f32x16 __attribute__((ext_vector_type(16)));
typedef short s16x4 __attribute__((ext_vector_type(4)));
typedef short v4i16_t __attribute__((ext_vector_type(4)));
typedef float f32x2_t __attribute__((ext_vector_type(2))); typedef __bf16 bf16x2_t __attribute__((ext_vector_type(2)));
typedef LAS const char* lds_cptr;
#define MFMA32(a, b, c) __builtin_amdgcn_mfma_f32_32x32x16_bf16((a), (b), (c), 0, 0, 0)
__device__ __forceinline__ int crow(int reg, int hh) { return (reg & 3) + 8 * (reg >> 2) + 4 * hh; }
__device__ __forceinline__ s16x4 vtr(lds_cptr p) { return __builtin_bit_cast(s16x4, __builtin_amdgcn_ds_read_tr16_b64_v4i16((LAS v4i16_t*)p)); }
__device__ __forceinline__ unsigned cvtpk(float lo, float hi) { f32x2_t v = {lo, hi}; bf16x2_t b = __builtin_convertvector(v, bf16x2_t); return __builtin_bit_cast(unsigned, b); }
__device__ __forceinline__ bf16x8 cat8(s16x4 lo, s16x4 hi) { return (bf16x8){lo[0], lo[1], lo[2], lo[3], hi[0], hi[1], hi[2], hi[3]}; }
__device__ __forceinline__ float ulo(unsigned w) { return __builtin_bit_cast(float, w << 16); }
__device__ __forceinline__ float uhi(unsigned w) { return __builtin_bit_cast(float, w & 0xffff0000u); }

constexpr int EQ = 128, NET = EQ / 32;
constexpr int KSTR = 528;
constexpr int KTSTR = 576;
constexpr int VSTR = 320;
constexpr int R3_KB0 = 0, R3_KB1 = 32 * KSTR, R3_VB0 = 2 * 32 * KSTR, R3_VB1 = R3_VB0 + 32 * VSTR;
constexpr int R12_KB0 = 0, R12_KB1 = 32 * KTSTR, R12_VB0 = 2 * 32 * KTSTR, R12_VB1 = R12_VB0 + 32 * VSTR;

__device__ __forceinline__ void r3f_item(Frame& F, int it) {
    bool lat; int b, n, h, eq;
    if (it < NLAT * NCH_LAT * NH * 4) { lat = true; eq = it & 3; h = (it >> 2) & 3; n = (it >> 4) & 7; b = it >> 7; }
    else { const int i2 = it - NLAT * NCH_LAT * NH * 4; lat = false; eq = i2 & 3; h = (i2 >> 2) & 3; n = 0; b = i2 >> 4; }
    const int seq0 = lat ? MCTX + b * LLAT : b * LCTX, row0 = seq0 + n * CH;
    const int tid = F.tid, lane = F.lane, w = F.wave, r32 = lane & 31, hh = lane >> 5;
    const float lgf = log_gamma(F, 0, h), lgb = log_gamma(F, 1, h);
    LAS char* lds = (LAS char*)F.lds;
    bf16x8 qf[16];
    { const bf16* qp = F.Q + (size_t)(row0 + 32 * w + r32) * DQK + h * DK + 8 * hh;
#pragma unroll
      for (int ks = 0; ks < 16; ++ks) qf[ks] = *(const bf16x8*)(qp + 16 * ks); }
    f32x16 acc[NET];
#pragma unroll
    for (int et = 0; et < NET; ++et)
#pragma unroll
        for (int r = 0; r < 16; ++r) acc[et][r] = 0.f;
    const int vrow = tid >> 4, vch = tid & 15;
    const int blk = (lane >> 4) & 1, q4 = (lane & 15) >> 2, p4 = lane & 3;
    const int trn = (8 * hh + q4) * VSTR + 32 * blk + 8 * p4;
    const int trp = (4 * hh + q4) * VSTR + 32 * blk + 8 * p4;
    if (lat) {
#pragma unroll 1
        for (int dir = 0; dir < 2; ++dir) {
            const bf16* sp = F.SP + sp_index(b, h, dir, n) + eq * EQ;
            { const v4u v = *(const v4u*)(sp + (size_t)vrow * DV + vch * 8); *(LAS v4u*)(lds + R3_VB0 + vrow * VSTR + vch * 16) = v; }
            __syncthreads();
#pragma unroll
            for (int db = 0; db < 8; ++db) {
                v4u nv = {0u, 0u, 0u, 0u};
                if (db < 7) nv = *(const v4u*)(sp + (size_t)(32 * (db + 1) + vrow) * DV + vch * 8);
                lds_cptr vb = lds + ((db & 1) ? R3_VB1 : R3_VB0);
#pragma unroll
                for (int ks2 = 0; ks2 < 2; ++ks2)
#pragma unroll
                    for (int et = 0; et < NET; ++et) {
                        const s16x4 lo = vtr(vb + trn + (16 * ks2) * VSTR + 64 * et), hi = vtr(vb + trn + (16 * ks2 + 4) * VSTR + 64 * et);
                        acc[et] = MFMA32(qf[2 * db + ks2], cat8(lo, hi), acc[et]);
                    }
                if (db < 7) *(LAS v4u*)(lds + ((db & 1) ? R3_VB0 : R3_VB1) + vrow * VSTR + vch * 16) = nv;
                __syncthreads();
            }
#pragma unroll
            for (int r = 0; r < 16; ++r) {
                const float i = (float)(32 * w + crow(r, hh));
                const float f = dir == 0 ? __expf(lgf * (i + 1.0f) - lgb * (256.0f - i)) : __expf(lgb * (256.0f - i));
#pragma unroll
                for (int et = 0; et < NET; ++et) acc[et][r] *= f;
            }
        }
    }
    {
        const bf16* kp = F.K + (size_t)row0 * DQK + h * DK; const bf16* vp = F.V + (size_t)row0 * DRV + h * DV + eq * EQ;
        const int krow0 = tid >> 5, kch = tid & 31;
        { const v4u k0 = *(const v4u*)(kp + (size_t)krow0 * DQK + kch * 8), k1 = *(const v4u*)(kp + (size_t)(krow0 + 16) * DQK + kch * 8);
          const v4u v0 = *(const v4u*)(vp + (size_t)vrow * DRV + vch * 8);
          *(LAS v4u*)(lds + R3_KB0 + krow0 * KSTR + kch * 16) = k0; *(LAS v4u*)(lds + R3_KB0 + (krow0 + 16) * KSTR + kch * 16) = k1;
          *(LAS v4u*)(lds + R3_VB0 + vrow * VSTR + vch * 16) = v0; }
        __syncthreads();
#pragma unroll 1
        for (int jb = 0; jb < 8; ++jb) {
            const int cur = jb & 1;
            v4u k0 = {0u, 0u, 0u, 0u}, k1 = k0, v0 = k0;
            if (jb < 7) { const size_t r1 = (size_t)(32 * (jb + 1));
                k0 = *(const v4u*)(kp + (r1 + krow0) * DQK + kch * 8); k1 = *(const v4u*)(kp + (r1 + krow0 + 16) * DQK + kch * 8);
                v0 = *(const v4u*)(vp + (r1 + vrow) * DRV + vch * 8); }
            lds_cptr kb = lds + (cur ? R3_KB1 : R3_KB0) + r32 * KSTR + 16 * hh;
            lds_cptr vb = lds + (cur ? R3_VB1 : R3_VB0);
            f32x16 X;
#pragma unroll
            for (int r = 0; r < 16; ++r) X[r] = 0.f;
#pragma unroll
            for (int ks = 0; ks < 16; ++ks) { const bf16x8 a = *(const LAS bf16x8*)(kb + 32 * ks); X = MFMA32(a, qf[ks], X); }
            const int qi = 32 * w + r32;
#pragma unroll
            for (int r = 0; r < 16; ++r) { const int dj = qi - (32 * jb + crow(r, hh)); X[r] *= dj >= 0 ? __expf(lgf * (float)dj) : __expf(-lgb * (float)dj); }
            bf16x8 pa[2];
#pragma unroll
            for (int s2 = 0; s2 < 2; ++s2) { const unsigned u0 = cvtpk(X[8 * s2], X[8 * s2 + 1]), u1 = cvtpk(X[8 * s2 + 2], X[8 * s2 + 3]), u2 = cvtpk(X[8 * s2 + 4], X[8 * s2 + 5]), u3 = cvtpk(X[8 * s2 + 6], X[8 * s2 + 7]);
                pa[s2] = __builtin_bit_cast(bf16x8, (v4u){u0, u1, u2, u3}); }
#pragma unroll
            for (int s2 = 0; s2 < 2; ++s2)
#pragma unroll
                for (int et = 0; et < NET; ++et) {
                    const s16x4 lo = vtr(vb + trp + (16 * s2) * VSTR + 64 * et), hi = vtr(vb + trp + (16 * s2 + 8) * VSTR + 64 * et);
                    acc[et] = MFMA32(pa[s2], cat8(lo, hi), acc[et]);
                }
            if (jb < 7) { LAS char* kn = lds + (cur ? R3_KB0 : R3_KB1); LAS char* vn = lds + (cur ? R3_VB0 : R3_VB1);
                *(LAS v4u*)(kn + krow0 * KSTR + kch * 16) = k0; *(LAS v4u*)(kn + (krow0 + 16) * KSTR + kch * 16) = k1; *(LAS v4u*)(vn + vrow * VSTR + vch * 16) = v0; }
            __syncthreads();
        }
    }
#pragma unroll
    for (int r = 0; r < 16; ++r) {
        float ss = 0.f;
#pragma unroll
        for (int et = 0; et < NET; ++et) ss += acc[et][r] * acc[et][r];
#pragma unroll
        for (int o = 1; o < 32; o <<= 1) ss += __shfl_xor(ss, o);
        const int row = row0 + 32 * w + crow(r, hh);
        if (r32 == 0) F.SS[((size_t)row * NH + h) * 4 + eq] = ss;
        bf16* op = F.OG + (size_t)row * DRV + h * DV + eq * EQ + r32;
#pragma unroll
        for (int et = 0; et < NET; ++et) op[32 * et] = (bf16)f2bf(acc[et][r]);
    }
}
__device__ __forceinline__ void phase_r3f(Frame& F) {
    for (int it = F.wg; it < (NLAT * NCH_LAT + NCTX) * NH * 4; it += F.G) r3f_item(F, it);
}

__device__ __forceinline__ void r12f_item(Frame& F, int it) {
    bool lat; int b, h, dir, eq;
    if (it < NLAT * NH * 2 * 4) { lat = true; eq = it & 3; dir = (it >> 2) & 1; h = (it >> 3) & 3; b = it >> 5; }
    else { const int i2 = it - NLAT * NH * 2 * 4; lat = false; eq = i2 & 3; dir = (i2 >> 2) & 1; h = (i2 >> 3) & 3; b = i2 >> 5; }
    const int seq0 = lat ? MCTX + b * LLAT : b * LCTX;
    const int tid = F.tid, lane = F.lane, w = F.wave, r32 = lane & 31, hh = lane >> 5;
    const float lg = log_gamma(F, dir, h);
    LAS char* lds = (LAS char*)F.lds;
    f32x16 acc[NET];
    if (lat) {
        const float* s0 = F.state_ret + ((size_t)((b * 2 + dir) * NH + h) * DK) * DV + eq * EQ + r32;
#pragma unroll
        for (int et = 0; et < NET; ++et)
#pragma unroll
            for (int r = 0; r < 16; ++r) acc[et][r] = s0[(size_t)(32 * w + crow(r, hh)) * DV + 32 * et];
    } else {
#pragma unroll
        for (int et = 0; et < NET; ++et)
#pragma unroll
            for (int r = 0; r < 16; ++r) acc[et][r] = 0.f;
    }
    const int nproc = lat ? NCH_LAT - 1 : 1;
    const int nblocks = nproc * 8;
    const int vrow = tid >> 4, vch = tid & 15, krow0 = tid >> 5, kch = tid & 31;
    const int blk = (lane >> 4) & 1, q4 = (lane & 15) >> 2, p4 = lane & 3;
    const int tra = (8 * hh + q4) * KTSTR + 64 * w + 32 * blk + 8 * p4;
    const int trb = (8 * hh + q4) * VSTR + 32 * blk + 8 * p4;
    const bf16* kp = F.K + (size_t)seq0 * DQK + h * DK; const bf16* vp = F.V + (size_t)seq0 * DRV + h * DV + eq * EQ;
    const float g256 = __expf(lg * 256.0f);
    const int nch = lat ? NCH_LAT : 1;
    v4u k0, k1, v0;
#define R12_LOAD(t) do { const int cn_ = (t) >> 3, tb_ = (t) & 7, n_ = dir ? nch - 1 - cn_ : cn_; const size_t r_ = (size_t)(n_ * CH + 32 * tb_); \
        k0 = *(const v4u*)(kp + (r_ + krow0) * DQK + kch * 8); k1 = *(const v4u*)(kp + (r_ + krow0 + 16) * DQK + kch * 8); \
        const v4u vv_ = *(const v4u*)(vp + (r_ + vrow) * DRV + vch * 8); const int pos_ = 32 * tb_ + vrow; \
        const float dec_ = __expf(lg * (float)(dir ? pos_ : 255 - pos_)); \
        v0.x = cvtpk(ulo(vv_.x) * dec_, uhi(vv_.x) * dec_); v0.y = cvtpk(ulo(vv_.y) * dec_, uhi(vv_.y) * dec_); v0.z = cvtpk(ulo(vv_.z) * dec_, uhi(vv_.z) * dec_); v0.w = cvtpk(ulo(vv_.w) * dec_, uhi(vv_.w) * dec_); } while (0)
#define R12_STORE(buf) do { LAS char* kn_ = lds + ((buf) ? R12_KB1 : R12_KB0); LAS char* vn_ = lds + ((buf) ? R12_VB1 : R12_VB0); \
        *(LAS v4u*)(kn_ + krow0 * KTSTR + kch * 16) = k0; *(LAS v4u*)(kn_ + (krow0 + 16) * KTSTR + kch * 16) = k1; *(LAS v4u*)(vn_ + vrow * VSTR + vch * 16) = v0; } while (0)
    R12_LOAD(0); R12_STORE(0);
    __syncthreads();
#pragma unroll 1
    for (int t = 0; t < nblocks; ++t) {
        const int cur = t & 1;
        if ((t & 7) == 0) {
            if (lat) {
                const int cn = t >> 3, n = dir ? nch - 1 - cn : cn;
                bf16* sp = F.SP + sp_index(b, h, dir, n) + eq * EQ + r32;
#pragma unroll
                for (int et = 0; et < NET; ++et)
#pragma unroll
                    for (int r = 0; r < 16; ++r) sp[(size_t)(32 * w + crow(r, hh)) * DV + 32 * et] = (bf16)f2bf(acc[et][r]);
            }
#pragma unroll
            for (int et = 0; et < NET; ++et)
#pragma unroll
                for (int r = 0; r < 16; ++r) acc[et][r] *= g256;
        }
        if (t + 1 < nblocks) R12_LOAD(t + 1);
        lds_cptr kb = lds + (cur ? R12_KB1 : R12_KB0), vb = lds + (cur ? R12_VB1 : R12_VB0);
#pragma unroll
        for (int ks2 = 0; ks2 < 2; ++ks2) {
            const bf16x8 a = cat8(vtr(kb + tra + (16 * ks2) * KTSTR), vtr(kb + tra + (16 * ks2 + 4) * KTSTR));
#pragma unroll
            for (int et = 0; et < NET; ++et) {
                const bf16x8 bb = cat8(vtr(vb + trb + (16 * ks2) * VSTR + 64 * et), vtr(vb + trb + (16 * ks2 + 4) * VSTR + 64 * et));
                acc[et] = MFMA32(a, bb, acc[et]);
            }
        }
        if (t + 1 < nblocks) R12_STORE(cur ^ 1);
        __syncthreads();
    }
#undef R12_LOAD
#undef R12_STORE
    if (lat) {
        const int n = dir ? 0 : nch - 1;
        bf16* sp = F.SP + sp_index(b, h, dir, n) + eq * EQ + r32;
#pragma unroll
        for (int et = 0; et < NET; ++et)
#pragma unroll
            for (int r = 0; r < 16; ++r) sp[(size_t)(32 * w + crow(r, hh)) * DV + 32 * et] = (bf16)f2bf(acc[et][r]);
    } else {
        float* op = F.out + OUT_NSR + ((size_t)((b * 2 + dir) * NH + h) * DK) * DV + eq * EQ + r32;
#pragma unroll
        for (int et = 0; et < NET; ++et)
#pragma unroll
            for (int r = 0; r < 16; ++r) op[(size_t)(32 * w + crow(r, hh)) * DV + 32 * et] = acc[et][r];
    }
}
__device__ __forceinline__ void phase_r12f(Frame& F) {
    constexpr int NLI = NLAT * NH * 2 * 4, NCI = NCTX * NH * 2 * 4;
    if (F.G == 256) {
        if (F.wg < NLI) r12f_item(F, F.wg);
        else { for (int j = 0; j < 4; ++j) r12f_item(F, NLI + (F.wg - NLI) * 4 + j); }
    } else {
        for (int it = F.wg; it < NLI + NCI; it += F.G) r12f_item(F, it);
    }
}


constexpr int XSTR = 272, LRU_XCB = 0, LRU_AS = 64 * XSTR, LRU_BS = LRU_AS + 32768, LRU_HF = LRU_BS + 32768;
__device__ __forceinline__ void lruf_item(Frame& F, int T, int hb, bool fin) {
    const int row0 = 64 * T, tid = F.tid, lane = F.lane, w = F.wave, r32 = lane & 31, hh = lane >> 5;
    int b, seq0, L; bool lat;
    if (row0 < MCTX) { b = row0 / LCTX; seq0 = b * LCTX; L = LCTX; lat = false; } else { b = (row0 - MCTX) / LLAT; seq0 = MCTX + b * LLAT; L = LLAT; lat = true; }
    const int p0 = row0 - seq0, ti = p0 / 64, ntile = L / 64;
    LAS char* lds = (LAS char*)F.lds;
    LAS float* a_s = (LAS float*)(lds + LRU_AS); LAS float* b_s = (LAS float*)(lds + LRU_BS); LAS float* hf_s = (LAS float*)(lds + LRU_HF);
    LAS float* segp = (LAS float*)(lds + LRU_HF + 32768); LAS float* segh = segp + 512; LAS float* carry_s = segh + 512;
    if (fin && tid < 256) {
        const int d2 = tid >> 7, cc = tid & 127, chh = hb * 128 + cc;
        float carry = lat ? F.state_lru[(size_t)(b * 2 + d2) * DL + chh] : 0.f;
        if (d2 == 0) { for (int n = 0; n < ti; ++n) { const float* ag = F.AGG + ((size_t)((T - ti + n) * 2 + 0) * 2) * DL; carry = ag[chh] * carry + ag[DL + chh]; } }
        else { for (int n = ntile - 1; n > ti; --n) { const float* ag = F.AGG + ((size_t)((T - ti + n) * 2 + 1) * 2) * DL; carry = ag[chh] * carry + ag[DL + chh]; } }
        carry_s[tid] = carry;
    }
#pragma unroll
    for (int pp = 0; pp < 2; ++pp) {
        const int piece = tid + 512 * pp, t = piece >> 4, c8 = piece & 15, ch0 = hb * 128 + 8 * c8;
        f32x4 x0 = *(const f32x4*)(F.conv_b + ch0), x1 = *(const f32x4*)(F.conv_b + ch0 + 4);
#pragma unroll
        for (int tap = 0; tap < 4; ++tap) {
            const int tt = t + tap - 2; bool ok;
            if (lat) ok = (tt >= 0 && tt < 64); else { const int p = p0 + tt; ok = (p >= 0 && p < L); }
            if (ok) {
                const v4u raw = *(const v4u*)(F.XL + (size_t)(row0 + tt) * DL + ch0);
                const f32x4 w0 = *(const f32x4*)(F.conv_w + tap * DL + ch0), w1 = *(const f32x4*)(F.conv_w + tap * DL + ch0 + 4);
                x0[0] += w0[0] * ulo(raw.x); x0[1] += w0[1] * uhi(raw.x); x0[2] += w0[2] * ulo(raw.y); x0[3] += w0[3] * uhi(raw.y);
                x1[0] += w1[0] * ulo(raw.z); x1[1] += w1[1] * uhi(raw.z); x1[2] += w1[2] * ulo(raw.w); x1[3] += w1[3] * uhi(raw.w);
            }
        }
        v4u o; o.x = cvtpk(x0[0], x0[1]); o.y = cvtpk(x0[2], x0[3]); o.z = cvtpk(x1[0], x1[1]); o.w = cvtpk(x1[2], x1[3]);
        *(LAS v4u*)(lds + LRU_XCB + t * XSTR + c8 * 16) = o;
    }
    __syncthreads();
    const int rt = w >> 2, cg = w & 3, c = 32 * cg + r32, ch = hb * 128 + c;
#pragma unroll 1
    for (int dir = 0; dir < 2; ++dir) {
        f32x16 acc0, acc1;
#pragma unroll
        for (int r = 0; r < 16; ++r) { acc0[r] = 0.f; acc1[r] = 0.f; }
        const bf16* wb = F.WlruT + (size_t)hb * 512 * LB + (size_t)((2 * dir) * 128 + c) * LB + 8 * hh;
        lds_cptr xa = lds + LRU_XCB + (32 * rt + r32) * XSTR + 16 * hh;
#pragma unroll
        for (int ks = 0; ks < 8; ++ks) {
            const bf16x8 a = *(const LAS bf16x8*)(xa + 32 * ks);
            const bf16x8 b0 = *(const bf16x8*)(wb + 16 * ks), b1 = *(const bf16x8*)(wb + 128 * LB + 16 * ks);
            acc0 = MFMA32(a, b0, acc0); acc1 = MFMA32(a, b1, acc1);
        }
        const float ba = F.lru_ba[dir * DL + ch], bx = F.lru_bx[dir * DL + ch];
        const float sp = log1pf(expf(-F.lru_a[dir * DL + ch]));
#pragma unroll
        for (int r = 0; r < 16; ++r) {
            const int tok = 32 * rt + crow(r, hh);
            const float rr = __builtin_amdgcn_rcpf(1.0f + __expf(-(acc0[r] + ba))), gi = __builtin_amdgcn_rcpf(1.0f + __expf(-(acc1[r] + bx)));
            const float la = -8.0f * rr * sp, x2 = 2.0f * la;
            const float xv = bf2f(*(const LAS bf16*)(lds + LRU_XCB + tok * XSTR + c * 2));
            const float pl = -x2 * (1.0f + x2 * 0.5f * (1.0f + x2 * (1.0f / 3.0f) * (1.0f + x2 * 0.25f * (1.0f + x2 * 0.2f * (1.0f + x2 * (1.0f / 6.0f) * (1.0f + x2 * (1.0f / 7.0f)))))));
            const float em = x2 > -0.25f ? pl : 1.0f - __expf(x2);
            a_s[tok * 128 + c] = __expf(la);
            b_s[tok * 128 + c] = sqrtf(em) * gi * xv;
        }
        __syncthreads();
        {
            const int seg = tid >> 7, cc = tid & 127, chh = hb * 128 + cc;
            const int tb = dir == 0 ? 16 * seg : 16 * seg + 15, ts = dir == 0 ? 1 : -1;
            float av[16], bv[16];
#pragma unroll
            for (int k = 0; k < 16; ++k) { const int t = tb + ts * k; av[k] = a_s[t * 128 + cc]; bv[k] = b_s[t * 128 + cc]; }
            float h = 0.f, pr = 1.f;
#pragma unroll
            for (int k = 0; k < 16; ++k) { h = av[k] * h + bv[k]; pr *= av[k]; bv[k] = h; av[k] = pr; }
            segp[seg * 128 + cc] = pr; segh[seg * 128 + cc] = h;
            __syncthreads();
            float cin = fin ? carry_s[dir * 128 + cc] : 0.f;
            if (dir == 0) { for (int s2 = 0; s2 < seg; ++s2) cin = segp[s2 * 128 + cc] * cin + segh[s2 * 128 + cc]; }
            else { for (int s2 = 3; s2 > seg; --s2) cin = segp[s2 * 128 + cc] * cin + segh[s2 * 128 + cc]; }
            if (fin) {
#pragma unroll
                for (int k = 0; k < 16; ++k) { const int t = tb + ts * k; const float hv = bv[k] + av[k] * cin;
                    if (dir == 0) hf_s[t * 128 + cc] = hv; else hf_s[t * 128 + cc] += hv; }
            }
            const bool lastseg = dir == 0 ? seg == 3 : seg == 0;
            if (lastseg) {
                const float hend = bv[15] + av[15] * cin;
                if (!fin) { float* ag = F.AGG + ((size_t)(T * 2 + dir) * 2) * DL; ag[chh] = (segp[cc] * segp[128 + cc]) * (segp[256 + cc] * segp[384 + cc]); ag[DL + chh] = hend; }
                else if (!lat && (dir == 0 ? ti == ntile - 1 : ti == 0)) F.out[OUT_NSL + (size_t)(b * 2 + dir) * DL + chh] = hend;
            }
        }
        __syncthreads();
    }
    if (fin) {
#pragma unroll
        for (int pp = 0; pp < 2; ++pp) {
            const int piece = tid + 512 * pp, t = piece >> 4, c8 = piece & 15; const size_t o = (size_t)(row0 + t) * DL + hb * 128 + 8 * c8;
            const v4u g = *(const v4u*)(F.GL + o); const LAS float* hp = hf_s + t * 128 + 8 * c8;
            const f32x4 h0 = *(const LAS f32x4*)hp, h1 = *(const LAS f32x4*)(hp + 4);
            v4u r; r.x = cvtpk(h0[0] * ulo(g.x), h0[1] * uhi(g.x)); r.y = cvtpk(h0[2] * ulo(g.y), h0[3] * uhi(g.y)); r.z = cvtpk(h1[0] * ulo(g.z), h1[1] * uhi(g.z)); r.w = cvtpk(h1[2] * ulo(g.w), h1[3] * uhi(g.w));
            *(v4u*)(F.HL + o) = r;
        }
    }
    __syncthreads();
}
__device__ __forceinline__ void phase_lruf(Frame& F, bool fin) {
    for (int it = F.wg; it < (M / 64) * NB; it += F.G) lruf_item(F, it / NB, it % NB, fin);
}


constexpr int LW_XCB = 0, LW_HF0 = 64 * XSTR, LW_HF1 = LW_HF0 + 32768;
__device__ __forceinline__ void lruw_item(Frame& F, int T, int hb, bool fin) {
    const int row0 = 64 * T, tid = F.tid, lane = F.lane, w = F.wave, r32 = lane & 31, hh = lane >> 5;
    int b, seq0, L; bool lat;
    if (row0 < MCTX) { b = row0 / LCTX; seq0 = b * LCTX; L = LCTX; lat = false; } else { b = (row0 - MCTX) / LLAT; seq0 = MCTX + b * LLAT; L = LLAT; lat = true; }
    const int p0 = row0 - seq0, ti = p0 / 64, ntile = L / 64;
    LAS char* lds = (LAS char*)F.lds;
    const int dir = w >> 2, cg = w & 3, c = 32 * cg + r32, ch = hb * 128 + c;
    const float ba = F.lru_ba[dir * DL + ch], bx = F.lru_bx[dir * DL + ch], ap = F.lru_a[dir * DL + ch];
    bf16x8 bfr[2][8];
    { const bf16* wb = F.WlruT + (size_t)hb * 512 * LB + (size_t)((2 * dir) * 128 + c) * LB + 8 * hh;
#pragma unroll
      for (int ks = 0; ks < 8; ++ks) { bfr[0][ks] = *(const bf16x8*)(wb + 16 * ks); bfr[1][ks] = *(const bf16x8*)(wb + 128 * LB + 16 * ks); } }
    float carry = 0.f;
    if (fin) {
        carry = lat ? F.state_lru[(size_t)(b * 2 + dir) * DL + ch] : 0.f;
        const int cnt = dir == 0 ? ti : ntile - 1 - ti;
        const int tstart = dir == 0 ? T - ti : T - ti + ntile - 1, tstep = dir == 0 ? 1 : -1;
        for (int n0 = 0; n0 < cnt; n0 += 8) {
            float pa[8], ha[8];
#pragma unroll
            for (int u = 0; u < 8; ++u) { const int nn = n0 + u < cnt ? n0 + u : cnt - 1; const float* ag = F.AGG + ((size_t)((tstart + tstep * nn) * 2 + dir) * 2) * DL; pa[u] = ag[ch]; ha[u] = ag[DL + ch]; }
#pragma unroll
            for (int u = 0; u < 8; ++u) if (n0 + u < cnt) carry = pa[u] * carry + ha[u];
        }
    }
#pragma unroll
    for (int pp = 0; pp < 2; ++pp) {
        const int piece = tid + 512 * pp, t = piece >> 4, c8 = piece & 15, ch0 = hb * 128 + 8 * c8;
        f32x4 x0 = *(const f32x4*)(F.conv_b + ch0), x1 = *(const f32x4*)(F.conv_b + ch0 + 4);
#pragma unroll
        for (int tap = 0; tap < 4; ++tap) {
            const int tt = t + tap - 2; bool ok;
            if (lat) ok = (tt >= 0 && tt < 64); else { const int p = p0 + tt; ok = (p >= 0 && p < L); }
            if (ok) {
                const v4u raw = *(const v4u*)(F.XL + (size_t)(row0 + tt) * DL + ch0);
                const f32x4 w0 = *(const f32x4*)(F.conv_w + tap * DL + ch0), w1 = *(const f32x4*)(F.conv_w + tap * DL + ch0 + 4);
                x0[0] += w0[0] * ulo(raw.x); x0[1] += w0[1] * uhi(raw.x); x0[2] += w0[2] * ulo(raw.y); x0[3] += w0[3] * uhi(raw.y);
                x1[0] += w1[0] * ulo(raw.z); x1[1] += w1[1] * uhi(raw.z); x1[2] += w1[2] * ulo(raw.w); x1[3] += w1[3] * uhi(raw.w);
            }
        }
        v4u o; o.x = cvtpk(x0[0], x0[1]); o.y = cvtpk(x0[2], x0[3]); o.z = cvtpk(x1[0], x1[1]); o.w = cvtpk(x1[2], x1[3]);
        *(LAS v4u*)(lds + LW_XCB + t * XSTR + c8 * 16) = o;
    }
    __syncthreads();
    float a[8][4], bq[8][4];
    {
        const float sp = log1pf(__expf(-ap));
#pragma unroll
        for (int rt = 0; rt < 2; ++rt) {
            f32x16 acc0, acc1;
#pragma unroll
            for (int r = 0; r < 16; ++r) { acc0[r] = 0.f; acc1[r] = 0.f; }
            lds_cptr xa = lds + LW_XCB + (32 * rt + r32) * XSTR + 16 * hh;
#pragma unroll
            for (int ks = 0; ks < 8; ++ks) { const bf16x8 av = *(const LAS bf16x8*)(xa + 32 * ks); acc0 = MFMA32(av, bfr[0][ks], acc0); acc1 = MFMA32(av, bfr[1][ks], acc1); }
#pragma unroll
            for (int r = 0; r < 16; ++r) {
                const int tok = 32 * rt + crow(r, hh);
                const float rr = __builtin_amdgcn_rcpf(1.0f + __expf(-(acc0[r] + ba))), gi = __builtin_amdgcn_rcpf(1.0f + __expf(-(acc1[r] + bx)));
                const float la = -8.0f * rr * sp, x2 = 2.0f * la;
                const float xv = bf2f(*(const LAS bf16*)(lds + LW_XCB + tok * XSTR + c * 2));
                const float pl = -x2 * (1.0f + x2 * 0.5f * (1.0f + x2 * (1.0f / 3.0f) * (1.0f + x2 * 0.25f * (1.0f + x2 * 0.2f * (1.0f + x2 * (1.0f / 6.0f) * (1.0f + x2 * (1.0f / 7.0f)))))));
                const float em = x2 > -0.25f ? pl : 1.0f - __expf(x2);
                a[rt * 4 + (r >> 2)][r & 3] = __expf(la);
                bq[rt * 4 + (r >> 2)][r & 3] = sqrtf(em) * gi * xv;
            }
        }
    }
    float PR[8], HR[8], PQ[8], HQ[8], ci[8];
    float cin = carry, ptile = 1.f;
    if (dir == 0) {
#pragma unroll
        for (int u = 0; u < 8; ++u) { float h = 0.f, pr = 1.f;
#pragma unroll
            for (int j = 0; j < 4; ++j) { h = a[u][j] * h + bq[u][j]; pr *= a[u][j]; bq[u][j] = h; a[u][j] = pr; }
            PR[u] = pr; HR[u] = h; }
#pragma unroll
        for (int u = 0; u < 8; ++u) { PQ[u] = __shfl_xor(PR[u], 32); HQ[u] = __shfl_xor(HR[u], 32); }
#pragma unroll
        for (int R = 0; R < 16; ++R) { const int u = R >> 1; const bool mine = (R & 1) == hh; const float pp = mine ? PR[u] : PQ[u], hq = mine ? HR[u] : HQ[u];
            ci[u] = mine ? cin : ci[u]; cin = pp * cin + hq; ptile *= pp; }
    } else {
#pragma unroll
        for (int u = 0; u < 8; ++u) { float h = 0.f, pr = 1.f;
#pragma unroll
            for (int j = 3; j >= 0; --j) { h = a[u][j] * h + bq[u][j]; pr *= a[u][j]; bq[u][j] = h; a[u][j] = pr; }
            PR[u] = pr; HR[u] = h; }
#pragma unroll
        for (int u = 0; u < 8; ++u) { PQ[u] = __shfl_xor(PR[u], 32); HQ[u] = __shfl_xor(HR[u], 32); }
#pragma unroll
        for (int R = 15; R >= 0; --R) { const int u = R >> 1; const bool mine = (R & 1) == hh; const float pp = mine ? PR[u] : PQ[u], hq = mine ? HR[u] : HQ[u];
            ci[u] = mine ? cin : ci[u]; cin = pp * cin + hq; ptile *= pp; }
    }
    if (!fin) {
        if (hh == 0) { float* ag = F.AGG + ((size_t)(T * 2 + dir) * 2) * DL; ag[ch] = ptile; ag[DL + ch] = cin; }
    } else {
        LAS float* hf = (LAS float*)(lds + (dir ? LW_HF1 : LW_HF0));
#pragma unroll
        for (int u = 0; u < 8; ++u)
#pragma unroll
            for (int j = 0; j < 4; ++j) hf[(4 * (2 * u + hh) + j) * 128 + c] = bq[u][j] + a[u][j] * ci[u];
        if (hh == 0 && !lat && (dir == 0 ? ti == ntile - 1 : ti == 0)) F.out[OUT_NSL + (size_t)(b * 2 + dir) * DL + ch] = cin;
        __syncthreads();
#pragma unroll
        for (int pp = 0; pp < 2; ++pp) {
            const int piece = tid + 512 * pp, t = piece >> 4, c8 = piece & 15; const size_t o = (size_t)(row0 + t) * DL + hb * 128 + 8 * c8;
            const v4u g = *(const v4u*)(F.GL + o); const LAS float* h0p = (const LAS float*)(lds + LW_HF0) + t * 128 + 8 * c8; const LAS float* h1p = (const LAS float*)(lds + LW_HF1) + t * 128 + 8 * c8;
            const f32x4 h0 = *(const LAS f32x4*)h0p + *(const LAS f32x4*)h1p, h1 = *(const LAS f32x4*)(h0p + 4) + *(const LAS f32x4*)(h1p + 4);
            v4u r; r.x = cvtpk(h0[0] * ulo(g.x), h0[1] * uhi(g.x)); r.y = cvtpk(h0[2] * ulo(g.y), h0[3] * uhi(g.y)); r.z = cvtpk(h1[0] * ulo(g.z), h1[1] * uhi(g.z)); r.w = cvtpk(h1[2] * ulo(g.w), h1[3] * uhi(g.w));
            *(v4u*)(F.HL + o) = r;
        }
    }
    if (!fin) __syncthreads();
}
__device__ __forceinline__ void phase_lruw(Frame& F, bool fin) {
    for (int it = F.wg; it < (M / 64) * NB; it += F.G) lruw_item(F, it / NB, it % NB, fin);
}


constexpr int LX_CW = LW_HF1 + 32768;
__device__ __forceinline__ void phase_lrux(Frame& F, bool fin) {
    constexpr int NT = M / 64;
    const int tid = F.tid, lane = F.lane, w = F.wave, r32 = lane & 31, hh = lane >> 5;
    const int hb = F.wg % NB, rank = F.wg / NB, nw = (F.G - hb + NB - 1) / NB;
    LAS char* lds = (LAS char*)F.lds;
    LAS float* cw = (LAS float*)(lds + LX_CW);
    for (int i = tid; i < 5 * 128; i += NTHR) { const int tap = i >> 7, cc = i & 127; cw[i] = tap < 4 ? F.conv_w[tap * DL + hb * 128 + cc] : F.conv_b[hb * 128 + cc]; }
    const int dir = w >> 2, cg = w & 3, c = 32 * cg + r32, ch = hb * 128 + c;
    const float ba = F.lru_ba[dir * DL + ch] * -1.4426950408889634f, bx = F.lru_bx[dir * DL + ch] * -1.4426950408889634f;
    const float c1 = -8.0f * 1.4426950408889634f * log1pf(__expf(-F.lru_a[dir * DL + ch]));
    const bf16* wb = F.WlruT + (size_t)hb * 512 * LB + (size_t)((2 * dir) * 128 + c) * LB + 8 * hh;
    const int c8 = tid & 15, tq = tid >> 4;
    v4u raw[2][4];
#define LX_LOAD(Tn) do { const int row0_ = 64 * (Tn); const bool lat_ = row0_ >= MCTX; const int seq0_ = lat_ ? MCTX + ((row0_ - MCTX) / LLAT) * LLAT : (row0_ / LCTX) * LCTX, L_ = lat_ ? LLAT : LCTX, p0_ = row0_ - seq0_; \
        _Pragma("unroll") for (int pp_ = 0; pp_ < 2; ++pp_) _Pragma("unroll") for (int tap_ = 0; tap_ < 4; ++tap_) { const int tt_ = tq + 32 * pp_ + tap_ - 2; \
            const bool ok_ = lat_ ? (tt_ >= 0 && tt_ < 64) : (p0_ + tt_ >= 0 && p0_ + tt_ < L_); \
            raw[pp_][tap_] = ok_ ? *(const v4u*)(F.XL + (size_t)(row0_ + tt_) * DL + hb * 128 + 8 * c8) : (v4u){0u, 0u, 0u, 0u}; } } while (0)
    int T = rank;
    if (T < NT) LX_LOAD(T);
    __syncthreads();
    for (; T < NT; T += nw) {
        const int row0 = 64 * T;
        int b, seq0, L; bool lat;
        if (row0 < MCTX) { b = row0 / LCTX; seq0 = b * LCTX; L = LCTX; lat = false; } else { b = (row0 - MCTX) / LLAT; seq0 = MCTX + b * LLAT; L = LLAT; lat = true; }
        const int p0 = row0 - seq0, ti = p0 / 64, ntile = L / 64;
        bf16x8 bfr[2][8];
#pragma unroll
        for (int ks = 0; ks < 8; ++ks) { bfr[0][ks] = *(const bf16x8*)(wb + 16 * ks); bfr[1][ks] = *(const bf16x8*)(wb + 128 * LB + 16 * ks); }
        float carry = 0.f;
        if (fin) {
            carry = lat ? F.state_lru[(size_t)(b * 2 + dir) * DL + ch] : 0.f;
            const int cnt = dir == 0 ? ti : ntile - 1 - ti;
            const int tstart = dir == 0 ? T - ti : T - ti + ntile - 1, tstep = dir == 0 ? 1 : -1;
            for (int n0 = 0; n0 < cnt; n0 += 8) {
                float pa[8], ha[8];
#pragma unroll
                for (int u = 0; u < 8; ++u) { const int nn = n0 + u < cnt ? n0 + u : cnt - 1; const float* ag = F.AGG + ((size_t)((tstart + tstep * nn) * 2 + dir) * 2) * DL; pa[u] = ag[ch]; ha[u] = ag[DL + ch]; }
#pragma unroll
                for (int u = 0; u < 8; ++u) if (n0 + u < cnt) carry = pa[u] * carry + ha[u];
            }
        }
#pragma unroll
        for (int pp = 0; pp < 2; ++pp) {
            f32x4 x0 = *(const LAS f32x4*)(cw + 4 * 128 + 8 * c8), x1 = *(const LAS f32x4*)(cw + 4 * 128 + 8 * c8 + 4);
#pragma unroll
            for (int tap = 0; tap < 4; ++tap) {
                const v4u rw = raw[pp][tap];
                const f32x4 w0 = *(const LAS f32x4*)(cw + tap * 128 + 8 * c8), w1 = *(const LAS f32x4*)(cw + tap * 128 + 8 * c8 + 4);
                x0[0] += w0[0] * ulo(rw.x); x0[1] += w0[1] * uhi(rw.x); x0[2] += w0[2] * ulo(rw.y); x0[3] += w0[3] * uhi(rw.y);
                x1[0] += w1[0] * ulo(rw.z); x1[1] += w1[1] * uhi(rw.z); x1[2] += w1[2] * ulo(rw.w); x1[3] += w1[3] * uhi(rw.w);
            }
            v4u o; o.x = cvtpk(x0[0], x0[1]); o.y = cvtpk(x0[2], x0[3]); o.z = cvtpk(x1[0], x1[1]); o.w = cvtpk(x1[2], x1[3]);
            *(LAS v4u*)(lds + LW_XCB + (tq + 32 * pp) * XSTR + c8 * 16) = o;
        }
        __syncthreads();
        if (T + nw < NT) LX_LOAD(T + nw);
        float a[8][4], bq[8][4];
#pragma unroll
        for (int rt = 0; rt < 2; ++rt) {
            f32x16 acc0, acc1;
#pragma unroll
            for (int r = 0; r < 16; ++r) { acc0[r] = 0.f; acc1[r] = 0.f; }
            lds_cptr xa = lds + LW_XCB + (32 * rt + r32) * XSTR + 16 * hh;
#pragma unroll
            for (int ks = 0; ks < 8; ++ks) { const bf16x8 av = *(const LAS bf16x8*)(xa + 32 * ks); acc0 = MFMA32(av, bfr[0][ks], acc0); acc1 = MFMA32(av, bfr[1][ks], acc1); }
#pragma unroll
            for (int r = 0; r < 16; ++r) {
                const int tok = 32 * rt + crow(r, hh);
                const float rr = __builtin_amdgcn_rcpf(1.0f + __builtin_amdgcn_exp2f(acc0[r] * -1.4426950408889634f + ba));
                const float gi = __builtin_amdgcn_rcpf(1.0f + __builtin_amdgcn_exp2f(acc1[r] * -1.4426950408889634f + bx));
                const float av = __builtin_amdgcn_exp2f(c1 * rr);
                const float xv = bf2f(*(const LAS bf16*)(lds + LW_XCB + tok * XSTR + c * 2));
                a[rt * 4 + (r >> 2)][r & 3] = av;
                bq[rt * 4 + (r >> 2)][r & 3] = __builtin_amdgcn_sqrtf(__builtin_fmaf(-av, av, 1.0f)) * (gi * xv);
            }
        }
        float PR[8], HR[8], PQ[8], HQ[8], ci[8];
        float cin = carry, ptile = 1.f;
        if (dir == 0) {
#pragma unroll
            for (int u = 0; u < 8; ++u) { float h = 0.f, pr = 1.f;
#pragma unroll
                for (int j = 0; j < 4; ++j) { h = a[u][j] * h + bq[u][j]; pr *= a[u][j]; bq[u][j] = h; a[u][j] = pr; }
                PR[u] = pr; HR[u] = h; }
#pragma unroll
            for (int u = 0; u < 8; ++u) { PQ[u] = __shfl_xor(PR[u], 32); HQ[u] = __shfl_xor(HR[u], 32); }
#pragma unroll
            for (int R = 0; R < 16; ++R) { const int u = R >> 1; const bool mine = (R & 1) == hh; const float pp = mine ? PR[u] : PQ[u], hq = mine ? HR[u] : HQ[u];
                ci[u] = mine ? cin : ci[u]; cin = pp * cin + hq; ptile *= pp; }
        } else {
#pragma unroll
            for (int u = 0; u < 8; ++u) { float h = 0.f, pr = 1.f;
#pragma unroll
                for (int j = 3; j >= 0; --j) { h = a[u][j] * h + bq[u][j]; pr *= a[u][j]; bq[u][j] = h; a[u][j] = pr; }
                PR[u] = pr; HR[u] = h; }
#pragma unroll
            for (int u = 0; u < 8; ++u) { PQ[u] = __shfl_xor(PR[u], 32); HQ[u] = __shfl_xor(HR[u], 32); }
#pragma unroll
            for (int R = 15; R >= 0; --R) { const int u = R >> 1; const bool mine = (R & 1) == hh; const float pp = mine ? PR[u] : PQ[u], hq = mine ? HR[u] : HQ[u];
                ci[u] = mine ? cin : ci[u]; cin = pp * cin + hq; ptile *= pp; }
        }
        if (!fin) {
            if (hh == 0) { float* ag = F.AGG + ((size_t)(T * 2 + dir) * 2) * DL; ag[ch] = ptile; ag[DL + ch] = cin; }
            __syncthreads();
        } else {
            LAS float* hf = (LAS float*)(lds + (dir ? LW_HF1 : LW_HF0));
#pragma unroll
            for (int u = 0; u < 8; ++u)
#pragma unroll
                for (int j = 0; j < 4; ++j) hf[(4 * (2 * u + hh) + j) * 128 + c] = bq[u][j] + a[u][j] * ci[u];
            if (hh == 0 && !lat && (dir == 0 ? ti == ntile - 1 : ti == 0)) F.out[OUT_NSL + (size_t)(b * 2 + dir) * DL + ch] = cin;
            __syncthreads();
#pragma unroll
            for (int pp = 0; pp < 2; ++pp) {
                const int t = tq + 32 * pp; const size_t o = (size_t)(row0 + t) * DL + hb * 128 + 8 * c8;
                const v4u g = *(const v4u*)(F.GL + o); const LAS float* h0p = (const LAS float*)(lds + LW_HF0) + t * 128 + 8 * c8; const LAS float* h1p = (const LAS float*)(lds + LW_HF1) + t * 128 + 8 * c8;
                const f32x4 h0 = *(const LAS f32x4*)h0p + *(const LAS f32x4*)h1p, h1 = *(const LAS f32x4*)(h0p + 4) + *(const LAS f32x4*)(h1p + 4);
                v4u r; r.x = cvtpk(h0[0] * ulo(g.x), h0[1] * uhi(g.x)); r.y = cvtpk(h0[2] * ulo(g.y), h0[3] * uhi(g.y)); r.z = cvtpk(h1[0] * ulo(g.z), h1[1] * uhi(g.z)); r.w = cvtpk(h1[2] * ulo(g.w), h1[3] * uhi(g.w));
                *(v4u*)(F.HL + o) = r;
            }
        }
    }
#undef LX_LOAD
    __syncthreads();
}

__device__ __forceinline__ void phase_norm(Frame& F) {
    const int gw = F.wg * NWAVES + F.wave, NGW = F.G * NWAVES;
    for (int m = gw; m < M; m += NGW) {
        f32x4* yr = (f32x4*)(F.out + OUT_Y + (size_t)m * D) + F.lane;
        f32x4 v[4]; float s = 0.f;
#pragma unroll
        for (int j = 0; j < 4; ++j) { v[j] = yr[64 * j]; s += (v[j].x * v[j].x + v[j].y * v[j].y) + (v[j].z * v[j].z + v[j].w * v[j].w); }
        const float rstd = 1.0f / sqrtf(wave_sum(s) * (1.f / D) + EPS);
#pragma unroll
        for (int j = 0; j < 4; ++j) { const f32x4 nw = *(const f32x4*)(F.final_norm_w + 4 * F.lane + 256 * j); yr[64 * j] = v[j] * rstd * nw; }
    }
}

__device__ __forceinline__ int opq(int x) { int r; asm volatile("s_mov_b32 %0, %1" : "=s"(r) : "s"(x)); return r; }
constexpr int PH_PREP = 0, PH_H = 1, PH_GEMM1 = 2, PH_LRUA = 3, PH_LRUB = 4, PH_R12 = 5, PH_R3 = 6, PH_G2 = 7, PH_DOWN = 8, PH_OUT = 9, PH_NORM = 10, N_PHASES = 11;

__global__ void __launch_bounds__(NTHR, 2) fwd_kernel(Args args) {
    extern __shared__ __attribute__((aligned(16))) unsigned char lds_raw[];
    Frame F;
    F.lds = (LAS unsigned char*)lds_raw;
    F.tid = threadIdx.x; F.lane = F.tid & 63; F.wave = __builtin_amdgcn_readfirstlane(F.tid >> 6);
    F.G = gridDim.x; F.wg = blockIdx.x;
    F.x_prompt = args.in[0]; F.x_sample = args.in[1]; F.state_ret = args.in[2]; F.state_lru = args.in[3]; F.c = args.in[4]; F.c_ctx = args.in[5];
    F.norm_w = args.in[6]; F.w_ada = args.in[7]; F.b_ada = args.in[8]; F.w_in = args.in[9]; F.decay_logit = args.in[10]; F.gn_w = args.in[11];
    F.w_ret_down = args.in[12]; F.conv_w = args.in[13]; F.conv_b = args.in[14]; F.lru_wa = args.in[15]; F.lru_ba = args.in[16]; F.lru_wx = args.in[17];
    F.lru_bx = args.in[18]; F.lru_a = args.in[19]; F.w_lru_down = args.in[20]; F.w_out = args.in[21]; F.final_norm_w = args.in[22];
    F.out = args.out; F.ws = args.ws;
    unsigned char* ws = args.ws;
    F.WinT = (bf16*)(ws + WS_WINT); F.WrdT = (bf16*)(ws + WS_WRDT); F.WldT = (bf16*)(ws + WS_WLDT); F.WoutT = (bf16*)(ws + WS_WOUTT); F.WlruT = (bf16*)(ws + WS_WLRUT);
    F.MOD = (float*)(ws + WS_MOD); F.MODP = (float*)(ws + WS_MODP); F.H = (bf16*)(ws + WS_H); F.Q = (bf16*)(ws + WS_Q); F.K = (bf16*)(ws + WS_K); F.V = (bf16*)(ws + WS_V);
    F.XL = (bf16*)(ws + WS_XL); F.GL = (bf16*)(ws + WS_GL); F.AGG = (float*)(ws + WS_AGG); F.SS = (float*)(ws + WS_SS); F.HL = (bf16*)(ws + WS_HL); F.SP = (bf16*)(ws + WS_SP);
    F.SIGR = (bf16*)(ws + WS_SIGR); F.SIGL = (bf16*)(ws + WS_SIGL); F.MERGED = (bf16*)(ws + WS_MERGED); F.OG = (bf16*)(args.out + OUT_Y);

    volatile LAS unsigned* MISC = (volatile LAS unsigned*)(F.lds + MISC_OFF);
    for (int u = F.tid; u < (LDS_BYTES - 131072) / 4; u += NTHR) ((LAS unsigned*)(F.lds + 131072))[u] = 0u;
    __syncthreads();
    const int lo = args.ph_lo, hi = args.ph_hi;
    XcdBarrier bar; bar.bar = (unsigned*)(ws + WS_CTL) + CW_BAR; bar.x = 0; bar.st = nullptr;
    if (hi - lo > 1) bar = xcd_barrier_post((unsigned*)(ws + WS_CTL) + CW_BAR, MISC + 8);
#define IN(k) (lo <= (k) && (k) < hi)
#define SEAM(k) do { if (IN(k) && IN((k) + 1)) xcd_barrier(bar); } while (0)

    if (IN(PH_PREP)) { for (int rp = 0; rp < args.rep[PH_PREP]; ++rp) { F.wg = opq(blockIdx.x); phase_prep(F); __syncthreads(); } SEAM(PH_PREP); }
    if (IN(PH_H)) { for (int rp = 0; rp < args.rep[PH_H]; ++rp) { F.wg = opq(blockIdx.x); phase_h(F); } SEAM(PH_H); }
    if (IN(PH_GEMM1)) for (int rp = 0; rp < args.rep[PH_GEMM1]; ++rp) { F.wg = opq(blockIdx.x); pg8::Gemm g{F.H, F.WinT, M, N1, D}; pg8::StaticOrder S; S.init(M, N1, F.G, F.wg); pg8::EpiG1 E{F.Q, F.K, F.V, F.XL, F.GL};
        pg8::gemm_phase<pg8::EpiG1, pg8::StaticOrder, true, true>(F.lds, g, S, E); } SEAM(PH_GEMM1);
    if (IN(PH_LRUA)) { for (int rp = 0; rp < args.rep[PH_LRUA]; ++rp) { F.wg = opq(blockIdx.x); phase_lrux(F, false); } SEAM(PH_LRUA); }
    if (IN(PH_LRUB)) { for (int rp = 0; rp < args.rep[PH_LRUB]; ++rp) { F.wg = opq(blockIdx.x); phase_lrux(F, true); } SEAM(PH_LRUB); }
    if (IN(PH_R12)) { for (int rp = 0; rp < args.rep[PH_R12]; ++rp) { F.wg = opq(blockIdx.x); phase_r12f(F); } SEAM(PH_R12); }
    if (IN(PH_R3)) { for (int rp = 0; rp < args.rep[PH_R3]; ++rp) { F.wg = opq(blockIdx.x); phase_r3f(F); } SEAM(PH_R3); }
    if (IN(PH_G2)) { pg8::Gemm g{F.H, F.WinT + (size_t)N1 * D, M, N2, D}; pg8::StaticOrder S; S.init(M, N2, F.G, F.wg); pg8::EpiG2 E{F.OG, F.SIGR, F.SIGL, F.SS, F.gn_w};
        pg8::gemm_phase<pg8::EpiG2, pg8::StaticOrder, true, true>(F.lds, g, S, E); SEAM(PH_G2); }
    if (IN(PH_DOWN)) { for (int rp = 0; rp < args.rep[PH_DOWN]; ++rp) { F.wg = opq(blockIdx.x);
        { pg8::Gemm g{F.OG, F.WrdT, M, D, DRV}; pg8::StaticOrder S; S.init(M, D, F.G, F.wg); pg8::EpiDown<false> E{F.MERGED, F.SIGR}; pg8::gemm_phase<pg8::EpiDown<false>, pg8::StaticOrder, true, true>(F.lds, g, S, E); }
        { pg8::Gemm g{F.HL, F.WldT, M, D, DL}; pg8::StaticOrder S; S.init(M, D, F.G, F.wg); pg8::EpiDown<true> E{F.MERGED, F.SIGL}; pg8::gemm_phase<pg8::EpiDown<true>, pg8::StaticOrder, true, true>(F.lds, g, S, E); } }
        SEAM(PH_DOWN);
    }
    if (IN(PH_OUT)) for (int rp = 0; rp < args.rep[PH_OUT]; ++rp) { F.wg = opq(blockIdx.x); pg8::Gemm g{F.MERGED, F.WoutT, M, D, D}; pg8::StaticOrder S; S.init(M, D, F.G, F.wg); pg8::EpiY E{F.out + OUT_Y, F.x_prompt, F.x_sample, F.MOD, MCTX, LLAT};
        pg8::gemm_phase<pg8::EpiY, pg8::StaticOrder, true, true>(F.lds, g, S, E); } SEAM(PH_OUT);
    if (IN(PH_NORM)) { phase_norm(F); }
#undef IN
#undef SEAM
}
}

extern "C" void kernel_launch(void* const* d_in, const int* in_sizes, int n_in, void* d_out, int out_size, void* d_ws, size_t ws_size, hipStream_t stream) {
    static int grid = 0;
    if (grid == 0) {
        if (n_in != 23 || (size_t)out_size != OUT_TOTAL || ws_size < WS_END) { fprintf(stderr, "kernel_launch: unexpected shapes n_in %d out %d ws %zu\n", n_in, out_size, ws_size); grid = -1; return; }
        int dev = 0, cus = 0;
        if (hipGetDevice(&dev) != hipSuccess || hipDeviceGetAttribute(&cus, hipDeviceAttributeMultiprocessorCount, dev) != hipSuccess) { grid = -1; return; }
        if (hipFuncSetAttribute((const void*)fwd_kernel, hipFuncAttributeMaxDynamicSharedMemorySize, LDS_BYTES) != hipSuccess) { fprintf(stderr, "kernel_launch: hipFuncSetAttribute failed\n"); grid = -1; return; }
        int per_cu = 0;
        (void)hipOccupancyMaxActiveBlocksPerMultiprocessor(&per_cu, (const void*)fwd_kernel, NTHR, LDS_BYTES);
        (void)hipGetLastError();
        grid = cus;
    }
    if (grid < 0) return;
    (void)hipMemsetAsync((char*)d_ws + WS_CTL, 0, CTL_ZERO_BYTES, stream);
    Args a{};
    for (int i = 0; i < 23; ++i) a.in[i] = (const float*)d_in[i];
    a.out = (float*)d_out; a.ws = (unsigned char*)d_ws;
    { static const int REP[12] = {PROBE_REP}; for (int i = 0; i < 12; ++i) a.rep[i] = REP[i]; }
#if MK_ONE_LAUNCH
    a.ph_lo = 0; a.ph_hi = N_PHASES;
    hipLaunchKernelGGL(fwd_kernel, dim3(grid), dim3(NTHR), LDS_BYTES, stream, a);
#else
    for (int p = 0; p < N_PHASES; ++p) { a.ph_lo = p; a.ph_hi = p + 1; hipLaunchKernelGGL(fwd_kernel, dim3(grid), dim3(NTHR), LDS_BYTES, stream, a); }
#endif
}
```
